# Optimizing an MI355X kernel written in HIP

```python
import math
import jax, jax.numpy as jnp
from jax import lax
import numpy as np

D_MODEL = 1024
BATCH = 2
SEQ = 8192
DEPTH = 1

N_MEM = 256
GDN_HEADS = 4
GDN_DK = 128
GDN_DV = 128
GDN_CONV = 4
GDN_CHUNK = 64
DIFF_HEADS = 4
DIFF_DQK = 64
DIFF_DV = 2 * DIFF_DQK
Q_BLOCK = 128
XA_HEADS = 4
XA_DH = D_MODEL // XA_HEADS
N_EXPERTS = 32
TOP_K = 4
D_FF = D_MODEL
SWIGLU_ALPHA = 1.702
SWIGLU_LIMIT = 7.0
MOE_BLOCK = 128
LN_EPS = 1e-5
RMS_EPS = 1e-6
DEEPNORM_ALPHA = (2 * DEPTH) ** 0.25
DEEPNORM_BETA = (8 * DEPTH) ** -0.25
GDN_QK_W = GDN_HEADS * GDN_DK
GDN_V_W = GDN_HEADS * GDN_DV
DIFF_QK_W = DIFF_HEADS * 2 * DIFF_DQK
DIFF_V_W = DIFF_HEADS * DIFF_DV
MIX_WIDTH = GDN_V_W + DIFF_V_W
IN_SIZES = (GDN_QK_W, GDN_QK_W, GDN_V_W, GDN_V_W, GDN_HEADS, GDN_HEADS, DIFF_QK_W, DIFF_QK_W, DIFF_V_W)
IN_COLS = sum(IN_SIZES)

kernel_name = 'hybrid_gdn_diffattn_memxattn_moe_deepnorm'


def split_cols(t, sizes):
    out, off = [], 0
    for s in sizes:
        out.append(t[..., off:off + s])
        off += s
    return out


def layer_norm(x, g, b):
    xf = x.astype(jnp.float32)
    mu = jnp.mean(xf, -1, keepdims=True)
    var = jnp.mean(jnp.square(xf - mu), -1, keepdims=True)
    return ((xf - mu) * lax.rsqrt(var + LN_EPS) * g.astype(jnp.float32) + b.astype(jnp.float32)).astype(x.dtype)


def rms_norm(x, w):
    xf = x.astype(jnp.float32)
    return xf * lax.rsqrt(jnp.mean(jnp.square(xf), -1, keepdims=True) + RMS_EPS) * w.astype(jnp.float32)


def l2_normalize(x):
    xf = x.astype(jnp.float32)
    return xf * lax.rsqrt(jnp.sum(jnp.square(xf), -1, keepdims=True) + RMS_EPS)


def causal_depthwise_conv(x, w):
    return lax.conv_general_dilated(x, w.astype(x.dtype), window_strides=(1,),
                                    padding=((GDN_CONV - 1, 0),),
                                    dimension_numbers=('NWC', 'WIO', 'NWC'),
                                    feature_group_count=x.shape[-1])


def gated_delta_rule_chunked(q, k, v, g, beta):
    B_, S_, H, DK = q.shape
    DV = v.shape[-1]
    C = GDN_CHUNK
    N = S_ // C
    f32 = jnp.float32

    def to_chunks(t):
        t = t.astype(f32).reshape((B_, N, C, H) + t.shape[3:])
        return jnp.moveaxis(t, 3, 1)

    q = to_chunks(q) * (DK ** -0.5)
    k = to_chunks(k)
    v = to_chunks(v)
    beta = to_chunks(beta)
    g = jnp.cumsum(to_chunks(g), axis=-1)
    causal = jnp.tril(jnp.ones((C, C), bool))
    strict = jnp.tril(jnp.ones((C, C), bool), -1)
    gdiff = g[..., :, None] - g[..., None, :]
    decay = jnp.where(causal, jnp.exp(jnp.where(causal, gdiff, 0.0)), 0.0)
    k_beta = k * beta[..., None]
    v_beta = v * beta[..., None]
    lmat = jnp.where(strict, jnp.einsum('bhncd,bhnsd->bhncs', k_beta, k) * decay, 0.0)
    amat = lmat + jnp.eye(C, dtype=f32)
    rhs = jnp.concatenate([v_beta, k_beta * jnp.exp(g)[..., None]], -1)
    sol = lax.linalg.triangular_solve(amat, rhs, left_side=True, lower=True, unit_diagonal=True)
    u = sol[..., :DV]
    w = sol[..., DV:]
    attn_intra = jnp.where(causal, jnp.einsum('bhncd,bhnsd->bhncs', q, k) * decay, 0.0)
    q_decay = q * jnp.exp(g)[..., None]
    k_tail = k * jnp.exp(g[..., -1:] - g)[..., None]
    g_last = jnp.exp(g[..., -1])

    def step(state, inp):
        u_c, w_c, qd_c, ai_c, kt_c, gl_c = inp
        v_new = u_c - jnp.einsum('bhck,bhkv->bhcv', w_c, state)
        out = jnp.einsum('bhck,bhkv->bhcv', qd_c, state) + jnp.einsum('bhcs,bhsv->bhcv', ai_c, v_new)
        state = state * gl_c[..., None, None] + jnp.einsum('bhck,bhcv->bhkv', kt_c, v_new)
        return state, out

    xs = tuple(jnp.moveaxis(t, 2, 0) for t in (u, w, q_decay, attn_intra, k_tail, g_last))
    state0 = jnp.zeros((B_, H, DK, DV), f32)
    _, out = lax.scan(step, state0, xs)
    return jnp.transpose(out, (1, 0, 3, 2, 4)).reshape(B_, S_, H, DV)


def differential_attention(q, k, v, lam):
    B_, S_, H = q.shape[:3]
    nb = S_ // Q_BLOCK
    scale = DIFF_DQK ** -0.5
    qb = jnp.moveaxis(q.reshape((B_, nb, Q_BLOCK) + q.shape[2:]), 1, 0)
    kpos = jnp.arange(S_)

    def block(args):
        q_blk, i = args
        qpos = i * Q_BLOCK + jnp.arange(Q_BLOCK)
        s = jnp.einsum('bqhcd,bkhcd->bhcqk', q_blk, k).astype(jnp.float32) * scale
        s = jnp.where(kpos[None, :] <= qpos[:, None], s, -jnp.inf)
        p = jax.nn.softmax(s, axis=-1)
        a = p[:, :, 0] - lam * p[:, :, 1]
        return jnp.einsum('bhqk,bkhv->bqhv', a.astype(v.dtype), v)

    out = lax.map(block, (qb, jnp.arange(nb)))
    return jnp.moveaxis(out, 0, 1).reshape(B_, S_, H, v.shape[-1])


def hybrid_mixer(x, w_in, conv_w, a_log, dt_bias, gdn_norm_w, lq1, lk1, lq2, lk2, diff_norm_w, w_out, lambda_init):
    B_, S_, _ = x.shape
    f32 = jnp.float32
    proj = x @ w_in
    gq, gk, gv, gz, gb, ga, dq, dk, dv = split_cols(proj, IN_SIZES)
    qkv = jax.nn.silu(causal_depthwise_conv(jnp.concatenate([gq, gk, gv], -1), conv_w))
    gq, gk, gv = split_cols(qkv, (GDN_QK_W, GDN_QK_W, GDN_V_W))
    q = l2_normalize(gq.reshape(B_, S_, GDN_HEADS, GDN_DK))
    k = l2_normalize(gk.reshape(B_, S_, GDN_HEADS, GDN_DK))
    v = gv.reshape(B_, S_, GDN_HEADS, GDN_DV).astype(f32)
    beta = jax.nn.sigmoid(gb.astype(f32))
    g = -jnp.exp(a_log.astype(f32)) * jax.nn.softplus(ga.astype(f32) + dt_bias.astype(f32))
    o = gated_delta_rule_chunked(q, k, v, g, beta)
    o = rms_norm(o, gdn_norm_w) * jax.nn.silu(gz.reshape(B_, S_, GDN_HEADS, GDN_DV).astype(f32))
    o_gdn = o.reshape(B_, S_, GDN_V_W).astype(x.dtype)
    lam = (jnp.exp(jnp.sum(lq1.astype(f32) * lk1.astype(f32)))
           - jnp.exp(jnp.sum(lq2.astype(f32) * lk2.astype(f32))) + lambda_init)
    od = differential_attention(dq.reshape(B_, S_, DIFF_HEADS, 2, DIFF_DQK),
                                dk.reshape(B_, S_, DIFF_HEADS, 2, DIFF_DQK),
                                dv.reshape(B_, S_, DIFF_HEADS, DIFF_DV), lam)
    od = rms_norm(od, diff_norm_w) * (1.0 - lambda_init)
    o_diff = od.reshape(B_, S_, DIFF_V_W).astype(x.dtype)
    return jnp.concatenate([o_gdn, o_diff], -1) @ w_out


def mem_cross_attention(x, mem, wq, wk, wv, wo):
    B_, S_, D = x.shape
    M = mem.shape[1]
    q = (x @ wq).reshape(B_, S_, XA_HEADS, XA_DH)
    k = (mem @ wk).reshape(B_, M, XA_HEADS, XA_DH)
    v = (mem @ wv).reshape(B_, M, XA_HEADS, XA_DH)
    s = jnp.einsum('bshd,bmhd->bhsm', q, k).astype(jnp.float32) * (XA_DH ** -0.5)
    p = jax.nn.softmax(s, axis=-1)
    o = jnp.einsum('bhsm,bmhd->bshd', p.astype(v.dtype), v).reshape(B_, S_, D)
    return o @ wo


def clamped_swiglu(h_gate, h_lin):
    h_gate = jnp.minimum(h_gate, SWIGLU_LIMIT)
    h_lin = jnp.clip(h_lin, -SWIGLU_LIMIT, SWIGLU_LIMIT)
    return h_gate * jax.nn.sigmoid(SWIGLU_ALPHA * h_gate) * (h_lin + 1.0)


def moe_ffn(x, router_w, router_b, w_gate, b_gate, w_up, b_up, w_down, b_down):
    B_, S_, D = x.shape
    xt = x.reshape(-1, D)
    T = xt.shape[0]
    logits = (xt @ router_w + router_b).astype(jnp.float32)
    top_val, top_idx = lax.top_k(logits, TOP_K)
    gate = jax.nn.softmax(top_val, axis=-1)
    A = T * TOP_K
    flat_e = top_idx.reshape(-1)
    order = jnp.argsort(flat_e)
    sorted_e = flat_e[order]
    token_of = order // TOP_K
    counts = jnp.bincount(flat_e, length=N_EXPERTS)
    padded = (counts + MOE_BLOCK - 1) // MOE_BLOCK * MOE_BLOCK
    start = jnp.cumsum(counts) - counts
    pad_end = jnp.cumsum(padded)
    pad_start = pad_end - padded
    dest = pad_start[sorted_e] + (jnp.arange(A) - start[sorted_e])
    n_blocks = -(-A // MOE_BLOCK) + N_EXPERTS
    P = n_blocks * MOE_BLOCK
    xs = jnp.zeros((P, D), xt.dtype).at[dest].set(xt[token_of])
    block_e = jnp.minimum(jnp.searchsorted(pad_end, jnp.arange(n_blocks) * MOE_BLOCK, side='right'), N_EXPERTS - 1)

    def expert_block(args):
        xb, e = args
        h = clamped_swiglu(xb @ w_gate[e] + b_gate[e], xb @ w_up[e] + b_up[e])
        return h @ w_down[e] + b_down[e]

    ys = lax.map(expert_block, (xs.reshape(n_blocks, MOE_BLOCK, D), block_e)).reshape(P, D)
    y_assign = ys[dest] * gate.reshape(-1)[order][:, None].astype(ys.dtype)
    y = jnp.zeros_like(xt).at[token_of].add(y_assign)
    return y.reshape(B_, S_, D)


def setup_inputs(seed: int = 0) -> dict:
    key = jax.random.key(seed)
    ks = jax.random.split(key, 40)
    f32 = jnp.float32
    L = DEPTH

    def nrm(k, shape, scale):
        return jax.random.normal(k, shape, f32) * scale

    dt = jnp.exp(jax.random.uniform(ks[4], (L, GDN_HEADS), f32, math.log(1e-3), math.log(1e-1)))
    return {
        'x': nrm(ks[0], (BATCH, SEQ, D_MODEL), 1.0),
        'mem': nrm(ks[1], (BATCH, N_MEM, D_MODEL), 1.0),
        'w_in': nrm(ks[2], (L, D_MODEL, IN_COLS), D_MODEL ** -0.5),
        'gdn_conv_w': nrm(ks[3], (L, GDN_CONV, 1, 2 * GDN_QK_W + GDN_V_W), GDN_CONV ** -0.5),
        'gdn_a_log': jnp.log(jax.random.uniform(ks[5], (L, GDN_HEADS), f32, 1.0, 16.0)),
        'gdn_dt_bias': dt + jnp.log(-jnp.expm1(-dt)),
        'gdn_norm_w': 1.0 + nrm(ks[6], (L, GDN_DV), 0.02),
        'diff_lq1': nrm(ks[7], (L, DIFF_DQK), 0.1),
        'diff_lk1': nrm(ks[8], (L, DIFF_DQK), 0.1),
        'diff_lq2': nrm(ks[9], (L, DIFF_DQK), 0.1),
        'diff_lk2': nrm(ks[10], (L, DIFF_DQK), 0.1),
        'diff_norm_w': 1.0 + nrm(ks[11], (L, DIFF_DV), 0.02),
        'w_out': nrm(ks[12], (L, MIX_WIDTH, D_MODEL), MIX_WIDTH ** -0.5 * DEEPNORM_BETA),
        'ln1_g': 1.0 + nrm(ks[13], (L, D_MODEL), 0.02),
        'ln1_b': nrm(ks[14], (L, D_MODEL), 0.02),
        'xa_wq': nrm(ks[15], (L, D_MODEL, D_MODEL), D_MODEL ** -0.5),
        'xa_wk': nrm(ks[16], (L, D_MODEL, D_MODEL), D_MODEL ** -0.5),
        'xa_wv': nrm(ks[17], (L, D_MODEL, D_MODEL), D_MODEL ** -0.5),
        'xa_wo': nrm(ks[18], (L, D_MODEL, D_MODEL), D_MODEL ** -0.5 * DEEPNORM_BETA),
        'ln2_g': 1.0 + nrm(ks[19], (L, D_MODEL), 0.02),
        'ln2_b': nrm(ks[20], (L, D_MODEL), 0.02),
        'router_w': nrm(ks[21], (L, D_MODEL, N_EXPERTS), D_MODEL ** -0.5),
        'router_b': nrm(ks[22], (L, N_EXPERTS), 0.01),
        'exp_w_gate': nrm(ks[23], (L, N_EXPERTS, D_MODEL, D_FF), D_MODEL ** -0.5),
        'exp_b_gate': nrm(ks[24], (L, N_EXPERTS, D_FF), 0.01),
        'exp_w_up': nrm(ks[25], (L, N_EXPERTS, D_MODEL, D_FF), D_MODEL ** -0.5),
        'exp_b_up': nrm(ks[26], (L, N_EXPERTS, D_FF), 0.01),
        'exp_w_down': nrm(ks[27], (L, N_EXPERTS, D_FF, D_MODEL), D_FF ** -0.5 * DEEPNORM_BETA),
        'exp_b_down': nrm(ks[28], (L, N_EXPERTS, D_MODEL), 0.01),
        'ln3_g': 1.0 + nrm(ks[29], (L, D_MODEL), 0.02),
        'ln3_b': nrm(ks[30], (L, D_MODEL), 0.02),
    }


def reference(x, mem, w_in, gdn_conv_w, gdn_a_log, gdn_dt_bias, gdn_norm_w, diff_lq1, diff_lk1, diff_lq2, diff_lk2,
              diff_norm_w, w_out, ln1_g, ln1_b, xa_wq, xa_wk, xa_wv, xa_wo, ln2_g, ln2_b, router_w, router_b,
              exp_w_gate, exp_b_gate, exp_w_up, exp_b_up, exp_w_down, exp_b_down, ln3_g, ln3_b):
    for l in range(DEPTH):
        lambda_init = 0.8 - 0.6 * math.exp(-0.3 * l)
        h = hybrid_mixer(x, w_in[l], gdn_conv_w[l], gdn_a_log[l], gdn_dt_bias[l], gdn_norm_w[l],
                         diff_lq1[l], diff_lk1[l], diff_lq2[l], diff_lk2[l], diff_norm_w[l], w_out[l], lambda_init)
        x = layer_norm(DEEPNORM_ALPHA * x + h, ln1_g[l], ln1_b[l])
        h = mem_cross_attention(x, mem, xa_wq[l], xa_wk[l], xa_wv[l], xa_wo[l])
        x = layer_norm(DEEPNORM_ALPHA * x + h, ln2_g[l], ln2_b[l])
        h = moe_ffn(x, router_w[l], router_b[l], exp_w_gate[l], exp_b_gate[l], exp_w_up[l], exp_b_up[l],
                    exp_w_down[l], exp_b_down[l])
        x = layer_norm(DEEPNORM_ALPHA * x + h, ln3_g[l], ln3_b[l])
    return x
```

```cpp
#include <hip/hip_runtime.h>
#include <hip/hip_cooperative_groups.h>
#include <cstdio>
#include <cstdint>
namespace cg = cooperative_groups;
#define MK_N_LAUNCHES 15
namespace pg8 {
#define PG8_LAS __attribute__((address_space(3)))
typedef unsigned short bf16_t;
typedef short bf16x8 __attribute__((ext_vector_type(8)));
typedef float f32x4 __attribute__((ext_vector_type(4)));
typedef unsigned u32x4 __attribute__((ext_vector_type(4)));
constexpr int BM = 256, BK = 64, HALF = 128, HTB = HALF * BK * 2  , STAGE_BYTES = 8 * HTB, NXCD = 8, WGM = 8;

__host__ __device__ __forceinline__ int lds_byte(int r, int c) { const int st = (r >> 4) * 2 + (c >> 5), rr = r & 15, cc = c & 31, ob = rr * 64 + cc * 2; return st * 1024 + (ob ^ (((ob >> 9) & 1) << 5)); }
__host__ __device__ __forceinline__ void stage_rc(int b, int& R, int& C) { const int st = b / 1024, sb = b % 1024, swz = sb ^ (((sb >> 9) & 1) << 5); R = (st >> 1) * 16 + swz / 64; C = (st & 1) * 32 + (swz % 64) / 2; }
__host__ __device__ __forceinline__ int perm32(int rho) { const int n = rho >> 4, i = rho & 15; return 8 * (i >> 2) + 4 * n + (i & 3); }

struct Unit { int pm, pn; };
struct Gemm { const bf16_t* A; const bf16_t* Bt; int M, N, K; };

struct StaticOrder {
    int nM, nN, nwg, G, c;
    __host__ __device__ void init(int M, int N, int G_, int c_) { nM = M / BM; nN = N / BM; nwg = nM * nN; G = G_; c = c_; }
    __host__ __device__ bool next(int i, Unit& u) const {
        const long L = (long)i * G + c; if (L >= nwg) return false;
        int wgid = (int)L; { const int q = nwg / NXCD, r = nwg % NXCD, xcd = wgid % NXCD, off = wgid / NXCD; wgid = (xcd < r ? xcd * (q + 1) : r * (q + 1) + (xcd - r) * q) + off; }
        const int nig = WGM * nN, gid = wgid / nig, fm = gid * WGM, gsz = (nM - fm) < WGM ? (nM - fm) : WGM;
        u.pm = fm + ((wgid % nig) % gsz); u.pn = (wgid % nig) / gsz; return true;
    }
    __device__ __forceinline__ void a_ready(const Unit&) const {}
    __device__ __forceinline__ void done(const Unit&) const {}
};

__device__ __forceinline__ unsigned cvt_pk_bf16(float lo, float hi) { unsigned r; asm volatile("v_cvt_pk_bf16_f32 %0, %1, %2" : "=v"(r) : "v"(lo), "v"(hi)); return r; }
typedef float f32x2 __attribute__((ext_vector_type(2)));
__device__ __forceinline__ f32x2 gelu_pk(f32x2 v) {
    const f32x2 av = __builtin_elementwise_abs(v), d = av * 0.2316418882f + 1.0f;
    f32x2 t; t.x = __builtin_amdgcn_rcpf(d.x); t.y = __builtin_amdgcn_rcpf(d.y);
    f32x2 q = t * 0.5307027145f + (-0.7265760135f); q = q * t + 0.7107068705f; q = q * t + (-0.142248368f); q = q * t + 0.127414796f; q = q * t;
    const f32x2 s = (v * v) * (-0.72134752044f);
    f32x2 e; e.x = __builtin_amdgcn_exp2f(s.x); e.y = __builtin_amdgcn_exp2f(s.y);
    const f32x2 m = v * (q * e), r = v - m;
    f32x2 o; o.x = v.x < 0.f ? m.x : r.x; o.y = v.y < 0.f ? m.y : r.y; return o;
}

template <int ACT  > struct EpiBf16 {
    static constexpr bool PERM = true, AFTER_DRAIN = false; static_assert(ACT == 0 || ACT == 1, "EpiBf16: ACT is 0 (none) or 1 (gelu_pk)");
    bf16_t* O; int ldc; const float* bias; int split_cols; size_t split_stride; float scale0;
    __device__ __forceinline__ void operator()(const f32x4 (&acc)[2][2][4][2], const Unit& u, int wr, int wc, int fr, int fq) const {
        const int row0 = u.pm * BM + wr * 64 + fr; int colt = u.pn * BM; bf16_t* base = O;
        float sc = 1.f; if (split_cols) { const int t = colt / split_cols; base += (size_t)t * split_stride; colt -= t * split_cols; if (t == 0) sc = scale0; }
        const int col0 = colt + wc * 32 + 8 * fq, bcol0 = u.pn * BM + wc * 32 + 8 * fq;
        f32x4 bv[2][2];
#pragma unroll
        for (int bj = 0; bj < 2; ++bj)
#pragma unroll
            for (int n = 0; n < 2; ++n) bv[bj][n] = bias ? *(const f32x4*)(bias + bcol0 + bj * HALF + 4 * n) : (f32x4){0.f, 0.f, 0.f, 0.f};
#pragma unroll
        for (int ai = 0; ai < 2; ++ai)
#pragma unroll
            for (int m = 0; m < 4; ++m) { bf16_t* rowp = base + (size_t)(row0 + ai * HALF + m * 16) * ldc + col0;
#pragma unroll
                for (int bj = 0; bj < 2; ++bj) { f32x4 v0 = acc[ai][bj][m][0] + bv[bj][0], v1 = acc[ai][bj][m][1] + bv[bj][1];
                    if (ACT == 1) { f32x2 a = gelu_pk((f32x2){v0[0], v0[1]}), b = gelu_pk((f32x2){v0[2], v0[3]}), c = gelu_pk((f32x2){v1[0], v1[1]}), d = gelu_pk((f32x2){v1[2], v1[3]});
                        v0 = (f32x4){a.x, a.y, b.x, b.y}; v1 = (f32x4){c.x, c.y, d.x, d.y}; }
                    v0 = v0 * sc; v1 = v1 * sc; u32x4 w; w.x = cvt_pk_bf16(v0[0], v0[1]); w.y = cvt_pk_bf16(v0[2], v0[3]); w.z = cvt_pk_bf16(v1[0], v1[1]); w.w = cvt_pk_bf16(v1[2], v1[3]);
                    *(u32x4*)(rowp + bj * HALF) = w; } }
    }
};

struct PanelStats {
    unsigned* xbuf;
    unsigned* cnt;
    unsigned* tmo;
    int ntn; float eps;
    unsigned code;
    __device__ __forceinline__ bool run(const f32x4 (&v)[2][2][4][2], const Unit& u, int wr, int wc, int fr, int fq, PG8_LAS unsigned char* lds, int wid, int lane) const {
        typedef float f32x2v __attribute__((ext_vector_type(2)));
        PG8_LAS f32x2v* P = (PG8_LAS f32x2v*)lds;
        PG8_LAS f32x2v* S = (PG8_LAS f32x2v*)(lds + 8192);
        PG8_LAS unsigned* flag = (PG8_LAS unsigned*)(lds + 8192 + 2048);
#pragma unroll
        for (int ai = 0; ai < 2; ++ai)
#pragma unroll
            for (int m = 0; m < 4; ++m) {
                float s = 0.f;
#pragma unroll
                for (int bj = 0; bj < 2; ++bj)
#pragma unroll
                    for (int n = 0; n < 2; ++n) { const f32x4 x = v[ai][bj][m][n]; s += (x[0] + x[1]) + (x[2] + x[3]); }
                s += __shfl_xor(s, 16); s += __shfl_xor(s, 32);
                const float mw = s * (1.0f / 64.0f); float q = 0.f;
#pragma unroll
                for (int bj = 0; bj < 2; ++bj)
#pragma unroll
                    for (int n = 0; n < 2; ++n) { const f32x4 d = v[ai][bj][m][n] - mw; q += (d[0] * d[0] + d[1] * d[1]) + (d[2] * d[2] + d[3] * d[3]); }
                q += __shfl_xor(q, 16); q += __shfl_xor(q, 32);
                if (fq == 0) P[(ai * HALF + wr * 64 + m * 16 + fr) * 4 + wc] = (f32x2v){mw, q};
            }
        asm volatile("s_waitcnt lgkmcnt(0)" ::: "memory"); __builtin_amdgcn_s_barrier(); asm volatile("" ::: "memory");
#if defined(BROKEN_EXCHANGE_NO_WAIT)
#warning BROKEN CONTROL BUILD: the row-statistics exchange does not wait; results are wrong by design
        if (blockIdx.x >= 64) { const long long t0_ = clock64(); while (clock64() - t0_ < 60000) __builtin_amdgcn_s_sleep(8); }
#endif
        const int row = wid * 32 + (lane & 31);
        if (lane < 32) {
            const f32x2v a = P[row * 4 + 0], b = P[row * 4 + 1], c = P[row * 4 + 2], d = P[row * 4 + 3];
            const float mt = (a.x + b.x + c.x + d.x) * 0.25f;
            const float da = a.x - mt, db = b.x - mt, dc = c.x - mt, dd = d.x - mt;
            const float m2 = (a.y + b.y) + (c.y + d.y) + 64.0f * ((da * da + db * db) + (dc * dc + dd * dd));
            unsigned long long* slot = (unsigned long long*)xbuf + ((size_t)(u.pm * BM + row) * 4 + u.pn);
            __hip_atomic_store(slot, ((unsigned long long)__float_as_uint(m2) << 32) | __float_as_uint(mt), __ATOMIC_RELAXED, __HIP_MEMORY_SCOPE_AGENT);
        }
        asm volatile("s_waitcnt vmcnt(0)" ::: "memory");
        if (lane == 0) __hip_atomic_fetch_add(cnt + 64 * u.pm, 1u, __ATOMIC_RELAXED, __HIP_MEMORY_SCOPE_AGENT);
        if (wid == 0) {
            bool dead = false; const unsigned long long t0 = __builtin_amdgcn_s_memrealtime(); const unsigned want = 8u * (unsigned)ntn;
            for (;;) {
#if defined(BROKEN_EXCHANGE_NO_WAIT)
                break;
#endif
                if ((unsigned)__builtin_amdgcn_readfirstlane(__hip_atomic_load(cnt + 64 * u.pm, __ATOMIC_RELAXED, __HIP_MEMORY_SCOPE_AGENT)) >= want) break;
                if (__builtin_amdgcn_s_memrealtime() - t0 > 2000000ull) {
                    if (lane == 0) { unsigned expect = 0u; __hip_atomic_compare_exchange_strong(tmo + 1, &expect, code | (unsigned)(u.pm & 0xff), __ATOMIC_RELAXED, __ATOMIC_RELAXED, __HIP_MEMORY_SCOPE_AGENT);
                                     __hip_atomic_store(tmo, 1u, __ATOMIC_RELAXED, __HIP_MEMORY_SCOPE_AGENT); }
                    dead = true; break; }
                __builtin_amdgcn_s_sleep(2);
            }
            __builtin_amdgcn_fence(__ATOMIC_ACQUIRE, "agent");
            if (lane == 0) flag[0] = dead ? 1u : 0u;
        }
        asm volatile("s_waitcnt vmcnt(0) lgkmcnt(0)" ::: "memory"); __builtin_amdgcn_s_barrier(); asm volatile("" ::: "memory");
        const bool bad = flag[0] != 0u;
        if (lane < 32) {
            const unsigned long long* slot = (const unsigned long long*)xbuf + (size_t)(u.pm * BM + row) * 4; float mt[4], m2[4]; float ms = 0.f;
#pragma unroll
            for (int t = 0; t < 4; ++t) { if (t < ntn) { const unsigned long long w = __hip_atomic_load(slot + t, __ATOMIC_RELAXED, __HIP_MEMORY_SCOPE_AGENT); mt[t] = __uint_as_float((unsigned)w); m2[t] = __uint_as_float((unsigned)(w >> 32)); } else { mt[t] = 0.f; m2[t] = 0.f; } ms += mt[t]; }
            const float mean = ms / (float)ntn; float q = 0.f;
#pragma unroll
            for (int t = 0; t < 4; ++t) if (t < ntn) { const float dm = mt[t] - mean; q += m2[t] + 256.0f * dm * dm; }
            S[row] = (f32x2v){mean, 1.0f / sqrtf(q / (256.0f * (float)ntn) + eps)};
        }
        asm volatile("s_waitcnt lgkmcnt(0)" ::: "memory"); __builtin_amdgcn_s_barrier(); asm volatile("" ::: "memory");
        return bad;
    }
};
struct EpiLnRes {
    static constexpr bool PERM = false, AFTER_DRAIN = true;
    const float* base; float* out; int ldc; const float* bias; PanelStats st; unsigned poison;
    __device__ __forceinline__ void fused(f32x4 (&acc)[2][2][4][2], const Unit& u, int wr, int wc, int fr, int fq, PG8_LAS unsigned char* lds, int wid, int lane) const {
        typedef float f32x2v __attribute__((ext_vector_type(2)));
        const PG8_LAS f32x2v* S = (const PG8_LAS f32x2v*)(lds + 8192);
        const int col0 = u.pn * BM + wc * 32 + 4 * fq;
#pragma unroll
        for (int bj = 0; bj < 2; ++bj)
#pragma unroll
            for (int n = 0; n < 2; ++n) { const f32x4 bv = bias ? *(const f32x4*)(bias + col0 + bj * HALF + n * 16) : (f32x4){0.f, 0.f, 0.f, 0.f};
#pragma unroll
                for (int ai = 0; ai < 2; ++ai)
#pragma unroll
                    for (int m = 0; m < 4; ++m) acc[ai][bj][m][n] += bv; }
        f32x4 pre[4][2][2];
#pragma unroll
        for (int m = 0; m < 4; ++m) { const size_t off = (size_t)(u.pm * BM + wr * 64 + m * 16 + fr) * ldc + col0;
#pragma unroll
            for (int bj = 0; bj < 2; ++bj)
#pragma unroll
                for (int n = 0; n < 2; ++n) pre[m][bj][n] = *(const f32x4*)(base + off + bj * HALF + n * 16); }
        const bool bad = st.run(acc, u, wr, wc, fr, fq, lds, wid, lane) || poison != 0u;
        const float qnan = __builtin_nanf("");
#pragma unroll
        for (int ai = 0; ai < 2; ++ai)
#pragma unroll
            for (int m = 0; m < 4; ++m) { const int r = ai * HALF + wr * 64 + m * 16 + fr; const f32x2v sr = S[r]; const size_t off = (size_t)(u.pm * BM + r) * ldc + col0;
#pragma unroll
                for (int bj = 0; bj < 2; ++bj)
#pragma unroll
                    for (int n = 0; n < 2; ++n) { const f32x4 bs = ai == 0 ? pre[m][bj][n] : *(const f32x4*)(base + off + bj * HALF + n * 16); f32x4 o = bs + (acc[ai][bj][m][n] - sr.x) * sr.y;
                        if (bad) o = (f32x4){qnan, qnan, qnan, qnan}; *(f32x4*)(out + off + bj * HALF + n * 16) = o; }
                if (m & 1) asm volatile("" ::: "memory"); }
    }
};
struct EpiLnResLn {
    static constexpr bool PERM = false, AFTER_DRAIN = true;
    const float* base; float* out; bf16_t* xn; int ldc; const float* bias; PanelStats st1, st2; unsigned poison;
    __device__ __forceinline__ void fused(f32x4 (&acc)[2][2][4][2], const Unit& u, int wr, int wc, int fr, int fq, PG8_LAS unsigned char* lds, int wid, int lane) const {
        typedef float f32x2v __attribute__((ext_vector_type(2))); typedef unsigned u32x2v __attribute__((ext_vector_type(2)));
        const PG8_LAS f32x2v* S = (const PG8_LAS f32x2v*)(lds + 8192);
        const int col0 = u.pn * BM + wc * 32 + 4 * fq;
#pragma unroll
        for (int bj = 0; bj < 2; ++bj)
#pragma unroll
            for (int n = 0; n < 2; ++n) { const f32x4 bv = bias ? *(const f32x4*)(bias + col0 + bj * HALF + n * 16) : (f32x4){0.f, 0.f, 0.f, 0.f};
#pragma unroll
                for (int ai = 0; ai < 2; ++ai)
#pragma unroll
                    for (int m = 0; m < 4; ++m) acc[ai][bj][m][n] += bv; }
        bool bad = st1.run(acc, u, wr, wc, fr, fq, lds, wid, lane) || poison != 0u;
        const float qnan = __builtin_nanf("");
#pragma unroll
        for (int ai = 0; ai < 2; ++ai)
#pragma unroll
            for (int m = 0; m < 4; ++m) { const int r = ai * HALF + wr * 64 + m * 16 + fr; const f32x2v sr = S[r]; const size_t off = (size_t)(u.pm * BM + r) * ldc + col0;
#pragma unroll
                for (int bj = 0; bj < 2; ++bj)
#pragma unroll
                    for (int n = 0; n < 2; ++n) { const f32x4 bs = *(const f32x4*)(base + off + bj * HALF + n * 16); acc[ai][bj][m][n] = bs + (acc[ai][bj][m][n] - sr.x) * sr.y; }
                asm volatile("" : "+v"(acc[ai][0][m][0]), "+v"(acc[ai][0][m][1]), "+v"(acc[ai][1][m][0]), "+v"(acc[ai][1][m][1]));
                if (m & 1) asm volatile("" ::: "memory"); }
        const bool bad1 = bad;
        bad = st2.run(acc, u, wr, wc, fr, fq, lds, wid, lane) || bad;
#pragma unroll
        for (int ai = 0; ai < 2; ++ai)
#pragma unroll
            for (int m = 0; m < 4; ++m) { const int r = ai * HALF + wr * 64 + m * 16 + fr; const f32x2v sr = S[r]; const size_t off = (size_t)(u.pm * BM + r) * ldc + col0;
#pragma unroll
                for (int bj = 0; bj < 2; ++bj)
#pragma unroll
                    for (int n = 0; n < 2; ++n) { const f32x4 x1 = acc[ai][bj][m][n]; *(f32x4*)(out + off + bj * HALF + n * 16) = bad1 ? (f32x4){qnan, qnan, qnan, qnan} : x1;
                        const f32x4 o = (x1 - sr.x) * sr.y; u32x2v w; w.x = cvt_pk_bf16(o[0], o[1]); w.y = cvt_pk_bf16(o[2], o[3]);
                        if (bad) { w.x = 0x7fc07fc0u; w.y = 0x7fc07fc0u; } *(u32x2v*)(xn + off + bj * HALF + n * 16) = w; }
                asm volatile("" ::: "memory"); }
    }
};

template <class Epi, class Sched, bool ALIGN_EPI = false, bool SP2 = false>
__device__ __forceinline__ void gemm_phase(PG8_LAS unsigned char* lds, const Gemm g, const Sched& S, const Epi& E) {
    const int tid = threadIdx.x, wid = __builtin_amdgcn_readfirstlane(tid >> 6), lane = tid & 63, wr = wid >> 2, wc = wid & 3, fr = lane & 15, fq = lane >> 4;
    const int K = g.K, nt = K / BK;
    unsigned voffA[2], voffB[2];
#pragma unroll
    for (int i = 0; i < 2; ++i) { int R, C; stage_rc(tid * 16 + i * 8192, R, C); const int Rb = Epi::PERM ? ((R & ~31) + perm32(R & 31)) : R;
        voffA[i] = (unsigned)(R * K + C) * 2u; voffB[i] = (unsigned)(Rb * K + C) * 2u; }
    const size_t kstep = (size_t)(BK * 2);
    const size_t hstep = (size_t)HALF * K * 2;
    const size_t tstep = 2 * hstep;
    const unsigned ldsw = (unsigned)wid * 1024u;
    const int aoff = lds_byte(wr * 64 + fr, fq * 8), boff = lds_byte(wc * 32 + fr, fq * 8);
#define PG8_SA(b, h) (((b) * 2 + (h)) * HTB)
#define PG8_SB(b, h) ((4 + (b) * 2 + (h)) * HTB)
#define PG8_STAGE(bufoff, gbase, voff) do { _Pragma("unroll") for (int _i = 0; _i < 2; ++_i) \
        __builtin_amdgcn_global_load_lds((const unsigned*)((const char*)(gbase) + (voff)[_i]), (PG8_LAS unsigned*)(lds + (bufoff) + ldsw + _i * 8192), 16, 0, 0); } while (0)
#define PG8_LDA(dst, b, h) do { _Pragma("unroll") for (int m = 0; m < 4; ++m) _Pragma("unroll") for (int k = 0; k < 2; ++k) dst[m][k] = *(const PG8_LAS bf16x8*)(lds + PG8_SA(b, h) + aoff + m * 2048 + k * 1024); } while (0)
#define PG8_LDB(dst, b, h) do { _Pragma("unroll") for (int n = 0; n < 2; ++n) _Pragma("unroll") for (int k = 0; k < 2; ++k) dst[n][k] = *(const PG8_LAS bf16x8*)(lds + PG8_SB(b, h) + boff + n * 2048 + k * 1024); } while (0)
#define PG8_MMA(ai, bj, At, Bt) do { __builtin_amdgcn_s_setprio(1); _Pragma("unroll") for (int m = 0; m < 4; ++m) _Pragma("unroll") for (int n = 0; n < 2; ++n) _Pragma("unroll") for (int k = 0; k < 2; ++k) \
        acc[ai][bj][m][n] = __builtin_amdgcn_mfma_f32_16x16x32_bf16(Bt[n][k], At[m][k], acc[ai][bj][m][n], 0, 0, 0); __builtin_amdgcn_s_setprio(0); } while (0)
#define PG8_WAIT_V(n) asm volatile("s_waitcnt vmcnt(" #n ")" ::: "memory")
#define PG8_WAIT_L(n) asm volatile("s_waitcnt lgkmcnt(" #n ")" ::: "memory")
#define PG8_BAR __builtin_amdgcn_s_barrier()
#define PG8_SCHED __builtin_amdgcn_sched_barrier(0)
    Unit cur, nxt; int ui = 0;
    if (!S.next(0, cur)) return;
    f32x4 acc[2][2][4][2];
#pragma unroll
    for (int a = 0; a < 2; ++a)
#pragma unroll
        for (int b = 0; b < 2; ++b)
#pragma unroll
            for (int m = 0; m < 4; ++m)
#pragma unroll
                for (int n = 0; n < 2; ++n) acc[a][b][m][n] = (f32x4){0.f, 0.f, 0.f, 0.f};
    bf16x8 At[4][2], B0[2][2], B1[2][2];
    const char* cA = (const char*)g.A + (size_t)cur.pm * tstep; const char* cB = (const char*)g.Bt + (size_t)cur.pn * tstep;
    S.a_ready(cur);
    if constexpr (SP2) {
        PG8_STAGE(PG8_SB(0, 0), cB, voffB); PG8_STAGE(PG8_SB(0, 1), cB + hstep, voffB); PG8_STAGE(PG8_SA(0, 0), cA, voffA); PG8_STAGE(PG8_SA(0, 1), cA + hstep, voffA);
        if (wr == 1) PG8_BAR;
        PG8_WAIT_V(2); PG8_BAR;
        PG8_STAGE(PG8_SB(1, 0), cB + kstep, voffB); PG8_STAGE(PG8_SA(1, 0), cA + kstep, voffA); PG8_STAGE(PG8_SB(1, 1), cB + hstep + kstep, voffB);
        PG8_WAIT_V(6); PG8_BAR;
    } else {
        PG8_STAGE(PG8_SB(0, 0), cB, voffB); PG8_STAGE(PG8_SA(0, 0), cA, voffA); PG8_STAGE(PG8_SB(0, 1), cB + hstep, voffB); PG8_STAGE(PG8_SA(0, 1), cA + hstep, voffA);
        if (wr == 1) PG8_BAR;
        PG8_WAIT_V(4); PG8_BAR;
        PG8_STAGE(PG8_SB(1, 0), cB + kstep, voffB); PG8_STAGE(PG8_SA(1, 0), cA + kstep, voffA); PG8_STAGE(PG8_SB(1, 1), cB + hstep + kstep, voffB);
        PG8_WAIT_V(6); PG8_BAR;
    }
    for (;;) {
        const bool has_next = S.next(ui + 1, nxt);
        const char* nA = has_next ? (const char*)g.A + (size_t)nxt.pm * tstep : cA; const char* nB = has_next ? (const char*)g.Bt + (size_t)nxt.pn * tstep : cB;
#pragma unroll 1
        for (int t = 0; t < nt; t += 2) {
            const bool last = (t == nt - 2);
            const char* a1 = cA + (size_t)(t + 1) * kstep;
            const char* a2 = last ? nA : cA + (size_t)(t + 2) * kstep; const char* b2 = last ? nB : cB + (size_t)(t + 2) * kstep;
            const char* a3 = a2 + kstep; const char* b3 = b2 + kstep;
            if (last && has_next) S.a_ready(nxt);
            if constexpr (SP2) {
            PG8_LDB(B0, 0, 0); PG8_LDB(B1, 0, 1); PG8_SCHED; PG8_LDA(At, 0, 0); PG8_STAGE(PG8_SA(1, 1), a1 + hstep, voffA);
            PG8_WAIT_V(8); PG8_WAIT_L(0); PG8_BAR; PG8_MMA(0, 0, At, B0); PG8_MMA(0, 1, At, B1); PG8_BAR; PG8_SCHED;
            PG8_LDA(At, 0, 1); PG8_STAGE(PG8_SB(0, 0), b2, voffB); PG8_STAGE(PG8_SB(0, 1), b2 + hstep, voffB); PG8_STAGE(PG8_SA(0, 0), a2, voffA);
            PG8_WAIT_V(8); PG8_WAIT_L(0); PG8_BAR; PG8_MMA(1, 0, At, B0); PG8_MMA(1, 1, At, B1); PG8_BAR; PG8_SCHED;
            PG8_LDB(B0, 1, 0); PG8_LDB(B1, 1, 1); PG8_SCHED; PG8_LDA(At, 1, 0); PG8_STAGE(PG8_SA(0, 1), a2 + hstep, voffA);
            PG8_WAIT_V(8); PG8_WAIT_L(0); PG8_BAR; PG8_MMA(0, 0, At, B0); PG8_MMA(0, 1, At, B1); PG8_BAR; PG8_SCHED;
            PG8_LDA(At, 1, 1); PG8_STAGE(PG8_SB(1, 0), b3, voffB); PG8_STAGE(PG8_SB(1, 1), b3 + hstep, voffB); PG8_STAGE(PG8_SA(1, 0), a3, voffA);
            PG8_WAIT_V(8); PG8_WAIT_L(0); PG8_BAR; PG8_MMA(1, 0, At, B0); PG8_MMA(1, 1, At, B1); PG8_BAR; PG8_SCHED;
            } else {
            PG8_LDB(B0, 0, 0); PG8_SCHED; PG8_LDA(At, 0, 0); PG8_STAGE(PG8_SA(1, 1), a1 + hstep, voffA);
            PG8_WAIT_L(8); PG8_BAR; PG8_WAIT_L(0); PG8_MMA(0, 0, At, B0); PG8_BAR; PG8_SCHED;
            PG8_LDB(B1, 0, 1); PG8_STAGE(PG8_SB(0, 0), b2, voffB);
            PG8_BAR; PG8_WAIT_L(0); PG8_MMA(0, 1, At, B1); PG8_BAR;
            PG8_LDA(At, 0, 1); PG8_STAGE(PG8_SA(0, 0), a2, voffA);
            PG8_BAR; PG8_WAIT_L(0); PG8_MMA(1, 0, At, B0); PG8_BAR; PG8_SCHED;
            PG8_STAGE(PG8_SB(0, 1), b2 + hstep, voffB);
            PG8_WAIT_V(6); PG8_BAR; PG8_MMA(1, 1, At, B1); PG8_BAR;
            PG8_LDB(B0, 1, 0); PG8_SCHED; PG8_LDA(At, 1, 0); PG8_STAGE(PG8_SA(0, 1), a2 + hstep, voffA);
            PG8_WAIT_L(8); PG8_BAR; PG8_WAIT_L(0); PG8_MMA(0, 0, At, B0); PG8_BAR; PG8_SCHED;
            PG8_LDB(B1, 1, 1); PG8_STAGE(PG8_SB(1, 0), b3, voffB);
            PG8_BAR; PG8_WAIT_L(0); PG8_MMA(0, 1, At, B1); PG8_BAR;
            PG8_LDA(At, 1, 1); PG8_STAGE(PG8_SA(1, 0), a3, voffA);
            PG8_BAR; PG8_WAIT_L(0); PG8_MMA(1, 0, At, B0); PG8_BAR; PG8_SCHED;
            PG8_STAGE(PG8_SB(1, 1), b3 + hstep, voffB);
            PG8_WAIT_V(6); PG8_BAR; PG8_MMA(1, 1, At, B1); PG8_BAR;
            }
        }
        if constexpr (ALIGN_EPI) { if (wr == 0) PG8_BAR; }
        if constexpr (!Epi::AFTER_DRAIN) { E(acc, cur, wr, wc, fr, fq); S.done(cur); }
        if (!has_next) break;
#pragma unroll
        for (int a = 0; a < 2; ++a)
#pragma unroll
            for (int b = 0; b < 2; ++b)
#pragma unroll
                for (int m = 0; m < 4; ++m)
#pragma unroll
                    for (int n = 0; n < 2; ++n) acc[a][b][m][n] = (f32x4){0.f, 0.f, 0.f, 0.f};
        cur = nxt; cA = nA; cB = nB; ++ui;
        if constexpr (ALIGN_EPI) { if (wr == 1) PG8_BAR; }
    }
    PG8_WAIT_V(0);
    if constexpr (!ALIGN_EPI) { if (wr == 0) PG8_BAR; }
    PG8_BAR;
    if constexpr (Epi::AFTER_DRAIN) { E.fused(acc, cur, wr, wc, fr, fq, lds, wid, lane); S.done(cur); }
#undef PG8_SA
#undef PG8_SB
#undef PG8_STAGE
#undef PG8_LDA
#undef PG8_LDB
#undef PG8_MMA
#undef PG8_WAIT_V
#undef PG8_WAIT_L
#undef PG8_BAR
#undef PG8_SCHED
}
}
namespace pg8 {
struct TileDst { bf16_t* base; int ldc; float scale; const float* bias; };

template <class Map> struct EpiBf16Map {
    static constexpr bool PERM = true, AFTER_DRAIN = false;
    Map map;
    __device__ __forceinline__ void operator()(const f32x4 (&acc)[2][2][4][2], const Unit& u, int wr, int wc, int fr, int fq) const {
        const TileDst d = map(u);
        const int row0 = wr * 64 + fr, col0 = wc * 32 + 8 * fq;
        f32x4 bv[2][2];
#pragma unroll
        for (int bj = 0; bj < 2; ++bj)
#pragma unroll
            for (int n = 0; n < 2; ++n) bv[bj][n] = d.bias ? *(const f32x4*)(d.bias + col0 + bj * HALF + 4 * n) : (f32x4){0.f, 0.f, 0.f, 0.f};
#pragma unroll
        for (int ai = 0; ai < 2; ++ai)
#pragma unroll
            for (int m = 0; m < 4; ++m) { bf16_t* rowp = d.base + (size_t)(row0 + ai * HALF + m * 16) * d.ldc + col0;
#pragma unroll
                for (int bj = 0; bj < 2; ++bj) { f32x4 v0 = (acc[ai][bj][m][0] + bv[bj][0]) * d.scale, v1 = (acc[ai][bj][m][1] + bv[bj][1]) * d.scale;
                    u32x4 w; w.x = cvt_pk_bf16(v0[0], v0[1]); w.y = cvt_pk_bf16(v0[2], v0[3]); w.z = cvt_pk_bf16(v1[0], v1[1]); w.w = cvt_pk_bf16(v1[2], v1[3]);
                    *(u32x4*)(rowp + bj * HALF) = w; } }
    }
};

struct EpiSwiglu {
    static constexpr bool PERM = true, AFTER_DRAIN = false;
    bf16_t* H; const float* bg; const float* bu;
    __device__ __forceinline__ void operator()(const f32x4 (&acc)[2][2][4][2], const Unit& u, int wr, int wc, int fr, int fq) const {
        const int e = u.pn >> 3, pnl = u.pn & 7;
        const int row0 = u.pm * BM + wr * 64 + fr, col0 = pnl * 128 + wc * 32 + 8 * fq;
        f32x4 g0 = *(const f32x4*)(bg + e * 1024 + col0), g1 = *(const f32x4*)(bg + e * 1024 + col0 + 4);
        f32x4 u0 = *(const f32x4*)(bu + e * 1024 + col0), u1 = *(const f32x4*)(bu + e * 1024 + col0 + 4);
#pragma unroll
        for (int ai = 0; ai < 2; ++ai)
#pragma unroll
            for (int m = 0; m < 4; ++m) {
                float r[8];
#pragma unroll
                for (int n = 0; n < 2; ++n)
#pragma unroll
                    for (int j = 0; j < 4; ++j) {
                        float hg = acc[ai][0][m][n][j] + (n ? g1[j] : g0[j]);
                        float hl = acc[ai][1][m][n][j] + (n ? u1[j] : u0[j]);
                        hg = fminf(hg, 7.0f); hl = fminf(fmaxf(hl, -7.0f), 7.0f);
                        const float sg = 1.0f / (1.0f + __expf(-1.702f * hg));
                        r[n * 4 + j] = hg * sg * (hl + 1.0f);
                    }
                u32x4 w; w.x = cvt_pk_bf16(r[0], r[1]); w.y = cvt_pk_bf16(r[2], r[3]); w.z = cvt_pk_bf16(r[4], r[5]); w.w = cvt_pk_bf16(r[6], r[7]);
                *(u32x4*)(H + (size_t)(row0 + ai * HALF + m * 16) * 1024 + col0) = w;
            }
    }
};

struct EpiF32Res {
    static constexpr bool PERM = false, AFTER_DRAIN = false;
    const float* base; float* out; float alpha;
    __device__ __forceinline__ void operator()(const f32x4 (&acc)[2][2][4][2], const Unit& u, int wr, int wc, int fr, int fq) const {
        const int col0 = (u.pn & 3) * BM + wc * 32 + 4 * fq;
#pragma unroll
        for (int ai = 0; ai < 2; ++ai)
#pragma unroll
            for (int m = 0; m < 4; ++m) { const size_t off = (size_t)(u.pm * BM + ai * HALF + wr * 64 + m * 16 + fr) * 1024 + col0;
#pragma unroll
                for (int bj = 0; bj < 2; ++bj)
#pragma unroll
                    for (int n = 0; n < 2; ++n) { const f32x4 bs = *(const f32x4*)(base + off + bj * HALF + n * 16);
                        *(f32x4*)(out + off + bj * HALF + n * 16) = bs * alpha + acc[ai][bj][m][n]; } }
    }
};

struct EpiSoftmax {
    static constexpr bool PERM = true, AFTER_DRAIN = true;
    bf16_t* P;
    __device__ __forceinline__ void fused(f32x4 (&acc)[2][2][4][2], const Unit& u, int wr, int wc, int fr, int fq, PG8_LAS unsigned char* lds, int wid, int lane) const {
        PG8_LAS float* X = (PG8_LAS float*)lds;
        PG8_LAS float* Y = (PG8_LAS float*)(lds + 4096);
#pragma unroll
        for (int ai = 0; ai < 2; ++ai)
#pragma unroll
            for (int m = 0; m < 4; ++m) {
                float mx = -INFINITY;
#pragma unroll
                for (int bj = 0; bj < 2; ++bj)
#pragma unroll
                    for (int n = 0; n < 2; ++n) { const f32x4 x = acc[ai][bj][m][n]; mx = fmaxf(mx, fmaxf(fmaxf(x[0], x[1]), fmaxf(x[2], x[3]))); }
                mx = fmaxf(mx, __shfl_xor(mx, 16)); mx = fmaxf(mx, __shfl_xor(mx, 32));
                if (fq == 0) X[(ai * HALF + wr * 64 + m * 16 + fr) * 4 + wc] = mx;
            }
        asm volatile("s_waitcnt lgkmcnt(0)" ::: "memory"); __builtin_amdgcn_s_barrier(); asm volatile("" ::: "memory");
#pragma unroll
        for (int ai = 0; ai < 2; ++ai)
#pragma unroll
            for (int m = 0; m < 4; ++m) {
                const int r = ai * HALF + wr * 64 + m * 16 + fr;
                const f32x4 q = *(const PG8_LAS f32x4*)(X + r * 4);
                const float mx = fmaxf(fmaxf(q[0], q[1]), fmaxf(q[2], q[3]));
                float s = 0.f;
#pragma unroll
                for (int bj = 0; bj < 2; ++bj)
#pragma unroll
                    for (int n = 0; n < 2; ++n) { f32x4 x = acc[ai][bj][m][n];
                        x[0] = __builtin_amdgcn_exp2f(x[0] - mx); x[1] = __builtin_amdgcn_exp2f(x[1] - mx); x[2] = __builtin_amdgcn_exp2f(x[2] - mx); x[3] = __builtin_amdgcn_exp2f(x[3] - mx);
                        acc[ai][bj][m][n] = x; s += (x[0] + x[1]) + (x[2] + x[3]); }
                s += __shfl_xor(s, 16); s += __shfl_xor(s, 32);
                if (fq == 0) Y[r * 4 + wc] = s;
            }
        asm volatile("s_waitcnt lgkmcnt(0)" ::: "memory"); __builtin_amdgcn_s_barrier(); asm volatile("" ::: "memory");
        const int col0 = (u.pn & 3) * BM + wc * 32 + 8 * fq;
#pragma unroll
        for (int ai = 0; ai < 2; ++ai)
#pragma unroll
            for (int m = 0; m < 4; ++m) {
                const int r = ai * HALF + wr * 64 + m * 16 + fr;
                const f32x4 q = *(const PG8_LAS f32x4*)(Y + r * 4);
                const float inv = 1.0f / ((q[0] + q[1]) + (q[2] + q[3]));
                bf16_t* rowp = P + (size_t)(u.pm * BM + r) * 1024 + col0;
#pragma unroll
                for (int bj = 0; bj < 2; ++bj) { const f32x4 v0 = acc[ai][bj][m][0] * inv, v1 = acc[ai][bj][m][1] * inv;
                    u32x4 w; w.x = cvt_pk_bf16(v0[0], v0[1]); w.y = cvt_pk_bf16(v0[2], v0[3]); w.z = cvt_pk_bf16(v1[0], v1[1]); w.w = cvt_pk_bf16(v1[2], v1[3]);
                    *(u32x4*)(rowp + bj * HALF) = w; }
            }
        asm volatile("s_waitcnt lgkmcnt(0)" ::: "memory"); __builtin_amdgcn_s_barrier(); asm volatile("" ::: "memory");
    }
};

struct BatchOrder {
    StaticOrder so;
    __device__ void init(int M, int N, int G_, int c_) { so.init(M, N, G_, c_); }
    __device__ bool next(int i, Unit& u) const { if (!so.next(i, u)) return false; u.pn += (u.pm >> 5) * 4; return true; }
    __device__ __forceinline__ void a_ready(const Unit&) const {}
    __device__ __forceinline__ void done(const Unit&) const {}
};
struct WqkOrder {
    int G, c;
    __device__ bool next(int i, Unit& u) const { const int L = i * G + c; if (L >= 32) return false; const int b = L >> 4, h = (L >> 2) & 3, kt = L & 3; u.pm = b * 4 + h; u.pn = h * 4 + kt; return true; }
    __device__ __forceinline__ void a_ready(const Unit&) const {}
    __device__ __forceinline__ void done(const Unit&) const {}
};
struct VwoOrder {
    int G, c;
    __device__ bool next(int i, Unit& u) const { const int L = i * G + c; if (L >= 32) return false; const int b = L >> 4, h = (L >> 2) & 3, nt = L & 3; u.pm = h * 4 + nt; u.pn = b * 4 + h; return true; }
    __device__ __forceinline__ void a_ready(const Unit&) const {}
    __device__ __forceinline__ void done(const Unit&) const {}
};
struct MoeOrder {
    int G, c, nN, n_mt; const PG8_LAS int* tile_e;
    __device__ bool next(int i, Unit& u) const { const int L = i * G + c; const int pm = L / nN; if (pm >= n_mt) return false; const int e = __builtin_amdgcn_readfirstlane(tile_e[pm]); u.pm = pm; u.pn = e * nN + (L % nN); return true; }
    __device__ __forceinline__ void a_ready(const Unit&) const {}
    __device__ __forceinline__ void done(const Unit&) const {}
};
}
#include <hip/hip_bf16.h>
#include <cmath>
namespace attn_body {
using bf16=__hip_bfloat16;
using bf16x8=__attribute__((ext_vector_type(8)))short;
using s16x4=__attribute__((ext_vector_type(4)))short;
using f32x16=__attribute__((ext_vector_type(16)))float;
using u32x4=__attribute__((ext_vector_type(4)))unsigned;
constexpr int BATCH=2,NHEAD=16,SEQ=8192,D=64,DM=NHEAD*D;
constexpr int PQKV=512;
constexpr int NW=8,QBLK=32,QB=QBLK*NW,KVBLK=64,NQB=SEQ/QB;
constexpr int ATTN_PITCH=DM, ATTN_UNIT_ROWS=QB;
__device__ __forceinline__ int crow(int r,int hi){return (r&3)+8*(r>>2)+4*hi;}
#define SBAR() __builtin_amdgcn_sched_barrier(0)
__device__ __forceinline__ void cmask(f32x16&p0,f32x16&p1,int jb,int qrel,int hi){
  const float NEG=-INFINITY; int kb=64*jb+4*hi;
  #pragma unroll
  for(int r=0;r<16;++r){int kv=kb+(r&3)+8*(r>>2); if(kv>qrel)p0[r]=NEG; if(kv+32>qrel)p1[r]=NEG;}
}

constexpr int NSLOT=3, SLOTB=8192;
constexpr int LDS_K=0, LDS_V=NSLOT*SLOTB, LDS_WS=2*NSLOT*SLOTB, LDS_OST=LDS_WS+NW*64*4, LDS_BYTES=LDS_OST+NW*4096;
constexpr float C2=0.125f*1.4426950408889634f;
__device__ __forceinline__ void glds16(const void*gsrc,unsigned lds_dst){unsigned keep;
  asm volatile("s_mov_b32 %0, m0\n\ts_mov_b32 m0, %2\n\ts_nop 0\n\tglobal_load_lds_dwordx4 %1, off\n\ts_mov_b32 m0, %0":"=&s"(keep):"v"(gsrc),"s"(lds_dst):"memory");}
__device__ __forceinline__ float max3f(float a,float b,float c){float r;asm("v_max3_f32 %0, %1, %2, %3":"=v"(r):"v"(a),"v"(b),"v"(c));return r;}
__device__ __forceinline__ float max2f(float a,float b){float r;asm("v_max_f32_e32 %0, %1, %2":"=v"(r):"v"(a),"v"(b));return r;}
__device__ __forceinline__ float fadd_s(float a,float b){float r;asm("v_add_f32_e32 %0, %1, %2":"=v"(r):"v"(a),"v"(b));return r;}
__device__ __forceinline__ float fsub_s(float a,float b){float r;asm("v_sub_f32_e32 %0, %1, %2":"=v"(r):"v"(a),"v"(b));return r;}
typedef float f32x2_t __attribute__((ext_vector_type(2))); typedef __bf16 bf16x2_t __attribute__((ext_vector_type(2)));
__device__ __forceinline__ unsigned cvtpk_s(float lo,float hi){f32x2_t v={lo,hi};bf16x2_t b=__builtin_convertvector(v,bf16x2_t);return __builtin_bit_cast(unsigned,b);}
#define WAIT_BAR(N) asm volatile("s_waitcnt vmcnt(" #N ") lgkmcnt(0)\n\ts_barrier":::"memory")

__device__ __forceinline__ void qkt(f32x16&p0,f32x16&p1,const char*Kslot,const bf16x8*qr,const f32x16&negm,int r32,int hi){
  const char*kb=Kslot+hi*1024+r32*16;
  #pragma unroll
  for(int d0=0;d0<4;++d0){
    const bf16x8 b0=*reinterpret_cast<const bf16x8*>(kb+d0*2048);
    const bf16x8 b1=*reinterpret_cast<const bf16x8*>(kb+d0*2048+512);
    if(d0==0){p0=__builtin_amdgcn_mfma_f32_32x32x16_bf16(b0,qr[0],negm,0,0,0);p1=__builtin_amdgcn_mfma_f32_32x32x16_bf16(b1,qr[0],negm,0,0,0);}
    else{p0=__builtin_amdgcn_mfma_f32_32x32x16_bf16(b0,qr[d0],p0,0,0,0);p1=__builtin_amdgcn_mfma_f32_32x32x16_bf16(b1,qr[d0],p1,0,0,0);}}
}
typedef __attribute__((address_space(3))) const char* lds_cptr;
typedef short v4i16_t __attribute__((ext_vector_type(4)));
__device__ __forceinline__ void kload8(bf16x8*kf,lds_cptr kp){
  kf[0]=*(const __attribute__((address_space(3))) bf16x8*)(kp);      kf[1]=*(const __attribute__((address_space(3))) bf16x8*)(kp+512);
  kf[2]=*(const __attribute__((address_space(3))) bf16x8*)(kp+2048); kf[3]=*(const __attribute__((address_space(3))) bf16x8*)(kp+2560);
  kf[4]=*(const __attribute__((address_space(3))) bf16x8*)(kp+4096); kf[5]=*(const __attribute__((address_space(3))) bf16x8*)(kp+4608);
  kf[6]=*(const __attribute__((address_space(3))) bf16x8*)(kp+6144); kf[7]=*(const __attribute__((address_space(3))) bf16x8*)(kp+6656);
}
__device__ __forceinline__ void kload2(bf16x8*kf,lds_cptr kp,int j){ kf[2*j]=*(const __attribute__((address_space(3))) bf16x8*)(kp+j*2048); kf[2*j+1]=*(const __attribute__((address_space(3))) bf16x8*)(kp+j*2048+512); }
__device__ __forceinline__ s16x4 vtr(lds_cptr p){ return __builtin_bit_cast(s16x4,__builtin_amdgcn_ds_read_tr16_b64_v4i16((__attribute__((address_space(3))) v4i16_t*)p)); }
__device__ __forceinline__ float rowmax(const f32x16&p0,const f32x16&p1){
  float a=max3f(p0[0],p0[1],p1[0]),b=max3f(p0[2],p0[3],p1[1]);a=max3f(a,p1[2],p1[3]);
  #pragma unroll
  for(int r=4;r<16;r+=4){a=max3f(a,p0[r],p0[r+1]);b=max3f(b,p0[r+2],p0[r+3]);a=max3f(a,p1[r],p1[r+1]);b=max3f(b,p1[r+2],p1[r+3]);}
  const float m=max2f(a,b);
  auto rr=__builtin_amdgcn_permlane32_swap(__float_as_uint(m),__float_as_uint(m),false,false);
  return max2f(__uint_as_float(rr[0]),__uint_as_float(rr[1]));
}
__device__ __forceinline__ void pv(f32x16*o,int vb,bf16x8 pa0,bf16x8 pa1,bf16x8 pa2,bf16x8 pa3){
  #pragma unroll
  for(int d0=0;d0<2;++d0){s16x4 lo[4],hi[4];
    #pragma unroll
    for(int ks=0;ks<4;++ks){
      asm volatile("ds_read_b64_tr_b16 %0,%1 offset:%c2":"=&v"(lo[ks]):"v"(vb),"i"(d0*4096+ks*1024):"memory");
      asm volatile("ds_read_b64_tr_b16 %0,%1 offset:%c2":"=&v"(hi[ks]):"v"(vb),"i"(d0*4096+ks*1024+512):"memory");}
    asm volatile("s_waitcnt lgkmcnt(0)":::"memory");SBAR();
    #define PK(k) (bf16x8){lo[k][0],lo[k][1],lo[k][2],lo[k][3],hi[k][0],hi[k][1],hi[k][2],hi[k][3]}
    o[d0]=__builtin_amdgcn_mfma_f32_32x32x16_bf16(pa0,PK(0),o[d0],0,0,0);
    o[d0]=__builtin_amdgcn_mfma_f32_32x32x16_bf16(pa1,PK(1),o[d0],0,0,0);
    o[d0]=__builtin_amdgcn_mfma_f32_32x32x16_bf16(pa2,PK(2),o[d0],0,0,0);
    o[d0]=__builtin_amdgcn_mfma_f32_32x32x16_bf16(pa3,PK(3),o[d0],0,0,0);
    #undef PK
  }
}

#ifndef ATTN_STORE16
#define ATTN_STORE16(p,v) (*(u32x4*)(p)=(v))
#endif
template<int THRL> __device__ __forceinline__ void attn_unit(int b,int h,int qb,const bf16*Q,const bf16*__restrict__ K,const bf16*__restrict__ V,bf16*O,char*shm){
  const int tid=threadIdx.x,lane=tid&63,r32=lane&31,hi=lane>>5; const int wid=__builtin_amdgcn_readfirstlane(tid>>6);
  const long rowbase=(long)b*SEQ; const int q0=qb*QB;
  const bf16*Qw=Q+(rowbase+q0+wid*QBLK)*PQKV+(h>>1)*D;
  const bf16*Kh=K+rowbase*PQKV+(h>>1)*D,*Vh=V+rowbase*PQKV+((h>>2)*2+(h&1))*D;
  const unsigned lds0=(unsigned)(uintptr_t)shm;
  float*wsf=(float*)(shm+LDS_WS)+wid*64;
  const bf16*ksrc=Kh+(long)lane*PQKV+wid*8;
  const bf16*vsrc=Vh+(long)(16*(wid&3)+(lane>>2))*PQKV+(wid>>2)*32+(lane&3)*8;
  const unsigned kdst=lds0+LDS_K+wid*1024, vdst=lds0+LDS_V+wid*1024;
  #define DMA_K(t,slot) glds16(ksrc+(long)(t)*KVBLK*PQKV,(unsigned)__builtin_amdgcn_readfirstlane(kdst+(slot)))
  #define DMA_V(t,slot) glds16(vsrc+(long)(t)*KVBLK*PQKV,(unsigned)__builtin_amdgcn_readfirstlane(vdst+(slot)))
  const int vb0=(int)(lds0+LDS_V)+((lane>>4)&1)*32+(lane&3)*8+(4*hi+((lane&15)>>2))*64;
  const char*Kbase=shm+LDS_K; bf16x8 kf[8];
  const lds_cptr shm3=(lds_cptr)shm; const lds_cptr kp0=shm3+LDS_K+hi*1024+r32*16; const lds_cptr vp0=shm3+LDS_V+((lane>>4)&1)*32+(lane&3)*8+(4*hi+((lane&15)>>2))*64;
  const int NT=(q0+QB)/KVBLK;
  DMA_K(0,0);DMA_V(0,0);DMA_K(1,SLOTB);
  bf16x8 qr[4];
  #pragma unroll
  for(int d0=0;d0<4;++d0)qr[d0]=*reinterpret_cast<const bf16x8*>(&Qw[(long)r32*PQKV+d0*16+hi*8]);
  float mhat=0.f,l_reg=0.f;f32x16 o[2];o[0]=f32x16{};o[1]=f32x16{};f32x16 negm=f32x16{};asm volatile("":"+v"(negm));
  const int qrel=wid*QBLK+r32;
  #define CMASK(P0,P1,t) do{int jb_=(t)-(NT-4); if(jb_>=0)cmask(P0,P1,jb_,qrel,hi);}while(0)
  bool resc=false;
  #define START(P0,P1) do{ const float rm=rowmax(P0,P1); resc=false; \
    { const float dl=rm; mhat=fadd_s(mhat,dl); \
      _Pragma("unroll") for(int r=0;r<16;++r){P0[r]=fsub_s(P0[r],dl);P1[r]=fsub_s(P1[r],dl);} \
      _Pragma("unroll") for(int r=0;r<16;++r)negm[r]=-mhat; asm volatile("":"+v"(negm)); } \
    _Pragma("unroll") for(int r=0;r<16;++r)P0[r]=__builtin_amdgcn_exp2f(P0[r]); }while(0)
  #define RESC() do{ if(resc){ asm volatile("s_waitcnt lgkmcnt(0)":::"memory"); \
      _Pragma("unroll") for(int d_=0;d_<2;++d_) _Pragma("unroll") for(int r=0;r<16;++r)o[d_][r]*=wsf[crow(r,hi)]; } }while(0)
  f32x16 pA0,pA1,pB0,pB1;
  int sl_prev=0,sl_cur=0,sl_next=SLOTB;
  #define ROT() do{sl_prev=sl_cur;sl_cur=sl_next;sl_next=(sl_next==(NSLOT-1)*SLOTB)?0:sl_next+SLOTB;}while(0)
  DMA_K(2,2*SLOTB);
  WAIT_BAR(3);
  qkt(pA0,pA1,Kbase,qr,negm,r32,hi);asm volatile("s_nop 15\n\ts_nop 7":"+v"(pA0),"+v"(pA1));CMASK(pA0,pA1,0);
  START(pA0,pA1);
  _Pragma("unroll") for(int r=0;r<16;++r)pA1[r]=__builtin_amdgcn_exp2f(pA1[r]);
  WAIT_BAR(0);
  DMA_K(3,0);DMA_V(1,SLOTB);
  ROT();
  kload8(kf,kp0+sl_cur);
  WAIT_BAR(2);
  s16x4 vlo[8],vhi[8]; u32x4 pw0,pw1,pw2,pw3;
  #define PKW(P,B) cvtpk_s(P[B],P[B+1])
  #define PAF(k) __builtin_bit_cast(bf16x8,pw##k)
  #define VFR(i) (bf16x8){vlo[i][0],vlo[i][1],vlo[i][2],vlo[i][3],vhi[i][0],vhi[i][1],vhi[i][2],vhi[i][3]}
  #define PIN(x) asm volatile("":"+v"(x))
  #define MX3(a,b,c) __builtin_fmaxf(__builtin_fmaxf((a),(b)),(c))
  #define GAPA(MF,A0,A1,A2,A3,W0,W1,PW) do{ MF; sacc+=A0; sacc+=A1; sacc+=A2; sacc+=A3; PIN(sacc); W0; W1; PIN(PW); SBAR(); }while(0)
  #define EX(v) __builtin_amdgcn_exp2f(v)
  #define GAPB(MF,X,B) do{ MF; X[B]=EX(X[B]); X[B+1]=EX(X[B+1]); X[B+2]=EX(X[B+2]); X[B+3]=EX(X[B+3]); PIN(X); SBAR(); }while(0)
  #define VRD(i) do{ vlo[i]=vtr(vp_+(((i)>>2)*4096+((i)&3)*1024)); vhi[i]=vtr(vp_+(((i)>>2)*4096+((i)&3)*1024+512)); }while(0)
  #define KRD(G,j) do{ if(G){ kload2(kf,kp0+sl_next,j); SBAR(); } }while(0)
  #define STEP(C0,C1,P0,P1,t,GK,GV,GL) do{ SBAR(); \
    const lds_cptr vp_=vp0+sl_prev; \
    VRD(0); SBAR(); float sacc=(P0[0]+P0[1]); \
    GAPA(C0=__builtin_amdgcn_mfma_f32_32x32x16_bf16(kf[0],qr[0],negm,0,0,0), P0[2],P0[3],P0[4],P0[5],     pw0[0]=PKW(P0,0), pw0[1]=PKW(P0,2), pw0); \
    VRD(4); SBAR(); GAPA(C1=__builtin_amdgcn_mfma_f32_32x32x16_bf16(kf[1],qr[0],negm,0,0,0), P0[6],P0[7],P0[8],P0[9],     pw0[2]=PKW(P0,4), pw0[3]=PKW(P0,6), pw0); \
    VRD(1); SBAR(); GAPA(C0=__builtin_amdgcn_mfma_f32_32x32x16_bf16(kf[2],qr[1],C0,0,0,0),   P0[10],P0[11],P0[12],P0[13], pw1[0]=PKW(P0,8), pw1[1]=PKW(P0,10), pw1); \
    VRD(5); SBAR(); GAPA(C1=__builtin_amdgcn_mfma_f32_32x32x16_bf16(kf[3],qr[1],C1,0,0,0),   P0[14],P0[15],P1[0],P1[1],   pw1[2]=PKW(P0,12),pw1[3]=PKW(P0,14), pw1); \
    VRD(2); SBAR(); GAPA(C0=__builtin_amdgcn_mfma_f32_32x32x16_bf16(kf[4],qr[2],C0,0,0,0),   P1[2],P1[3],P1[4],P1[5],     pw2[0]=PKW(P1,0), pw2[1]=PKW(P1,2), pw2); \
    VRD(6); SBAR(); GAPA(C1=__builtin_amdgcn_mfma_f32_32x32x16_bf16(kf[5],qr[2],C1,0,0,0),   P1[6],P1[7],P1[8],P1[9],     pw2[2]=PKW(P1,4), pw2[3]=PKW(P1,6), pw2); \
    VRD(3); SBAR(); GAPA(C0=__builtin_amdgcn_mfma_f32_32x32x16_bf16(kf[6],qr[3],C0,0,0,0),   P1[10],P1[11],P1[12],P1[13], pw3[0]=PKW(P1,8), pw3[1]=PKW(P1,10), pw3); \
    VRD(7); SBAR(); GAPA(C1=__builtin_amdgcn_mfma_f32_32x32x16_bf16(kf[7],qr[3],C1,0,0,0),   P1[14],P1[15],0.f,0.f,       pw3[2]=PKW(P1,12),pw3[3]=PKW(P1,14), pw3); \
    l_reg+=sacc; \
    if(GK){DMA_K((t)+3,sl_cur);} if(GV){DMA_V((t)+1,sl_next);} \
    CMASK(C0,C1,t); \
    { float a=MX3(C0[0],C0[1],C1[0]),b=MX3(C0[2],C0[3],C1[1]); a=MX3(a,C1[2],C1[3]); \
      _Pragma("unroll") for(int r=4;r<16;r+=4){a=MX3(a,C0[r],C0[r+1]);b=MX3(b,C0[r+2],C0[r+3]);a=MX3(a,C1[r],C1[r+1]);b=MX3(b,C1[r+2],C1[r+3]);} \
      float rm=__builtin_fmaxf(a,b); { auto rr=__builtin_amdgcn_permlane32_swap(__float_as_uint(rm),__float_as_uint(rm),false,false); rm=__builtin_fmaxf(__uint_as_float(rr[0]),__uint_as_float(rr[1])); } \
      resc=false; \
      if(__builtin_expect(__any(rm>(float)THRL),0)){ const float dl=__builtin_fmaxf(rm,0.f); mhat+=dl; \
        _Pragma("unroll") for(int r=0;r<16;++r){C0[r]-=dl;C1[r]-=dl;} \
        _Pragma("unroll") for(int r=0;r<16;++r)negm[r]=-mhat; asm volatile("":"+v"(negm)); \
        const float f=__builtin_amdgcn_exp2f(-dl); l_reg*=f; if(hi==0)wsf[r32]=f; resc=true; } } \
    SBAR(); \
    GAPB(o[0]=__builtin_amdgcn_mfma_f32_32x32x16_bf16(PAF(0),VFR(0),o[0],0,0,0), C0,0); \
    GAPB(o[1]=__builtin_amdgcn_mfma_f32_32x32x16_bf16(PAF(0),VFR(4),o[1],0,0,0), C0,4); \
    KRD(GL,0); GAPB(o[0]=__builtin_amdgcn_mfma_f32_32x32x16_bf16(PAF(1),VFR(1),o[0],0,0,0), C0,8); \
    KRD(GL,1); GAPB(o[1]=__builtin_amdgcn_mfma_f32_32x32x16_bf16(PAF(1),VFR(5),o[1],0,0,0), C0,12); \
    KRD(GL,2); GAPB(o[0]=__builtin_amdgcn_mfma_f32_32x32x16_bf16(PAF(2),VFR(2),o[0],0,0,0), C1,0); \
    KRD(GL,3); GAPB(o[1]=__builtin_amdgcn_mfma_f32_32x32x16_bf16(PAF(2),VFR(6),o[1],0,0,0), C1,4); \
    GAPB(o[0]=__builtin_amdgcn_mfma_f32_32x32x16_bf16(PAF(3),VFR(3),o[0],0,0,0), C1,8); \
    GAPB(o[1]=__builtin_amdgcn_mfma_f32_32x32x16_bf16(PAF(3),VFR(7),o[1],0,0,0), C1,12); \
    }while(0)
  int t=1;
  #undef CMASK
  #define CMASK(P0,P1,t) do{}while(0)
  for(;t+5<NT;t+=2){
    STEP(pB0,pB1,pA0,pA1,t,true,true,true);     WAIT_BAR(2); RESC(); ROT();
    STEP(pA0,pA1,pB0,pB1,t+1,true,true,true);   WAIT_BAR(2); RESC(); ROT();
  }
  #undef CMASK
  #define CMASK(P0,P1,t) do{int jb_=(t)-(NT-4); if(jb_>=0)cmask(P0,P1,jb_,qrel,hi);}while(0)
  #define ENDW(tt) do{ if((tt)+3<NT){WAIT_BAR(2);} else if((tt)+2<NT){WAIT_BAR(1);} else {WAIT_BAR(0);} }while(0)
  for(;t+1<NT;t+=2){
    STEP(pB0,pB1,pA0,pA1,t,(t+3<NT),(t+1<NT),(t+1<NT));       ENDW(t);   RESC(); ROT();
    STEP(pA0,pA1,pB0,pB1,t+1,(t+4<NT),(t+2<NT),(t+2<NT));     ENDW(t+1); RESC(); ROT();
  }
  STEP(pB0,pB1,pA0,pA1,NT-1,false,false,false); RESC();
  { float sacc=pB0[0]+pB0[1]; _Pragma("unroll") for(int r=2;r<16;++r)sacc+=pB0[r]; _Pragma("unroll") for(int r=0;r<16;++r)sacc+=pB1[r]; l_reg+=sacc;
    pw0=(u32x4){PKW(pB0,0),PKW(pB0,2),PKW(pB0,4),PKW(pB0,6)};pw1=(u32x4){PKW(pB0,8),PKW(pB0,10),PKW(pB0,12),PKW(pB0,14)};pw2=(u32x4){PKW(pB1,0),PKW(pB1,2),PKW(pB1,4),PKW(pB1,6)};pw3=(u32x4){PKW(pB1,8),PKW(pB1,10),PKW(pB1,12),PKW(pB1,14)};
    SBAR(); pv(o,vb0+sl_cur,PAF(0),PAF(1),PAF(2),PAF(3)); }
  #undef PKW
  #undef PAF
  #undef VFR
  #undef PIN
  #undef MX3
  #undef GAPA
  #undef GAPB
  #undef EX
  #undef VRD
  #undef KRD
  #undef STEP
  #undef ENDW
  {auto rr=__builtin_amdgcn_permlane32_swap(__float_as_uint(l_reg),__float_as_uint(l_reg),false,false);l_reg=__uint_as_float(rr[0])+__uint_as_float(rr[1]);}
  if(hi==0)wsf[32+r32]=l_reg;asm volatile("s_waitcnt lgkmcnt(0)":::"memory");
  float rli[16];
  #pragma unroll
  for(int r=0;r<16;++r)rli[r]=__builtin_amdgcn_rcpf(wsf[32+crow(r,hi)]);
  bf16*Ow=O+(rowbase+q0+wid*QBLK)*DM+h*D;
  { bf16*stg=(bf16*)(shm+LDS_OST)+wid*2048;
    #pragma unroll
    for(int r=0;r<16;++r){const int orow=crow(r,hi);
      #pragma unroll
      for(int d0=0;d0<2;++d0)stg[orow*64+d0*32+r32]=__float2bfloat16(o[d0][r]*rli[r]);}
    asm volatile("s_waitcnt lgkmcnt(0)":::"memory");
    #pragma unroll
    for(int i=0;i<4;++i){const int row=i*8+(lane>>3),ch=lane&7; const u32x4 v=*(const u32x4*)(stg+row*64+ch*8); ATTN_STORE16(Ow+(long)row*DM+ch*8,v);} }
  asm volatile("s_waitcnt lgkmcnt(0)\n\ts_barrier":::"memory");
  #undef DMA_K
  #undef DMA_V
  #undef CMASK
  #undef START
  #undef RESC
  #undef ROT
}
constexpr int ATTN_LDS_BYTES=LDS_BYTES;
struct AttnTensors { const bf16* Q; const bf16* K; const bf16* V; bf16* O; };
struct AttnUnit { int bh; int qb; };
struct StaticOrder {
  int vcu;
  __device__ __forceinline__ explicit StaticOrder(int grid,int block):vcu((block%8)*(grid/8)+block/8){}
  __device__ __forceinline__ bool next(int i,AttnUnit&u)const{ if(i>=4)return false; const int s=vcu&7; u.bh=vcu>>3; u.qb=(i==0)?s:(i==1)?15-s:(i==2)?16+s:31-s; return true; }
  __device__ __forceinline__ void a_ready(const AttnUnit&)const{}
  __device__ __forceinline__ void done(const AttnUnit&)const{}
};
template<class Sched,int THRL=8> __device__ __forceinline__ void attn_phase(char*lds,const AttnTensors&T,const Sched&S){
  AttnUnit u;
  for(int i=0;S.next(i,u);++i){ S.a_ready(u); attn_unit<THRL>(u.bh/NHEAD,u.bh%NHEAD,u.qb,T.Q,T.K,T.V,T.O,lds); S.done(u); }
}
#undef SBAR
#undef WAIT_BAR
}
constexpr int NWAVES = 8;
constexpr int NB = 2, SEQ = 8192, DM = 1024, NTOK = NB * SEQ;
constexpr int IN_COLS = 3592, INP_N = 3584;
constexpr int NEXP = 32, TOPK = 4, NMEM = 256;
constexpr int GCH = 64, NCHUNK = SEQ / GCH;
constexpr float DN_ALPHA = 1.189207115002721f;
constexpr float LN_EPS = 1e-5f, RMS_EPS = 1e-6f;
constexpr float LAMBDA_INIT = 0.2f;
constexpr int MOE_MAXROWS = 73728;
constexpr int MOE_MAXTILES = MOE_MAXROWS / 256;

constexpr size_t MiB = 1u << 20;
constexpr size_t WS_CTL = 0, CTL_ZERO_BYTES = 1 * MiB;
constexpr size_t WS_WD = 1 * MiB;
constexpr size_t WS_WGU = 65 * MiB;
constexpr size_t WS_Y = 65 * MiB;
constexpr size_t WS_WIN = 193 * MiB;
constexpr size_t WS_WOUT = 200 * MiB;
constexpr size_t WS_WKV = 202 * MiB;
constexpr size_t WS_WQH = 206 * MiB;
constexpr size_t WS_WOH = 208 * MiB;
constexpr size_t WS_WQK = 210 * MiB;
constexpr size_t WS_VWO = 214 * MiB;
constexpr size_t WS_KMAT = 218 * MiB;
constexpr size_t WS_VMAT = 219 * MiB;
constexpr size_t WS_MEMB = 220 * MiB;
constexpr size_t WS_GBA = 221 * MiB;
constexpr size_t WS_GL = 221 * MiB + 512 * 1024;
constexpr size_t WS_TOPI = 222 * MiB;
constexpr size_t WS_GATE = 222 * MiB + 256 * 1024;
constexpr size_t WS_DEST = 222 * MiB + 512 * 1024;
constexpr size_t WS_GCNT = 222 * MiB + 768 * 1024;
constexpr size_t WS_XB = 224 * MiB;
constexpr size_t WS_O16 = 224 * MiB;
constexpr size_t WS_GQKV = 256 * MiB;
constexpr size_t WS_OA = 256 * MiB;
constexpr size_t WS_GZ = 304 * MiB;
constexpr size_t WS_DQ = 320 * MiB, WS_DK = 336 * MiB, WS_DV = 352 * MiB;
constexpr size_t WS_GOP = 368 * MiB;
constexpr size_t WS_GOUT = 456 * MiB;
constexpr size_t WS_V1 = 288 * MiB;
constexpr size_t WS_X1F = 352 * MiB;
constexpr size_t WS_X1B = 416 * MiB;
constexpr size_t WS_PM = 448 * MiB;
constexpr size_t WS_XS = 224 * MiB;
constexpr size_t WS_H = 368 * MiB;
constexpr size_t WS_END = 512 * MiB;
constexpr int GOP_BYTES = 90112;
constexpr int GOP_W = 0, GOP_QD = 16384, GOP_KT = 32768, GOP_AI = 49152, GOP_UT = 57344, GOP_LDS = 57344;
constexpr int CW_CNT = 64;
constexpr int CW_FILL = 128;

constexpr int RING_BYTES = 131072;
constexpr int MISC_OFF = RING_BYTES;
constexpr int LDS_BYTES = 147456;

#define GAS __attribute__((address_space(1)))
#define LAS __attribute__((address_space(3)))
typedef unsigned short bf16;
typedef unsigned v4u __attribute__((ext_vector_type(4)));
typedef unsigned v2u __attribute__((ext_vector_type(2)));
typedef float f32x4 __attribute__((ext_vector_type(4)));
typedef short bf16x8 __attribute__((ext_vector_type(8)));
#define LDS_WAIT() asm volatile("s_waitcnt lgkmcnt(0)" ::: "memory")
__device__ __forceinline__ unsigned f2bf(float f) { unsigned u = __builtin_bit_cast(unsigned, f); return (u + 0x7fffu + ((u >> 16) & 1u)) >> 16; }
__device__ __forceinline__ unsigned pk2(float lo, float hi) { return f2bf(lo) | (f2bf(hi) << 16); }
__device__ __forceinline__ float bf2f(unsigned short b) { return __builtin_bit_cast(float, (unsigned)b << 16); }
__device__ __forceinline__ float bflo(unsigned w) { return __builtin_bit_cast(float, w << 16); }
__device__ __forceinline__ float bfhi(unsigned w) { return __builtin_bit_cast(float, w & 0xffff0000u); }
__device__ __forceinline__ float wave_sum(float v) {
#pragma unroll
    for (int o = 1; o < 64; o <<= 1) v += __shfl_xor(v, o);
    return v;
}
__device__ __forceinline__ float sigmoidf_(float x) { return 1.0f / (1.0f + __expf(-x)); }

struct Args { const float* in[31]; float* out; unsigned char* ws; int ph_lo, ph_hi; };
struct KA {
    unsigned char* ws;
    __device__ __forceinline__ const float* in(int i) const {
        const __attribute__((address_space(4))) unsigned long long* p = (const __attribute__((address_space(4))) unsigned long long*)__builtin_amdgcn_kernarg_segment_ptr();
        asm volatile("" : "+s"(p));
        return (const float*)p[i];
    }
    __device__ __forceinline__ float* out() const {
        const __attribute__((address_space(4))) unsigned long long* p = (const __attribute__((address_space(4))) unsigned long long*)__builtin_amdgcn_kernarg_segment_ptr();
        asm volatile("" : "+s"(p));
        return (float*)p[31];
    }
};

__device__ __forceinline__ void transpose_item(const float* src  , int srcN, bf16* dst  , int ld, LAS float* scr, int lane) {
#pragma unroll 16
    for (int i = 0; i < 32; ++i) { const int kk = 2 * i + (lane >> 5); scr[kk * 33 + (lane & 31)] = src[(size_t)kk * srcN + (lane & 31)]; }
    LDS_WAIT(); asm volatile("" ::: "memory");
    const int c = lane & 7;
#pragma unroll
    for (int j = 0; j < 4; ++j) { const int n = (lane >> 3) + 8 * j; const LAS float* s = scr + (8 * c) * 33 + n;
        v4u o; o.x = pk2(s[0 * 33], s[1 * 33]); o.y = pk2(s[2 * 33], s[3 * 33]); o.z = pk2(s[4 * 33], s[5 * 33]); o.w = pk2(s[6 * 33], s[7 * 33]);
        *(GAS v4u*)(dst + (size_t)n * ld + 8 * c) = o; }
    LDS_WAIT(); asm volatile("" ::: "memory");
}
enum { I_X = 0, I_MEM, I_WIN, I_CONVW, I_ALOG, I_DTB, I_GNW, I_LQ1, I_LK1, I_LQ2, I_LK2, I_DNW, I_WOUT, I_LN1G, I_LN1B, I_WQ, I_WK, I_WV, I_WO, I_LN2G, I_LN2B,
       I_RW, I_RB, I_EWG, I_EBG, I_EWU, I_EBU, I_EWD, I_EBD, I_LN3G, I_LN3B };

__device__ __forceinline__ void p0_prologue(const KA& A, LAS unsigned char* lds, int gw, int NGW, int wave, int lane, int tid) {
    unsigned char* ws = A.ws;
    LAS float* scr = (LAS float*)(lds + wave * 16384);
    constexpr int IT_WIN = 16 * 112, IT_SQ = 16 * 32;
    constexpr int O_WOUT = IT_WIN, O_WK = O_WOUT + IT_SQ, O_WV = O_WK + IT_SQ, O_WO = O_WV + IT_SQ, O_EXP = O_WO + IT_SQ, NITEMS = O_EXP + NEXP * 3 * IT_SQ;
    for (int it = gw; it < NITEMS; it += NGW) {
        if (it < O_WOUT) { const int kb = it / 112, nb = it % 112, n0 = nb * 32, k0 = kb * 64; const int sc = n0 + (n0 >= 2048 ? 8 : 0);
            transpose_item(A.in(I_WIN) + (size_t)k0 * IN_COLS + sc, IN_COLS, (bf16*)(ws + WS_WIN) + (size_t)n0 * 1024 + k0, 1024, scr, lane); continue; }
        if (it < O_EXP) {
            const int r = it - O_WOUT, which = r / IT_SQ, q = r % IT_SQ, kb = q / 32, nb = q % 32, n0 = nb * 32, k0 = kb * 64;
            const float* src; bf16* dst; int ld = 1024;
            if (which == 0) { src = A.in(I_WOUT); dst = (bf16*)(ws + WS_WOUT) + (size_t)n0 * 1024 + k0; }
            else if (which == 1) { src = A.in(I_WK); dst = (bf16*)(ws + WS_WKV) + (size_t)n0 * 1024 + k0; }
            else if (which == 2) { src = A.in(I_WV); dst = (bf16*)(ws + WS_WKV) + (size_t)(1024 + n0) * 1024 + k0; }
            else { src = A.in(I_WO); dst = (bf16*)(ws + WS_WOH) + ((size_t)(k0 >> 8) * 1024 + n0) * 256 + (k0 & 255); ld = 256; }
            transpose_item(src + (size_t)k0 * 1024 + n0, 1024, dst, ld, scr, lane); continue;
        }
        const int r = it - O_EXP, e = r / (3 * IT_SQ), r2 = r % (3 * IT_SQ), which = r2 / IT_SQ, q = r2 % IT_SQ, kb = q / 32, nb = q % 32, n0 = nb * 32, k0 = kb * 64;
        const float* src; bf16* dst;
        if (which == 0) { src = A.in(I_EWG) + (size_t)e * 1048576; dst = (bf16*)(ws + WS_WGU) + (size_t)e * 2097152 + (size_t)((n0 >> 7) * 256 + (n0 & 127)) * 1024 + k0; }
        else if (which == 1) { src = A.in(I_EWU) + (size_t)e * 1048576; dst = (bf16*)(ws + WS_WGU) + (size_t)e * 2097152 + (size_t)((n0 >> 7) * 256 + 128 + (n0 & 127)) * 1024 + k0; }
        else { src = A.in(I_EWD) + (size_t)e * 1048576; dst = (bf16*)(ws + WS_WD) + (size_t)e * 1048576 + (size_t)n0 * 1024 + k0; }
        transpose_item(src + (size_t)k0 * 1024 + n0, 1024, dst, 1024, scr, lane);
    }
    for (int r = gw; r < 1024 + NB * NMEM; r += NGW) {
        const float* srow = (r < 1024) ? A.in(I_WQ) + (size_t)r * 1024 : A.in(I_MEM) + (size_t)(r - 1024) * 1024;
#pragma unroll
        for (int j = 0; j < 4; ++j) {
            const int col = 4 * lane + 256 * j; const f32x4 v = *(const GAS f32x4*)(srow + col);
            v2u o; o.x = pk2(v.x, v.y); o.y = pk2(v.z, v.w);
            bf16* d = (r < 1024) ? (bf16*)(ws + WS_WQH) + ((size_t)(col >> 8) * 1024 + r) * 256 + (col & 255) : (bf16*)(ws + WS_MEMB) + (size_t)(r - 1024) * 1024 + col;
            *(GAS v2u*)d = o;
        }
    }
    __syncthreads();
    LAS float* w8 = (LAS float*)lds;
    for (int i = tid; i < 8192; i += 512) { const int k = i >> 3, c = i & 7; w8[c * 1024 + k] = A.in(I_WIN)[(size_t)k * IN_COLS + 2048 + c]; }
    __syncthreads();
    for (int m = gw; m < NTOK; m += NGW) {
        const float* xr = A.in(I_X) + (size_t)m * 1024;
        float acc[8];
#pragma unroll
        for (int c = 0; c < 8; ++c) acc[c] = 0.f;
#pragma unroll
        for (int j = 0; j < 4; ++j) {
            const int col = 4 * lane + 256 * j; const f32x4 v = *(const GAS f32x4*)(xr + col);
            v2u o; o.x = pk2(v.x, v.y); o.y = pk2(v.z, v.w);
            *(GAS v2u*)((bf16*)(ws + WS_XB) + (size_t)m * 1024 + col) = o;
#pragma unroll
            for (int c = 0; c < 8; ++c) { const f32x4 w = *(const LAS f32x4*)(w8 + c * 1024 + col); acc[c] += v.x * w.x + v.y * w.y + v.z * w.z + v.w * w.w; }
        }
#pragma unroll
        for (int c = 0; c < 8; ++c) acc[c] = wave_sum(acc[c]);
        if (lane == 0) { float* g = (float*)(ws + WS_GBA) + (size_t)m * 8;
            *(f32x4*)g = (f32x4){acc[0], acc[1], acc[2], acc[3]}; *(f32x4*)(g + 4) = (f32x4){acc[4], acc[5], acc[6], acc[7]}; }
    }
    __syncthreads();
}
constexpr int GP_KR = 0, GP_QR = 17408, GP_KBGT = 34816, GP_VBT = 53248, GP_KTT = 71680, GP_AINV = 88064, GP_LM = 97280, GP_G = 114688;
__device__ __forceinline__ int sigma_pos(int idx) { const int s = idx >> 5, tl = idx & 31; return 32 * s + 8 * ((tl >> 2) & 3) + 4 * (tl >> 4) + (tl & 3); }
__device__ __forceinline__ f32x4 mfma16(bf16x8 a, bf16x8 b, f32x4 c) { return __builtin_amdgcn_mfma_f32_16x16x32_bf16(a, b, c, 0, 0, 0); }

__device__ __forceinline__ void gdn_prep_unit(const KA& A, LAS unsigned char* lds, int unit, int tid_in) {
    int tid = tid_in; asm volatile("" : "+v"(tid));
    const int lane = tid & 63, wave = __builtin_amdgcn_readfirstlane(tid >> 6);
    unsigned char* ws = A.ws;
    const int bh = unit >> 7, n = unit & 127, b = bh >> 2, h = bh & 3;
    const int m0 = b * SEQ + n * GCH;
    LAS bf16* Kr = (LAS bf16*)(lds + GP_KR); LAS bf16* Qr = (LAS bf16*)(lds + GP_QR);
    LAS bf16* KbgT = (LAS bf16*)(lds + GP_KBGT); LAS bf16* VbT = (LAS bf16*)(lds + GP_VBT); LAS bf16* KtT = (LAS bf16*)(lds + GP_KTT);
    LAS bf16* Ainv = (LAS bf16*)(lds + GP_AINV); LAS float* Lm = (LAS float*)(lds + GP_LM); LAS float* Gs = (LAS float*)(lds + GP_G);
    unsigned char* gop = ws + WS_GOP + (size_t)unit * GOP_BYTES;
    if (wave == 0) {
        const float* gba = (const float*)(ws + WS_GBA) + (size_t)(m0 + lane) * 8;
        const float gb = gba[h], ga = gba[4 + h];
        const float beta = sigmoidf_(gb);
        const float xx = ga + A.in(I_DTB)[h];
        const float sp = fmaxf(xx, 0.f) + log1pf(__expf(-fabsf(xx)));
        float g = -__expf(A.in(I_ALOG)[h]) * sp;
#pragma unroll
        for (int o = 1; o < 64; o <<= 1) { const float v = __shfl_up(g, o); if (lane >= o) g += v; }
        Gs[lane] = g; Gs[64 + lane] = beta;
        if (lane == 63) ((float*)(ws + WS_GL))[unit] = __expf(g);
    }
    const int tok = tid >> 3, part = tid & 7;
    float yq[16], yk[16], yv[16];
    {
        const bf16* gq = (const bf16*)(ws + WS_GQKV);
        const float* cw = A.in(I_CONVW);
#pragma unroll
        for (int mat = 0; mat < 3; ++mat) {
            const int col = mat * 512 + h * 128 + part * 16;
            float y[16];
#pragma unroll
            for (int i = 0; i < 16; ++i) y[i] = 0.f;
#pragma unroll
            for (int j = 0; j < 4; ++j) {
                const int rel = n * GCH + tok - 3 + j;
                if (rel >= 0) {
                    const bf16* src = gq + (size_t)(b * SEQ + rel) * 1536 + col;
                    const v4u x0 = *(const GAS v4u*)src, x1 = *(const GAS v4u*)(src + 8);
                    const float* wj = cw + j * 1536 + col;
                    const f32x4 w0 = *(const f32x4*)wj, w1 = *(const f32x4*)(wj + 4), w2 = *(const f32x4*)(wj + 8), w3 = *(const f32x4*)(wj + 12);
                    y[0] += w0.x * bflo(x0.x); y[1] += w0.y * bfhi(x0.x); y[2] += w0.z * bflo(x0.y); y[3] += w0.w * bfhi(x0.y);
                    y[4] += w1.x * bflo(x0.z); y[5] += w1.y * bfhi(x0.z); y[6] += w1.z * bflo(x0.w); y[7] += w1.w * bfhi(x0.w);
                    y[8] += w2.x * bflo(x1.x); y[9] += w2.y * bfhi(x1.x); y[10] += w2.z * bflo(x1.y); y[11] += w2.w * bfhi(x1.y);
                    y[12] += w3.x * bflo(x1.z); y[13] += w3.y * bfhi(x1.z); y[14] += w3.z * bflo(x1.w); y[15] += w3.w * bfhi(x1.w);
                }
            }
#pragma unroll
            for (int i = 0; i < 16; ++i) { const float s = y[i] * sigmoidf_(y[i]); if (mat == 0) yq[i] = s; else if (mat == 1) yk[i] = s; else yv[i] = s; }
        }
        float sq = 0.f, sk = 0.f;
#pragma unroll
        for (int i = 0; i < 16; ++i) { sq += yq[i] * yq[i]; sk += yk[i] * yk[i]; }
        sq += __shfl_xor(sq, 1); sq += __shfl_xor(sq, 2); sq += __shfl_xor(sq, 4);
        sk += __shfl_xor(sk, 1); sk += __shfl_xor(sk, 2); sk += __shfl_xor(sk, 4);
        const float rq = rsqrtf(sq + RMS_EPS) * 0.08838834764831845f, rk = rsqrtf(sk + RMS_EPS);
#pragma unroll
        for (int i = 0; i < 16; ++i) { yq[i] *= rq; yk[i] *= rk; }
    }
    __syncthreads();
    {
        const float G = Gs[tok], beta = Gs[64 + tok], G63 = Gs[63];
        const float eG = __expf(G), eT = __expf(G63 - G), bG = beta * eG;
        v4u o0, o1;
        o0.x = pk2(yk[0], yk[1]); o0.y = pk2(yk[2], yk[3]); o0.z = pk2(yk[4], yk[5]); o0.w = pk2(yk[6], yk[7]);
        o1.x = pk2(yk[8], yk[9]); o1.y = pk2(yk[10], yk[11]); o1.z = pk2(yk[12], yk[13]); o1.w = pk2(yk[14], yk[15]);
        *(LAS v4u*)(Kr + tok * 136 + part * 16) = o0; *(LAS v4u*)(Kr + tok * 136 + part * 16 + 8) = o1;
        o0.x = pk2(yq[0], yq[1]); o0.y = pk2(yq[2], yq[3]); o0.z = pk2(yq[4], yq[5]); o0.w = pk2(yq[6], yq[7]);
        o1.x = pk2(yq[8], yq[9]); o1.y = pk2(yq[10], yq[11]); o1.z = pk2(yq[12], yq[13]); o1.w = pk2(yq[14], yq[15]);
        *(LAS v4u*)(Qr + tok * 136 + part * 16) = o0; *(LAS v4u*)(Qr + tok * 136 + part * 16 + 8) = o1;
        const int sp = sigma_pos(tok);
#pragma unroll
        for (int i = 0; i < 16; ++i) {
            const int d = part * 16 + i;
            KbgT[d * 72 + tok] = (bf16)f2bf(yk[i] * bG);
            VbT[d * 72 + tok] = (bf16)f2bf(yv[i] * beta);
            KtT[d * 64 + sp] = (bf16)f2bf(yk[i] * eT);
        }
        bf16* qd = (bf16*)(gop + GOP_QD) + tok * 128 + 32 * (part >> 1) + 4 * (part & 1);
#pragma unroll
        for (int q4 = 0; q4 < 4; ++q4) { v2u o; o.x = pk2(yq[4 * q4] * eG, yq[4 * q4 + 1] * eG); o.y = pk2(yq[4 * q4 + 2] * eG, yq[4 * q4 + 3] * eG); *(GAS v2u*)(qd + 8 * q4) = o; }
    }
    __syncthreads();
    const int c16 = lane & 15, q4 = lane >> 4;
#pragma unroll 1
    for (int jj = 0; jj < 4; ++jj) {
        const int J = wave * 4 + jj, isqk = J >> 4, tm = (J >> 2) & 3, tn = J & 3;
        if (tn < tm) { if (isqk) { const int i = 16 * tn + c16; *(GAS v2u*)((bf16*)(gop + GOP_AI) + i * 64 + 32 * (tm >> 1) + 8 * q4 + 4 * (tm & 1)) = (v2u){0u, 0u}; } continue; }
        f32x4 acc = {0.f, 0.f, 0.f, 0.f};
        const LAS bf16* ap = Kr + (16 * tm + c16) * 136 + 8 * q4;
        const LAS bf16* bp = (isqk ? Qr : Kr) + (16 * tn + c16) * 136 + 8 * q4;
#pragma unroll
        for (int ks = 0; ks < 4; ++ks) acc = mfma16(*(const LAS bf16x8*)(ap + 32 * ks), *(const LAS bf16x8*)(bp + 32 * ks), acc);
        const int i = 16 * tn + c16, j0 = 16 * tm + 4 * q4;
        const float Gi = Gs[i], bi = Gs[64 + i];
        float r[4];
#pragma unroll
        for (int k = 0; k < 4; ++k) { const int j = j0 + k; const float dec = __expf(fminf(Gi - Gs[j], 0.f)); r[k] = acc[k] * dec; }
        if (!isqk) {
#pragma unroll
            for (int k = 0; k < 4; ++k) r[k] = (j0 + k < i) ? r[k] * bi : 0.f;
            *(LAS f32x4*)(Lm + i * 68 + j0) = (f32x4){r[0], r[1], r[2], r[3]};
        } else {
#pragma unroll
            for (int k = 0; k < 4; ++k) r[k] = (j0 + k <= i) ? r[k] : 0.f;
            v2u o; o.x = pk2(r[0], r[1]); o.y = pk2(r[2], r[3]);
            *(GAS v2u*)((bf16*)(gop + GOP_AI) + i * 64 + 32 * (tm >> 1) + 8 * q4 + 4 * (tm & 1)) = o;
        }
    }
    __syncthreads();
    if (wave == 0) {
        float a[64];
        const float lanef = (float)lane;
        unsigned lmb = (unsigned)(uintptr_t)Lm; asm volatile("" : "+v"(lmb));
        const LAS float* Lmo = (const LAS float*)(uintptr_t)lmb;
#pragma unroll
        for (int i = 0; i < 64; ++i) {
            float v = fmaxf(0.f, 1.f - fabsf(lanef - (float)i));
#pragma unroll
            for (int j4 = 0; j4 < (i + 3) / 4; ++j4) {
                const f32x4 l = *(const LAS f32x4*)(Lmo + i * 68 + 4 * j4);
                if (4 * j4 + 0 < i) v -= l.x * a[4 * j4 + 0];
                if (4 * j4 + 1 < i) v -= l.y * a[4 * j4 + 1];
                if (4 * j4 + 2 < i) v -= l.z * a[4 * j4 + 2];
                if (4 * j4 + 3 < i) v -= l.w * a[4 * j4 + 3];
            }
            a[i] = v;
            Ainv[i * 72 + lane] = (bf16)f2bf(v);
        }
    } else {
        for (int ch = tid - 64; ch < 1024; ch += 448) *(GAS v4u*)(gop + GOP_KT + ch * 16) = *(const LAS v4u*)(lds + GP_KTT + ch * 16);
    }
    __syncthreads();
#pragma unroll 1
    for (int jj = 0; jj < 8; ++jj) {
        const int J = wave * 8 + jj;
        f32x4 acc = {0.f, 0.f, 0.f, 0.f};
        if (J < 32) {
            const int tm = J >> 3, tn = J & 7;
            const LAS bf16* ap = Ainv + (16 * tm + c16) * 72 + 8 * q4; const LAS bf16* bp = VbT + (16 * tn + c16) * 72 + 8 * q4;
#pragma unroll
            for (int ks = 0; ks < 2; ++ks) acc = mfma16(*(const LAS bf16x8*)(ap + 32 * ks), *(const LAS bf16x8*)(bp + 32 * ks), acc);
            *(GAS f32x4*)((float*)(gop + GOP_UT) + (16 * tn + c16) * 64 + 16 * tm + 4 * q4) = acc;
        } else {
            const int Jw = J - 32, tm = Jw >> 2, tn = Jw & 3;
            const LAS bf16* ap = KbgT + (16 * tm + c16) * 72 + 8 * q4; const LAS bf16* bp = Ainv + (16 * tn + c16) * 72 + 8 * q4;
#pragma unroll
            for (int ks = 0; ks < 2; ++ks) acc = mfma16(*(const LAS bf16x8*)(ap + 32 * ks), *(const LAS bf16x8*)(bp + 32 * ks), acc);
            v2u o; o.x = pk2(-acc[0], -acc[1]); o.y = pk2(-acc[2], -acc[3]);
            *(GAS v2u*)((bf16*)(gop + GOP_W) + (16 * tn + c16) * 128 + 32 * (tm >> 1) + 8 * q4 + 4 * (tm & 1)) = o;
        }
    }
    __syncthreads();
}

__device__ __forceinline__ bf16x8 pack_b(const f32x4& lo, const f32x4& hi) {
    v4u w; w.x = pg8::cvt_pk_bf16(lo[0], lo[1]); w.y = pg8::cvt_pk_bf16(lo[2], lo[3]); w.z = pg8::cvt_pk_bf16(hi[0], hi[1]); w.w = pg8::cvt_pk_bf16(hi[2], hi[3]);
    return __builtin_bit_cast(bf16x8, w);
}
__device__ __forceinline__ void gdn_scan(const KA& A, LAS unsigned char* lds, int bh, int tid, int wave, int lane) {
    unsigned char* ws = A.ws;
    const int b = bh >> 2, h = bh & 3;
    const int c16 = lane & 15, q4 = lane >> 4;
    const unsigned char* gop0 = ws + WS_GOP + (size_t)(bh * NCHUNK) * GOP_BYTES;
    const float* gl = (const float*)(ws + WS_GL) + bh * NCHUNK;
    float* gout = (float*)(ws + WS_GOUT) + (size_t)(b * SEQ) * 512 + h * 128 + 16 * wave + c16;
    f32x4 S[8];
#pragma unroll
    for (int i = 0; i < 8; ++i) S[i] = (f32x4){0.f, 0.f, 0.f, 0.f};
    v4u st[7];
#pragma unroll
    for (int i = 0; i < 7; ++i) st[i] = *(const GAS v4u*)(gop0 + (size_t)(tid + 512 * i) * 16);
#pragma unroll
    for (int i = 0; i < 7; ++i) *(LAS v4u*)(lds + (tid + 512 * i) * 16) = st[i];
    f32x4 un[4];
#pragma unroll
    for (int mt = 0; mt < 4; ++mt) un[mt] = *(const GAS f32x4*)((const float*)(gop0 + GOP_UT) + (16 * wave + c16) * 64 + 16 * mt + 4 * q4);
    __syncthreads();
#pragma unroll 1
    for (int n = 0; n < NCHUNK; ++n) {
        LAS unsigned char* cur = lds + (n & 1) * GOP_LDS;
        LAS unsigned char* nxt = lds + ((n + 1) & 1) * GOP_LDS;
        const bool has_next = (n + 1 < NCHUNK);
        const unsigned char* gn = gop0 + (size_t)(has_next ? n + 1 : n) * GOP_BYTES;
#pragma unroll
        for (int i = 0; i < 7; ++i) st[i] = *(const GAS v4u*)(gn + (size_t)(tid + 512 * i) * 16);
        f32x4 vn[4];
#pragma unroll
        for (int mt = 0; mt < 4; ++mt) vn[mt] = un[mt];
#pragma unroll
        for (int mt = 0; mt < 4; ++mt) un[mt] = *(const GAS f32x4*)((const float*)(gn + GOP_UT) + (16 * wave + c16) * 64 + 16 * mt + 4 * q4);
        const float glast = gl[n];
        bf16x8 bS[4];
#pragma unroll
        for (int s = 0; s < 4; ++s) bS[s] = pack_b(S[2 * s], S[2 * s + 1]);
        const LAS bf16* Wn = (const LAS bf16*)(cur + GOP_W) + c16 * 128 + 8 * q4;
        const LAS bf16* QD = (const LAS bf16*)(cur + GOP_QD) + c16 * 128 + 8 * q4;
        const LAS bf16* KT = (const LAS bf16*)(cur + GOP_KT) + c16 * 64 + 8 * q4;
        const LAS bf16* AI = (const LAS bf16*)(cur + GOP_AI) + c16 * 64 + 8 * q4;
        f32x4 o[4];
#pragma unroll
        for (int mt = 0; mt < 4; ++mt) {
            o[mt] = (f32x4){0.f, 0.f, 0.f, 0.f};
#pragma unroll
            for (int s = 0; s < 4; ++s) {
                vn[mt] = mfma16(*(const LAS bf16x8*)(Wn + mt * 16 * 128 + 32 * s), bS[s], vn[mt]);
                o[mt] = mfma16(*(const LAS bf16x8*)(QD + mt * 16 * 128 + 32 * s), bS[s], o[mt]);
            }
        }
        bf16x8 bV[2];
        bV[0] = pack_b(vn[0], vn[1]); bV[1] = pack_b(vn[2], vn[3]);
#pragma unroll
        for (int mt = 0; mt < 4; ++mt)
#pragma unroll
            for (int s2 = 0; s2 < 2; ++s2) if (!(s2 == 1 && mt < 2)) o[mt] = mfma16(*(const LAS bf16x8*)(AI + mt * 16 * 64 + 32 * s2), bV[s2], o[mt]);
#pragma unroll
        for (int i = 0; i < 8; ++i) {
            S[i] = S[i] * glast;
#pragma unroll
            for (int s2 = 0; s2 < 2; ++s2) S[i] = mfma16(*(const LAS bf16x8*)(KT + i * 16 * 64 + 32 * s2), bV[s2], S[i]);
        }
        float* go = gout + (size_t)(n * GCH) * 512;
#pragma unroll
        for (int mt = 0; mt < 4; ++mt)
#pragma unroll
            for (int r = 0; r < 4; ++r) go[(size_t)(16 * mt + 4 * q4 + r) * 512] = o[mt][r];
        if (has_next) {
#pragma unroll
            for (int i = 0; i < 7; ++i) *(LAS v4u*)(nxt + (tid + 512 * i) * 16) = st[i];
        }
        __syncthreads();
    }
}
__device__ __forceinline__ void mixer_post(const KA& A, int gw, int NGW, int lane) {
    unsigned char* ws = A.ws;
    float lam;
    { float a = A.in(I_LQ1)[lane] * A.in(I_LK1)[lane], c = A.in(I_LQ2)[lane] * A.in(I_LK2)[lane]; a = wave_sum(a); c = wave_sum(c); lam = __expf(a) - __expf(c) + LAMBDA_INIT; }
    const int col = lane * 8, hd = lane >> 4, dvi = (lane & 15) * 8;
    f32x4 gw0 = *(const f32x4*)(A.in(I_GNW) + dvi), gw1 = *(const f32x4*)(A.in(I_GNW) + dvi + 4);
    f32x4 dw0 = *(const f32x4*)(A.in(I_DNW) + dvi), dw1 = *(const f32x4*)(A.in(I_DNW) + dvi + 4);
    for (int m = gw; m < NTOK; m += NGW) {
        const float* go = (const float*)(ws + WS_GOUT) + (size_t)m * 512 + col;
        const f32x4 a0 = *(const GAS f32x4*)go, a1 = *(const GAS f32x4*)(go + 4);
        float ss = a0.x * a0.x + a0.y * a0.y + a0.z * a0.z + a0.w * a0.w + a1.x * a1.x + a1.y * a1.y + a1.z * a1.z + a1.w * a1.w;
        ss += __shfl_xor(ss, 1); ss += __shfl_xor(ss, 2); ss += __shfl_xor(ss, 4); ss += __shfl_xor(ss, 8);
        const float rs = rsqrtf(ss * (1.0f / 128.0f) + RMS_EPS);
        const v4u z = *(const GAS v4u*)((const bf16*)(ws + WS_GZ) + (size_t)m * 512 + col);
        float zz[8] = {bflo(z.x), bfhi(z.x), bflo(z.y), bfhi(z.y), bflo(z.z), bfhi(z.z), bflo(z.w), bfhi(z.w)};
        float ov[8] = {a0.x * gw0.x, a0.y * gw0.y, a0.z * gw0.z, a0.w * gw0.w, a1.x * gw1.x, a1.y * gw1.y, a1.z * gw1.z, a1.w * gw1.w};
#pragma unroll
        for (int i = 0; i < 8; ++i) ov[i] = ov[i] * rs * (zz[i] * sigmoidf_(zz[i]));
        v4u o; o.x = pk2(ov[0], ov[1]); o.y = pk2(ov[2], ov[3]); o.z = pk2(ov[4], ov[5]); o.w = pk2(ov[6], ov[7]);
        *(GAS v4u*)((bf16*)(ws + WS_OA) + (size_t)m * 1024 + col) = o;
        const int vh = dvi >> 6, dd = dvi & 63;
        const bf16* o16 = (const bf16*)(ws + WS_O16) + (size_t)m * 1024 + (hd * 4 + vh) * 64 + dd;
        const v4u p1 = *(const GAS v4u*)o16, p2 = *(const GAS v4u*)(o16 + 128);
        float d[8] = {bflo(p1.x) - lam * bflo(p2.x), bfhi(p1.x) - lam * bfhi(p2.x), bflo(p1.y) - lam * bflo(p2.y), bfhi(p1.y) - lam * bfhi(p2.y),
                      bflo(p1.z) - lam * bflo(p2.z), bfhi(p1.z) - lam * bfhi(p2.z), bflo(p1.w) - lam * bflo(p2.w), bfhi(p1.w) - lam * bfhi(p2.w)};
        float s2 = 0.f;
#pragma unroll
        for (int i = 0; i < 8; ++i) s2 += d[i] * d[i];
        s2 += __shfl_xor(s2, 1); s2 += __shfl_xor(s2, 2); s2 += __shfl_xor(s2, 4); s2 += __shfl_xor(s2, 8);
        const float r2 = rsqrtf(s2 * (1.0f / 128.0f) + RMS_EPS) * (1.0f - LAMBDA_INIT);
        const float dwv[8] = {dw0.x, dw0.y, dw0.z, dw0.w, dw1.x, dw1.y, dw1.z, dw1.w};
#pragma unroll
        for (int i = 0; i < 8; ++i) d[i] = d[i] * r2 * dwv[i];
        o.x = pk2(d[0], d[1]); o.y = pk2(d[2], d[3]); o.z = pk2(d[4], d[5]); o.w = pk2(d[6], d[7]);
        *(GAS v4u*)((bf16*)(ws + WS_OA) + (size_t)m * 1024 + 512 + col) = o;
    }
}

__device__ __forceinline__ void ln_pass(const float* v, const float* g, const float* bb, float* xf, bf16* xb, int gw, int NGW, int lane) {
    f32x4 gg[4], be[4];
#pragma unroll
    for (int j = 0; j < 4; ++j) { gg[j] = *(const f32x4*)(g + 4 * lane + 256 * j); be[j] = *(const f32x4*)(bb + 4 * lane + 256 * j); }
    for (int m = gw; m < NTOK; m += NGW) {
        const GAS f32x4* xr = (const GAS f32x4*)(v + (size_t)m * 1024) + lane;
        f32x4 x[4]; float s = 0.f;
#pragma unroll
        for (int j = 0; j < 4; ++j) { x[j] = xr[64 * j]; s += (x[j].x + x[j].y) + (x[j].z + x[j].w); }
        const float mean = wave_sum(s) * (1.f / 1024.f); float s2 = 0.f;
#pragma unroll
        for (int j = 0; j < 4; ++j) { x[j] = x[j] - mean; s2 += (x[j].x * x[j].x + x[j].y * x[j].y) + (x[j].z * x[j].z + x[j].w * x[j].w); }
        const float rstd = rsqrtf(wave_sum(s2) * (1.f / 1024.f) + LN_EPS);
#pragma unroll
        for (int j = 0; j < 4; ++j) {
            const f32x4 y = x[j] * rstd * gg[j] + be[j];
            *((GAS f32x4*)(xf + (size_t)m * 1024) + lane + 64 * j) = y;
            if (xb) { v2u o; o.x = pk2(y.x, y.y); o.y = pk2(y.z, y.w); *((GAS v2u*)(xb + (size_t)m * 1024) + lane + 64 * j) = o; }
        }
    }
}

__device__ __forceinline__ void moe_route(const KA& A, LAS unsigned char* lds, int gw, int NGW, int tid, int lane) {
    unsigned char* ws = A.ws;
    LAS float* rw = (LAS float*)lds;
    LAS unsigned* hist = (LAS unsigned*)(lds + MISC_OFF);
    for (int i = tid; i < 1024 * 32 / 4; i += 512) *((LAS f32x4*)rw + i) = *((const f32x4*)A.in(I_RW) + i);
    if (tid < 32) hist[tid] = 0u;
    __syncthreads();
    const float* x2 = A.out();
    const float rbias = A.in(I_RB)[lane & 31];
    const int wv = tid >> 6;
    for (int grp = gw / NWAVES; grp < NTOK / 64; grp += NGW / NWAVES) {
    if (tid < 32) hist[tid] = 0u;
    __syncthreads();
    for (int m = grp * 64 + wv * 8; m < grp * 64 + wv * 8 + 8; ++m) {
        float acc[32];
#pragma unroll
        for (int e = 0; e < 32; ++e) acc[e] = 0.f;
#pragma unroll
        for (int j = 0; j < 4; ++j) {
            const int col = 4 * lane + 256 * j; const f32x4 v = *(const GAS f32x4*)(x2 + (size_t)m * 1024 + col);
            const float xv[4] = {v.x, v.y, v.z, v.w};
#pragma unroll
            for (int k = 0; k < 4; ++k) {
                const LAS f32x4* wr = (const LAS f32x4*)(rw + (col + k) * 32);
#pragma unroll
                for (int e4 = 0; e4 < 8; ++e4) { const f32x4 w = wr[e4]; acc[4 * e4] += xv[k] * w.x; acc[4 * e4 + 1] += xv[k] * w.y; acc[4 * e4 + 2] += xv[k] * w.z; acc[4 * e4 + 3] += xv[k] * w.w; }
            }
        }
#pragma unroll
        for (int w = 16; w >= 1; w >>= 1) {
            const bool up = (lane & w) != 0;
#pragma unroll
            for (int i = 0; i < w; ++i) { const float send = up ? acc[i] : acc[i + w]; const float keep = up ? acc[i + w] : acc[i]; acc[i] = keep + __shfl_xor(send, w); }
        }
        float mine = acc[0] + __shfl_xor(acc[0], 32);
        mine += rbias;
        float tv[4]; int ti[4];
        float cur = mine;
#pragma unroll
        for (int k = 0; k < 4; ++k) {
            float best = cur; int bi = lane & 31;
#pragma unroll
            for (int o = 1; o < 32; o <<= 1) { const float ov = __shfl_xor(best, o); const int oi = __shfl_xor(bi, o); if (ov > best || (ov == best && oi < bi)) { best = ov; bi = oi; } }
            tv[k] = best; ti[k] = bi;
            if ((lane & 31) == bi) cur = -INFINITY;
        }
        const float e1 = __expf(tv[1] - tv[0]), e2 = __expf(tv[2] - tv[0]), e3 = __expf(tv[3] - tv[0]);
        const float inv = 1.0f / (1.0f + e1 + e2 + e3);
        if (lane == 0) {
            *(GAS v4u*)((int*)(ws + WS_TOPI) + (size_t)m * 4) = (v4u){(unsigned)ti[0], (unsigned)ti[1], (unsigned)ti[2], (unsigned)ti[3]};
            *(GAS f32x4*)((float*)(ws + WS_GATE) + (size_t)m * 4) = (f32x4){inv, e1 * inv, e2 * inv, e3 * inv};
            for (int k = 0; k < 4; ++k) __hip_atomic_fetch_add(&hist[ti[k]], 1u, __ATOMIC_RELAXED, __HIP_MEMORY_SCOPE_WORKGROUP);
        }
    }
    __syncthreads();
    if (tid < 32) { ((unsigned*)(ws + WS_GCNT))[grp * 32 + tid] = hist[tid]; if (hist[tid]) atomicAdd((unsigned*)(ws + WS_CTL) + CW_CNT + tid, hist[tid]); }
    __syncthreads();
    }
}

__device__ __forceinline__ void moe_layout(const KA& A, LAS unsigned char* lds, int tid) {
    LAS int* T = (LAS int*)(lds + MISC_OFF + 256);
    if (tid == 0) {
        const unsigned* cnt = (const unsigned*)(A.ws + WS_CTL) + CW_CNT;
        int row = 0;
        for (int e = 0; e < 32; ++e) {
            const int c = (int)__hip_atomic_load(cnt + e, __ATOMIC_RELAXED, __HIP_MEMORY_SCOPE_AGENT); const int nt = (c + 255) >> 8;
            T[e] = row; for (int t = 0; t < nt; ++t) T[64 + (row >> 8) + t] = e; row += nt * 256;
        }
        T[32] = row >> 8;
    }
    __syncthreads();
}

__device__ __forceinline__ void moe_scatter(const KA& A, LAS unsigned char* lds, int blk, int G, int tid, int wave, int lane) {
    unsigned char* ws = A.ws;
    LAS int* T = (LAS int*)(lds + MISC_OFF + 256);
    LAS unsigned* lc = (LAS unsigned*)(lds);
    const float* x2 = A.out();
    for (int grp = blk; grp < NTOK / 64; grp += G) {
        int e = 0;
        if (tid < 256) { e = ((const int*)(ws + WS_TOPI))[(size_t)grp * 256 + tid]; lc[320 + tid] = (unsigned)e; }
        if (tid < 32) { unsigned b = 0; const unsigned* gc = (const unsigned*)(ws + WS_GCNT) + tid; for (int g2 = 0; g2 < grp; ++g2) b += gc[g2 * 32]; lc[32 + tid] = b; }
        __syncthreads();
        if (tid < 256) { unsigned rank = 0; for (int a2 = 0; a2 < tid; ++a2) rank += (lc[320 + a2] == (unsigned)e) ? 1u : 0u;
            const int slot = T[e] + (int)lc[32 + e] + (int)rank; lc[64 + tid] = (unsigned)slot; ((int*)(ws + WS_DEST))[(size_t)grp * 256 + tid] = slot; }
        __syncthreads();
#pragma unroll 1
        for (int t = 0; t < 8; ++t) {
            const int tl = wave * 8 + t; const size_t m = (size_t)grp * 64 + tl;
            v2u o[4];
#pragma unroll
            for (int j = 0; j < 4; ++j) { const f32x4 v = *(const GAS f32x4*)(x2 + m * 1024 + 4 * lane + 256 * j); o[j].x = pk2(v.x, v.y); o[j].y = pk2(v.z, v.w); }
#pragma unroll
            for (int k = 0; k < 4; ++k) { bf16* d = (bf16*)(ws + WS_XS) + (size_t)lc[64 + tl * 4 + k] * 1024;
#pragma unroll
                for (int j = 0; j < 4; ++j) *(GAS v2u*)(d + 4 * lane + 256 * j) = o[j]; }
        }
        __syncthreads();
    }
}

__device__ __forceinline__ void moe_combine(const KA& A, int gw, int NGW, int lane) {
    unsigned char* ws = A.ws;
    f32x4 gg[4], be[4];
#pragma unroll
    for (int j = 0; j < 4; ++j) { gg[j] = *(const f32x4*)(A.in(I_LN3G) + 4 * lane + 256 * j); be[j] = *(const f32x4*)(A.in(I_LN3B) + 4 * lane + 256 * j); }
    for (int m = gw; m < NTOK; m += NGW) {
        const v4u dst = *(const GAS v4u*)((const int*)(ws + WS_DEST) + (size_t)m * 4);
        const f32x4 gt = *(const GAS f32x4*)((const float*)(ws + WS_GATE) + (size_t)m * 4);
        const unsigned dd[4] = {dst.x, dst.y, dst.z, dst.w}; const float gk[4] = {gt.x, gt.y, gt.z, gt.w};
        f32x4 x[4]; float s = 0.f;
#pragma unroll
        for (int j = 0; j < 4; ++j) {
            f32x4 v = *((const GAS f32x4*)(A.out() + (size_t)m * 1024) + lane + 64 * j) * DN_ALPHA;
#ifndef SKIP_MOE
#pragma unroll
            for (int k = 0; k < 4; ++k) { const v2u y = *((const GAS v2u*)((const bf16*)(ws + WS_Y) + (size_t)dd[k] * 1024) + lane + 64 * j);
                v.x += gk[k] * bflo(y.x); v.y += gk[k] * bfhi(y.x); v.z += gk[k] * bflo(y.y); v.w += gk[k] * bfhi(y.y); }
#endif
            x[j] = v; s += (v.x + v.y) + (v.z + v.w);
        }
        const float mean = wave_sum(s) * (1.f / 1024.f); float s2 = 0.f;
#pragma unroll
        for (int j = 0; j < 4; ++j) { x[j] = x[j] - mean; s2 += (x[j].x * x[j].x + x[j].y * x[j].y) + (x[j].z * x[j].z + x[j].w * x[j].w); }
        const float rstd = rsqrtf(wave_sum(s2) * (1.f / 1024.f) + LN_EPS);
#pragma unroll
        for (int j = 0; j < 4; ++j) *((GAS f32x4*)(A.out() + (size_t)m * 1024) + lane + 64 * j) = x[j] * rstd * gg[j] + be[j];
    }
}
struct InprojMap { unsigned char* ws;
    __device__ __forceinline__ pg8::TileDst operator()(const pg8::Unit& u) const {
        pg8::TileDst d; d.bias = nullptr; d.scale = 1.f; const size_t r0 = (size_t)u.pm * 256; const int pn = u.pn;
        if (pn < 6) { d.base = (bf16*)(ws + WS_GQKV) + r0 * 1536 + pn * 256; d.ldc = 1536; }
        else if (pn < 8) { d.base = (bf16*)(ws + WS_GZ) + r0 * 512 + (pn - 6) * 256; d.ldc = 512; }
        else { const int w = (pn - 8) >> 1; d.base = (bf16*)(ws + (w == 0 ? WS_DQ : (w == 1 ? WS_DK : WS_DV))) + r0 * 512 + ((pn - 8) & 1) * 256; d.ldc = 512; if (w == 0) d.scale = attn_body::C2; }
        return d; } };
struct KvMap { unsigned char* ws;
    __device__ __forceinline__ pg8::TileDst operator()(const pg8::Unit& u) const {
        pg8::TileDst d; d.bias = nullptr; d.scale = 1.f; d.ldc = 256;
        d.base = (bf16*)(ws + ((u.pn >> 2) ? WS_VMAT : WS_KMAT)) + (size_t)((u.pm * 4 + (u.pn & 3)) * 256) * 256; return d; } };
struct WqkMap { unsigned char* ws;
    __device__ __forceinline__ pg8::TileDst operator()(const pg8::Unit& u) const {
        pg8::TileDst d; d.bias = nullptr; d.scale = 0.0625f * 1.4426950408889634f; d.ldc = 1024;
        d.base = (bf16*)(ws + WS_WQK) + (size_t)(u.pm >> 2) * 1048576 + (size_t)((u.pm & 3) * 256) * 1024 + (u.pn & 3) * 256; return d; } };
struct VwoMap { unsigned char* ws;
    __device__ __forceinline__ pg8::TileDst operator()(const pg8::Unit& u) const {
        pg8::TileDst d; d.bias = nullptr; d.scale = 1.f; d.ldc = 1024;
        d.base = (bf16*)(ws + WS_VWO) + (size_t)(u.pn >> 2) * 1048576 + (size_t)((u.pm & 3) * 256) * 1024 + (u.pm >> 2) * 256; return d; } };
struct DownMap { unsigned char* ws; const float* bd;
    __device__ __forceinline__ pg8::TileDst operator()(const pg8::Unit& u) const {
        pg8::TileDst d; d.scale = 1.f; d.ldc = 1024; const int e = u.pn >> 2, pnl = u.pn & 3;
        d.base = (bf16*)(ws + WS_Y) + (size_t)u.pm * 256 * 1024 + pnl * 256; d.bias = bd + e * 1024 + pnl * 256; return d; } };

#ifndef MK_N_LAUNCHES
#define MK_N_LAUNCHES 1
#endif
constexpr int N_PHASES = 17;
__global__ void __launch_bounds__(NWAVES * 64, 2) hybrid_fwd(Args args) {
    extern __shared__ __attribute__((aligned(16))) unsigned char lds_raw[];
    LAS unsigned char* lds = (LAS unsigned char*)lds_raw;
    const int G = gridDim.x, blk = blockIdx.x, NGW = G * NWAVES;
#define PH_IDS int tid = threadIdx.x; asm volatile("" : "+v"(tid)); const int lane = tid & 63, wave = __builtin_amdgcn_readfirstlane(tid >> 6), gw = blk * NWAVES + wave; (void)lane; (void)gw
    const __attribute__((address_space(4))) unsigned char* kap = (const __attribute__((address_space(4))) unsigned char*)__builtin_amdgcn_kernarg_segment_ptr();
    unsigned char* ws = *(unsigned char* const __attribute__((address_space(4)))*)(kap + 256);
    const int lo = *(const __attribute__((address_space(4))) int*)(kap + 264), hi = *(const __attribute__((address_space(4))) int*)(kap + 268);
    const KA KAv{ws};
    cg::grid_group grid = cg::this_grid();
#ifndef PH_MASK
#define PH_MASK 0xFFFFF
#endif
#define IN(k) ((((PH_MASK) >> (k)) & 1) && lo <= (k) && (k) < hi)
#define SEAM(k) do { if (IN(k) && IN((k) + 1)) grid.sync(); } while (0)

    if (IN(0)) { PH_IDS; p0_prologue(KAv, lds, gw, NGW, wave, lane, tid); }
    SEAM(0);
    if (IN(1)) {
        { pg8::Gemm g{(const bf16*)(ws + WS_XB), (const bf16*)(ws + WS_WIN), NTOK, INP_N, 1024}; pg8::StaticOrder S; S.init(NTOK, INP_N, G, blk);
          pg8::EpiBf16Map<InprojMap> E{InprojMap{ws}};
          pg8::gemm_phase<pg8::EpiBf16Map<InprojMap>, pg8::StaticOrder, true, true>(lds, g, S, E); }
        { pg8::Gemm g{(const bf16*)(ws + WS_MEMB), (const bf16*)(ws + WS_WKV), NB * NMEM, 2048, 1024}; pg8::StaticOrder S; S.init(NB * NMEM, 2048, G, blk);
          pg8::EpiBf16Map<KvMap> E{KvMap{ws}};
          pg8::gemm_phase<pg8::EpiBf16Map<KvMap>, pg8::StaticOrder, true, true>(lds, g, S, E); }
    }
    SEAM(1);
    if (IN(2)) { PH_IDS;
#ifndef P2_PARTS
#define P2_PARTS 7
#endif
        if (P2_PARTS & 1) for (int u = blk; u < NB * 4 * NCHUNK; u += G) gdn_prep_unit(KAv, lds, u, tid);
        if (P2_PARTS & 2) { pg8::Gemm g{(const bf16*)(ws + WS_KMAT), (const bf16*)(ws + WS_WQH), 2048, 4096, 256}; pg8::WqkOrder S{G, blk};
          pg8::EpiBf16Map<WqkMap> E{WqkMap{ws}};
          pg8::gemm_phase<pg8::EpiBf16Map<WqkMap>, pg8::WqkOrder, true, true>(lds, g, S, E); }
        if (P2_PARTS & 4) { pg8::Gemm g{(const bf16*)(ws + WS_WOH), (const bf16*)(ws + WS_VMAT), 4096, 2048, 256}; pg8::VwoOrder S{G, blk};
          pg8::EpiBf16Map<VwoMap> E{VwoMap{ws}};
          pg8::gemm_phase<pg8::EpiBf16Map<VwoMap>, pg8::VwoOrder, true, true>(lds, g, S, E); }
    }
    SEAM(2);
    if (IN(3)) { PH_IDS;
        const attn_body::AttnTensors AT{(const attn_body::bf16*)(ws + WS_DQ), (const attn_body::bf16*)(ws + WS_DK), (const attn_body::bf16*)(ws + WS_DV), (attn_body::bf16*)(ws + WS_O16)};
        const attn_body::StaticOrder S(G, blk);
        attn_body::attn_phase<attn_body::StaticOrder>((char*)lds_raw, AT, S);
        __syncthreads();
        if (blk < NB * 4) gdn_scan(KAv, lds, blk, tid, wave, lane);
    }
    SEAM(3);
    if (IN(4)) { PH_IDS; mixer_post(KAv, gw, NGW, lane); }
    SEAM(4);
    if (IN(5)) {
        pg8::Gemm g{(const bf16*)(ws + WS_OA), (const bf16*)(ws + WS_WOUT), NTOK, 1024, 1024}; pg8::StaticOrder S; S.init(NTOK, 1024, G, blk);
        pg8::EpiF32Res E{KAv.in(I_X), (float*)(ws + WS_V1), DN_ALPHA};
        pg8::gemm_phase<pg8::EpiF32Res, pg8::StaticOrder, true, true>(lds, g, S, E);
    }
    SEAM(5);
    if (IN(6)) { PH_IDS; ln_pass((const float*)(ws + WS_V1), KAv.in(I_LN1G), KAv.in(I_LN1B), (float*)(ws + WS_X1F), (bf16*)(ws + WS_X1B), gw, NGW, lane); }
    SEAM(6);
    if (IN(7)) {
        pg8::Gemm g{(const bf16*)(ws + WS_X1B), (const bf16*)(ws + WS_WQK), NTOK, 1024, 1024}; pg8::BatchOrder S; S.init(NTOK, 1024, G, blk);
        pg8::EpiSoftmax E{(bf16*)(ws + WS_PM)};
        pg8::gemm_phase<pg8::EpiSoftmax, pg8::BatchOrder, false, true>(lds, g, S, E);
    }
    SEAM(7);
    if (IN(8)) {
        pg8::Gemm g{(const bf16*)(ws + WS_PM), (const bf16*)(ws + WS_VWO), NTOK, 1024, 1024}; pg8::BatchOrder S; S.init(NTOK, 1024, G, blk);
        pg8::EpiF32Res E{(const float*)(ws + WS_X1F), (float*)(ws + WS_V1), DN_ALPHA};
        pg8::gemm_phase<pg8::EpiF32Res, pg8::BatchOrder, true, true>(lds, g, S, E);
    }
    SEAM(8);
    if (IN(9)) { PH_IDS; ln_pass((const float*)(ws + WS_V1), KAv.in(I_LN2G), KAv.in(I_LN2B), KAv.out(), nullptr, gw, NGW, lane); }
    SEAM(9);
    if (IN(10)) { PH_IDS; moe_route(KAv, lds, gw, NGW, tid, lane); }
    SEAM(10);
    if (IN(11)) { PH_IDS; moe_layout(KAv, lds, tid); moe_scatter(KAv, lds, blk, G, tid, wave, lane); }
    SEAM(11);
    if (IN(12)) { PH_IDS;
        if (!IN(11)) moe_layout(KAv, lds, tid);
        const LAS int* T = (const LAS int*)(lds + MISC_OFF + 256);
        pg8::Gemm g{(const bf16*)(ws + WS_XS), (const bf16*)(ws + WS_WGU), MOE_MAXROWS, NEXP * 2048, 1024};
        pg8::MoeOrder S{G, blk, 8, __builtin_amdgcn_readfirstlane(T[32]), T + 64};
        pg8::EpiSwiglu E{(bf16*)(ws + WS_H), KAv.in(I_EBG), KAv.in(I_EBU)};
        pg8::gemm_phase<pg8::EpiSwiglu, pg8::MoeOrder, true, true>(lds, g, S, E);
    }
    SEAM(12);
    if (IN(13)) { PH_IDS;
        if (!IN(11)) moe_layout(KAv, lds, tid);
        const LAS int* T = (const LAS int*)(lds + MISC_OFF + 256);
        pg8::Gemm g{(const bf16*)(ws + WS_H), (const bf16*)(ws + WS_WD), MOE_MAXROWS, NEXP * 1024, 1024};
        pg8::MoeOrder S{G, blk, 4, __builtin_amdgcn_readfirstlane(T[32]), T + 64};
        pg8::EpiBf16Map<DownMap> E{DownMap{ws, KAv.in(I_EBD)}};
        pg8::gemm_phase<pg8::EpiBf16Map<DownMap>, pg8::MoeOrder, true, true>(lds, g, S, E);
    }
    SEAM(13);
    if (IN(14)) { PH_IDS; moe_combine(KAv, gw, NGW, lane); }
#undef IN
#undef SEAM
}

extern "C" void kernel_launch(void* const* d_in, const int* in_sizes, int n_in, void* d_out, int out_size, void* d_ws, size_t ws_size, hipStream_t stream) {
    static int grid = 0;
    if (grid == 0) {
        if (n_in != 31 || out_size != NTOK * DM || ws_size < WS_END) { fprintf(stderr, "kernel_launch: unexpected shapes (n_in %d, out %d, ws %zu)\n", n_in, out_size, ws_size); grid = -1; return; }
        int dev = 0, cus = 0, per_cu = 0;
        if (hipGetDevice(&dev) != hipSuccess || hipDeviceGetAttribute(&cus, hipDeviceAttributeMultiprocessorCount, dev) != hipSuccess) { grid = -1; return; }
        if (hipFuncSetAttribute((const void*)hybrid_fwd, hipFuncAttributeMaxDynamicSharedMemorySize, LDS_BYTES) != hipSuccess) { fprintf(stderr, "kernel_launch: hipFuncSetAttribute failed\n"); grid = -1; return; }
        if (hipOccupancyMaxActiveBlocksPerMultiprocessor(&per_cu, (const void*)hybrid_fwd, NWAVES * 64, LDS_BYTES) != hipSuccess || per_cu < 1) { fprintf(stderr, "kernel_launch: occupancy query says %d blocks per CU\n", per_cu); (void)hipGetLastError(); per_cu = 1; }
        grid = cus;
        if (grid != 256) fprintf(stderr, "kernel_launch: %d CUs; the fused softmax epilogue assumes 256\n", grid);
    }
    if (grid < 0) return;
    (void)hipMemsetAsync((char*)d_ws + WS_CTL, 0, CTL_ZERO_BYTES, stream);
    Args a{};
    for (int i = 0; i < 31; ++i) a.in[i] = (const float*)d_in[i];
    a.out = (float*)d_out; a.ws = (unsigned char*)d_ws;
#if MK_N_LAUNCHES == 1
    a.ph_lo = 0; a.ph_hi = N_PHASES;
    void* kargs[] = {&a};
    hipError_t e = hipLaunchCooperativeKernel((const void*)hybrid_fwd, dim3(grid), dim3(NWAVES * 64), kargs, LDS_BYTES, stream);
    if (e != hipSuccess) fprintf(stderr, "cooperative launch failed: %s (grid %d)\n", hipGetErrorString(e), grid);
#else
    for (int p = 0; p < 15; ++p) {
        a.ph_lo = p; a.ph_hi = p + 1;
        hipLaunchKernelGGL(hybrid_fwd, dim3(grid), dim3(NWAVES * 64), LDS_BYTES, stream, a);
    }
#endif
}
```

```cpp
#include <hip/hip_runtime.h>
#include <hip/hip_cooperative_groups.h>
#include <cstdio>
#include <cstdint>
namespace cg = cooperative_groups;
namespace pg8 {
#define PG8_LAS __attribute__((address_space(3)))
typedef unsigned short bf16_t;
typedef short bf16x8 __attribute__((ext_vector_type(8)));
typedef float f32x4 __attribute__((ext_vector_type(4)));
typedef unsigned u32x4 __attribute__((ext_vector_type(4)));
constexpr int BM = 256, BK = 64, HALF = 128, HTB = HALF * BK * 2  , STAGE_BYTES = 8 * HTB, NXCD = 8, WGM = 8;

__host__ __device__ __forceinline__ int lds_byte(int r, int c) { const int st = (r >> 4) * 2 + (c >> 5), rr = r & 15, cc = c & 31, ob = rr * 64 + cc * 2; return st * 1024 + (ob ^ (((ob >> 9) & 1) << 5)); }
__host__ __device__ __forceinline__ void stage_rc(int b, int& R, int& C) { const int st = b / 1024, sb = b % 1024, swz = sb ^ (((sb >> 9) & 1) << 5); R = (st >> 1) * 16 + swz / 64; C = (st & 1) * 32 + (swz % 64) / 2; }
__host__ __device__ __forceinline__ int perm32(int rho) { const int n = rho >> 4, i = rho & 15; return 8 * (i >> 2) + 4 * n + (i & 3); }

struct Unit { int pm, pn; };
struct Gemm { const bf16_t* A; const bf16_t* Bt; int M, N, K; const int* gtab = nullptr; };

struct StaticOrder {
    int nM, nN, nwg, G, c;
    __host__ __device__ void init(int M, int N, int G_, int c_) { nM = M / BM; nN = N / BM; nwg = nM * nN; G = G_; c = c_; }
    __host__ __device__ bool next(int i, Unit& u) const {
        const long L = (long)i * G + c; if (L >= nwg) return false;
        int wgid = (int)L; { const int q = nwg / NXCD, r = nwg % NXCD, xcd = wgid % NXCD, off = wgid / NXCD; wgid = (xcd < r ? xcd * (q + 1) : r * (q + 1) + (xcd - r) * q) + off; }
        const int nig = WGM * nN, gid = wgid / nig, fm = gid * WGM, gsz = (nM - fm) < WGM ? (nM - fm) : WGM;
        u.pm = fm + ((wgid % nig) % gsz); u.pn = (wgid % nig) / gsz; return true;
    }
    __device__ __forceinline__ void a_ready(const Unit&) const {}
    __device__ __forceinline__ void done(const Unit&) const {}
};

__device__ __forceinline__ unsigned cvt_pk_bf16(float lo, float hi) { unsigned r; asm volatile("v_cvt_pk_bf16_f32 %0, %1, %2" : "=v"(r) : "v"(lo), "v"(hi)); return r; }
typedef float f32x2 __attribute__((ext_vector_type(2)));
__device__ __forceinline__ f32x2 gelu_pk(f32x2 v) {
    const f32x2 av = __builtin_elementwise_abs(v), d = av * 0.2316418882f + 1.0f;
    f32x2 t; t.x = __builtin_amdgcn_rcpf(d.x); t.y = __builtin_amdgcn_rcpf(d.y);
    f32x2 q = t * 0.5307027145f + (-0.7265760135f); q = q * t + 0.7107068705f; q = q * t + (-0.142248368f); q = q * t + 0.127414796f; q = q * t;
    const f32x2 s = (v * v) * (-0.72134752044f);
    f32x2 e; e.x = __builtin_amdgcn_exp2f(s.x); e.y = __builtin_amdgcn_exp2f(s.y);
    const f32x2 m = v * (q * e), r = v - m;
    f32x2 o; o.x = v.x < 0.f ? m.x : r.x; o.y = v.y < 0.f ? m.y : r.y; return o;
}

template <int ACT  > struct EpiBf16 {
    static constexpr bool PERM = true, AFTER_DRAIN = false; static_assert(ACT == 0 || ACT == 1, "EpiBf16: ACT is 0 (none) or 1 (gelu_pk)");
    bf16_t* O; int ldc; const float* bias; int split_cols; size_t split_stride; float scale0;
    __device__ __forceinline__ void operator()(const f32x4 (&acc)[2][2][4][2], const Unit& u, int wr, int wc, int fr, int fq) const {
        const int row0 = u.pm * BM + wr * 64 + fr; int colt = u.pn * BM; bf16_t* base = O;
        float sc = 1.f; if (split_cols) { const int t = colt / split_cols; base += (size_t)t * split_stride; colt -= t * split_cols; if (t == 0) sc = scale0; }
        const int col0 = colt + wc * 32 + 8 * fq, bcol0 = u.pn * BM + wc * 32 + 8 * fq;
        f32x4 bv[2][2];
#pragma unroll
        for (int bj = 0; bj < 2; ++bj)
#pragma unroll
            for (int n = 0; n < 2; ++n) bv[bj][n] = bias ? *(const f32x4*)(bias + bcol0 + bj * HALF + 4 * n) : (f32x4){0.f, 0.f, 0.f, 0.f};
#pragma unroll
        for (int ai = 0; ai < 2; ++ai)
#pragma unroll
            for (int m = 0; m < 4; ++m) { bf16_t* rowp = base + (size_t)(row0 + ai * HALF + m * 16) * ldc + col0;
#pragma unroll
                for (int bj = 0; bj < 2; ++bj) { f32x4 v0 = acc[ai][bj][m][0] + bv[bj][0], v1 = acc[ai][bj][m][1] + bv[bj][1];
                    if (ACT == 1) { f32x2 a = gelu_pk((f32x2){v0[0], v0[1]}), b = gelu_pk((f32x2){v0[2], v0[3]}), c = gelu_pk((f32x2){v1[0], v1[1]}), d = gelu_pk((f32x2){v1[2], v1[3]});
                        v0 = (f32x4){a.x, a.y, b.x, b.y}; v1 = (f32x4){c.x, c.y, d.x, d.y}; }
                    v0 = v0 * sc; v1 = v1 * sc; u32x4 w; w.x = cvt_pk_bf16(v0[0], v0[1]); w.y = cvt_pk_bf16(v0[2], v0[3]); w.z = cvt_pk_bf16(v1[0], v1[1]); w.w = cvt_pk_bf16(v1[2], v1[3]);
                    *(u32x4*)(rowp + bj * HALF) = w; } }
    }
};

struct PanelStats {
    unsigned* xbuf;
    unsigned* cnt;
    unsigned* tmo;
    int ntn; float eps;
    unsigned code;
    __device__ __forceinline__ bool run(const f32x4 (&v)[2][2][4][2], const Unit& u, int wr, int wc, int fr, int fq, PG8_LAS unsigned char* lds, int wid, int lane) const {
        typedef float f32x2v __attribute__((ext_vector_type(2)));
        PG8_LAS f32x2v* P = (PG8_LAS f32x2v*)lds;
        PG8_LAS f32x2v* S = (PG8_LAS f32x2v*)(lds + 8192);
        PG8_LAS unsigned* flag = (PG8_LAS unsigned*)(lds + 8192 + 2048);
#pragma unroll
        for (int ai = 0; ai < 2; ++ai)
#pragma unroll
            for (int m = 0; m < 4; ++m) {
                float s = 0.f;
#pragma unroll
                for (int bj = 0; bj < 2; ++bj)
#pragma unroll
                    for (int n = 0; n < 2; ++n) { const f32x4 x = v[ai][bj][m][n]; s += (x[0] + x[1]) + (x[2] + x[3]); }
                s += __shfl_xor(s, 16); s += __shfl_xor(s, 32);
                const float mw = s * (1.0f / 64.0f); float q = 0.f;
#pragma unroll
                for (int bj = 0; bj < 2; ++bj)
#pragma unroll
                    for (int n = 0; n < 2; ++n) { const f32x4 d = v[ai][bj][m][n] - mw; q += (d[0] * d[0] + d[1] * d[1]) + (d[2] * d[2] + d[3] * d[3]); }
                q += __shfl_xor(q, 16); q += __shfl_xor(q, 32);
                if (fq == 0) P[(ai * HALF + wr * 64 + m * 16 + fr) * 4 + wc] = (f32x2v){mw, q};
            }
        asm volatile("s_waitcnt lgkmcnt(0)" ::: "memory"); __builtin_amdgcn_s_barrier(); asm volatile("" ::: "memory");
#if defined(BROKEN_EXCHANGE_NO_WAIT)
#warning BROKEN CONTROL BUILD: the row-statistics exchange does not wait; results are wrong by design
        if (blockIdx.x >= 64) { const long long t0_ = clock64(); while (clock64() - t0_ < 60000) __builtin_amdgcn_s_sleep(8); }
#endif
        const int row = wid * 32 + (lane & 31);
        if (lane < 32) {
            const f32x2v a = P[row * 4 + 0], b = P[row * 4 + 1], c = P[row * 4 + 2], d = P[row * 4 + 3];
            const float mt = (a.x + b.x + c.x + d.x) * 0.25f;
            const float da = a.x - mt, db = b.x - mt, dc = c.x - mt, dd = d.x - mt;
            const float m2 = (a.y + b.y) + (c.y + d.y) + 64.0f * ((da * da + db * db) + (dc * dc + dd * dd));
            unsigned long long* slot = (unsigned long long*)xbuf + ((size_t)(u.pm * BM + row) * 4 + u.pn);
            __hip_atomic_store(slot, ((unsigned long long)__float_as_uint(m2) << 32) | __float_as_uint(mt), __ATOMIC_RELAXED, __HIP_MEMORY_SCOPE_AGENT);
        }
        asm volatile("s_waitcnt vmcnt(0)" ::: "memory");
        if (lane == 0) __hip_atomic_fetch_add(cnt + 64 * u.pm, 1u, __ATOMIC_RELAXED, __HIP_MEMORY_SCOPE_AGENT);
        if (wid == 0) {
            bool dead = false; const unsigned long long t0 = __builtin_amdgcn_s_memrealtime(); const unsigned want = 8u * (unsigned)ntn;
            for (;;) {
#if defined(BROKEN_EXCHANGE_NO_WAIT)
                break;
#endif
                if ((unsigned)__builtin_amdgcn_readfirstlane(__hip_atomic_load(cnt + 64 * u.pm, __ATOMIC_RELAXED, __HIP_MEMORY_SCOPE_AGENT)) >= want) break;
                if (__builtin_amdgcn_s_memrealtime() - t0 > 2000000ull) {
                    if (lane == 0) { unsigned expect = 0u; __hip_atomic_compare_exchange_strong(tmo + 1, &expect, code | (unsigned)(u.pm & 0xff), __ATOMIC_RELAXED, __ATOMIC_RELAXED, __HIP_MEMORY_SCOPE_AGENT);
                                     __hip_atomic_store(tmo, 1u, __ATOMIC_RELAXED, __HIP_MEMORY_SCOPE_AGENT); }
                    dead = true; break; }
                __builtin_amdgcn_s_sleep(2);
            }
            __builtin_amdgcn_fence(__ATOMIC_ACQUIRE, "agent");
            if (lane == 0) flag[0] = dead ? 1u : 0u;
        }
        asm volatile("s_waitcnt vmcnt(0) lgkmcnt(0)" ::: "memory"); __builtin_amdgcn_s_barrier(); asm volatile("" ::: "memory");
        const bool bad = flag[0] != 0u;
        if (lane < 32) {
            const unsigned long long* slot = (const unsigned long long*)xbuf + (size_t)(u.pm * BM + row) * 4; float mt[4], m2[4]; float ms = 0.f;
#pragma unroll
            for (int t = 0; t < 4; ++t) { if (t < ntn) { const unsigned long long w = __hip_atomic_load(slot + t, __ATOMIC_RELAXED, __HIP_MEMORY_SCOPE_AGENT); mt[t] = __uint_as_float((unsigned)w); m2[t] = __uint_as_float((unsigned)(w >> 32)); } else { mt[t] = 0.f; m2[t] = 0.f; } ms += mt[t]; }
            const float mean = ms / (float)ntn; float q = 0.f;
#pragma unroll
            for (int t = 0; t < 4; ++t) if (t < ntn) { const float dm = mt[t] - mean; q += m2[t] + 256.0f * dm * dm; }
            S[row] = (f32x2v){mean, 1.0f / sqrtf(q / (256.0f * (float)ntn) + eps)};
        }
        asm volatile("s_waitcnt lgkmcnt(0)" ::: "memory"); __builtin_amdgcn_s_barrier(); asm volatile("" ::: "memory");
        return bad;
    }
};
struct EpiLnRes {
    static constexpr bool PERM = false, AFTER_DRAIN = true;
    const float* base; float* out; int ldc; const float* bias; PanelStats st; unsigned poison;
    __device__ __forceinline__ void fused(f32x4 (&acc)[2][2][4][2], const Unit& u, int wr, int wc, int fr, int fq, PG8_LAS unsigned char* lds, int wid, int lane) const {
        typedef float f32x2v __attribute__((ext_vector_type(2)));
        const PG8_LAS f32x2v* S = (const PG8_LAS f32x2v*)(lds + 8192);
        const int col0 = u.pn * BM + wc * 32 + 4 * fq;
#pragma unroll
        for (int bj = 0; bj < 2; ++bj)
#pragma unroll
            for (int n = 0; n < 2; ++n) { const f32x4 bv = bias ? *(const f32x4*)(bias + col0 + bj * HALF + n * 16) : (f32x4){0.f, 0.f, 0.f, 0.f};
#pragma unroll
                for (int ai = 0; ai < 2; ++ai)
#pragma unroll
                    for (int m = 0; m < 4; ++m) acc[ai][bj][m][n] += bv; }
        f32x4 pre[4][2][2];
#pragma unroll
        for (int m = 0; m < 4; ++m) { const size_t off = (size_t)(u.pm * BM + wr * 64 + m * 16 + fr) * ldc + col0;
#pragma unroll
            for (int bj = 0; bj < 2; ++bj)
#pragma unroll
                for (int n = 0; n < 2; ++n) pre[m][bj][n] = *(const f32x4*)(base + off + bj * HALF + n * 16); }
        const bool bad = st.run(acc, u, wr, wc, fr, fq, lds, wid, lane) || poison != 0u;
        const float qnan = __builtin_nanf("");
#pragma unroll
        for (int ai = 0; ai < 2; ++ai)
#pragma unroll
            for (int m = 0; m < 4; ++m) { const int r = ai * HALF + wr * 64 + m * 16 + fr; const f32x2v sr = S[r]; const size_t off = (size_t)(u.pm * BM + r) * ldc + col0;
#pragma unroll
                for (int bj = 0; bj < 2; ++bj)
#pragma unroll
                    for (int n = 0; n < 2; ++n) { const f32x4 bs = ai == 0 ? pre[m][bj][n] : *(const f32x4*)(base + off + bj * HALF + n * 16); f32x4 o = bs + (acc[ai][bj][m][n] - sr.x) * sr.y;
                        if (bad) o = (f32x4){qnan, qnan, qnan, qnan}; *(f32x4*)(out + off + bj * HALF + n * 16) = o; }
                if (m & 1) asm volatile("" ::: "memory"); }
    }
};
struct EpiLnResLn {
    static constexpr bool PERM = false, AFTER_DRAIN = true;
    const float* base; float* out; bf16_t* xn; int ldc; const float* bias; PanelStats st1, st2; unsigned poison;
    __device__ __forceinline__ void fused(f32x4 (&acc)[2][2][4][2], const Unit& u, int wr, int wc, int fr, int fq, PG8_LAS unsigned char* lds, int wid, int lane) const {
        typedef float f32x2v __attribute__((ext_vector_type(2))); typedef unsigned u32x2v __attribute__((ext_vector_type(2)));
        const PG8_LAS f32x2v* S = (const PG8_LAS f32x2v*)(lds + 8192);
        const int col0 = u.pn * BM + wc * 32 + 4 * fq;
#pragma unroll
        for (int bj = 0; bj < 2; ++bj)
#pragma unroll
            for (int n = 0; n < 2; ++n) { const f32x4 bv = bias ? *(const f32x4*)(bias + col0 + bj * HALF + n * 16) : (f32x4){0.f, 0.f, 0.f, 0.f};
#pragma unroll
                for (int ai = 0; ai < 2; ++ai)
#pragma unroll
                    for (int m = 0; m < 4; ++m) acc[ai][bj][m][n] += bv; }
        bool bad = st1.run(acc, u, wr, wc, fr, fq, lds, wid, lane) || poison != 0u;
        const float qnan = __builtin_nanf("");
#pragma unroll
        for (int ai = 0; ai < 2; ++ai)
#pragma unroll
            for (int m = 0; m < 4; ++m) { const int r = ai * HALF + wr * 64 + m * 16 + fr; const f32x2v sr = S[r]; const size_t off = (size_t)(u.pm * BM + r) * ldc + col0;
#pragma unroll
                for (int bj = 0; bj < 2; ++bj)
#pragma unroll
                    for (int n = 0; n < 2; ++n) { const f32x4 bs = *(const f32x4*)(base + off + bj * HALF + n * 16); acc[ai][bj][m][n] = bs + (acc[ai][bj][m][n] - sr.x) * sr.y; }
                asm volatile("" : "+v"(acc[ai][0][m][0]), "+v"(acc[ai][0][m][1]), "+v"(acc[ai][1][m][0]), "+v"(acc[ai][1][m][1]));
                if (m & 1) asm volatile("" ::: "memory"); }
        const bool bad1 = bad;
        bad = st2.run(acc, u, wr, wc, fr, fq, lds, wid, lane) || bad;
#pragma unroll
        for (int ai = 0; ai < 2; ++ai)
#pragma unroll
            for (int m = 0; m < 4; ++m) { const int r = ai * HALF + wr * 64 + m * 16 + fr; const f32x2v sr = S[r]; const size_t off = (size_t)(u.pm * BM + r) * ldc + col0;
#pragma unroll
                for (int bj = 0; bj < 2; ++bj)
#pragma unroll
                    for (int n = 0; n < 2; ++n) { const f32x4 x1 = acc[ai][bj][m][n]; *(f32x4*)(out + off + bj * HALF + n * 16) = bad1 ? (f32x4){qnan, qnan, qnan, qnan} : x1;
                        const f32x4 o = (x1 - sr.x) * sr.y; u32x2v w; w.x = cvt_pk_bf16(o[0], o[1]); w.y = cvt_pk_bf16(o[2], o[3]);
                        if (bad) { w.x = 0x7fc07fc0u; w.y = 0x7fc07fc0u; } *(u32x2v*)(xn + off + bj * HALF + n * 16) = w; }
                asm volatile("" ::: "memory"); }
    }
};

template <class Epi, class Sched, bool ALIGN_EPI = false, bool SP2 = false, bool GATHER = false>
__device__ __forceinline__ void gemm_phase(PG8_LAS unsigned char* lds, const Gemm g, const Sched& S, const Epi& E) {
    int tid_ = threadIdx.x; asm volatile("" : "+v"(tid_));
    const int tid = tid_, wid = __builtin_amdgcn_readfirstlane(tid >> 6), lane = tid & 63, wr = wid >> 2, wc = wid & 3, fr = lane & 15, fq = lane >> 4;
    const int K = g.K, nt = K / BK;
    unsigned voffA[2], voffB[2];
#pragma unroll
    for (int i = 0; i < 2; ++i) { int R, C; stage_rc(tid * 16 + i * 8192, R, C); const int Rb = Epi::PERM ? ((R & ~31) + perm32(R & 31)) : R;
        voffA[i] = (unsigned)(R * K + C) * 2u; voffB[i] = (unsigned)(Rb * K + C) * 2u; }
    const size_t kstep = (size_t)(BK * 2);
    const size_t hstep = (size_t)HALF * K * 2;
    const size_t tstep = 2 * hstep;
    const unsigned ldsw = (unsigned)wid * 1024u;
    const int aoff = lds_byte(wr * 64 + fr, fq * 8), boff = lds_byte(wc * 32 + fr, fq * 8);
#define PG8_SA(b, h) (((b) * 2 + (h)) * HTB)
#define PG8_SB(b, h) ((4 + (b) * 2 + (h)) * HTB)
#define PG8_STAGE(bufoff, gbase, voff) do { _Pragma("unroll") for (int _i = 0; _i < 2; ++_i) \
        __builtin_amdgcn_global_load_lds((const unsigned*)((const char*)(gbase) + (voff)[_i]), (PG8_LAS unsigned*)(lds + (bufoff) + ldsw + _i * 8192), 16, 0, 0); } while (0)
#define PG8_STA(bufoff, ptr, h, SET) do { if constexpr (GATHER) { PG8_STAGE(bufoff, ptr, (SET)[h]); } else { PG8_STAGE(bufoff, (ptr) + (h) * hstep, voffA); } } while (0)
#define PG8_LDA(dst, b, h) do { _Pragma("unroll") for (int m = 0; m < 4; ++m) _Pragma("unroll") for (int k = 0; k < 2; ++k) dst[m][k] = *(const PG8_LAS bf16x8*)(lds + PG8_SA(b, h) + aoff + m * 2048 + k * 1024); } while (0)
#define PG8_LDB(dst, b, h) do { _Pragma("unroll") for (int n = 0; n < 2; ++n) _Pragma("unroll") for (int k = 0; k < 2; ++k) dst[n][k] = *(const PG8_LAS bf16x8*)(lds + PG8_SB(b, h) + boff + n * 2048 + k * 1024); } while (0)
#define PG8_MMA(ai, bj, At, Bt) do { __builtin_amdgcn_s_setprio(1); _Pragma("unroll") for (int m = 0; m < 4; ++m) _Pragma("unroll") for (int n = 0; n < 2; ++n) _Pragma("unroll") for (int k = 0; k < 2; ++k) \
        acc[ai][bj][m][n] = __builtin_amdgcn_mfma_f32_16x16x32_bf16(Bt[n][k], At[m][k], acc[ai][bj][m][n], 0, 0, 0); __builtin_amdgcn_s_setprio(0); } while (0)
#define PG8_WAIT_V(n) asm volatile("s_waitcnt vmcnt(" #n ")" ::: "memory")
#define PG8_WAIT_L(n) asm volatile("s_waitcnt lgkmcnt(" #n ")" ::: "memory")
#define PG8_BAR __builtin_amdgcn_s_barrier()
#define PG8_SCHED __builtin_amdgcn_sched_barrier(0)
    Unit cur, nxt; int ui = 0;
    if (!S.next(0, cur)) return;
    static_assert(SP2 || !GATHER, "GATHER is implemented in the SP2 loop only");
    unsigned gcur[2][2] = {{0u, 0u}, {0u, 0u}}, gnxt[2][2] = {{0u, 0u}, {0u, 0u}}; int gR[2], gC[2];
    if constexpr (GATHER) {
#pragma unroll
        for (int i = 0; i < 2; ++i) stage_rc(tid * 16 + i * 8192, gR[i], gC[i]);
#pragma unroll
        for (int h = 0; h < 2; ++h)
#pragma unroll
            for (int i = 0; i < 2; ++i) gcur[h][i] = (unsigned)(g.gtab[cur.pm * BM + h * HALF + gR[i]] * K + gC[i]) * 2u;
    }
    f32x4 acc[2][2][4][2];
#pragma unroll
    for (int a = 0; a < 2; ++a)
#pragma unroll
        for (int b = 0; b < 2; ++b)
#pragma unroll
            for (int m = 0; m < 4; ++m)
#pragma unroll
                for (int n = 0; n < 2; ++n) acc[a][b][m][n] = (f32x4){0.f, 0.f, 0.f, 0.f};
    bf16x8 At[4][2], B0[2][2], B1[2][2];
    const char* cA = (const char*)g.A + (GATHER ? (size_t)0 : (size_t)cur.pm * tstep); const char* cB = (const char*)g.Bt + (size_t)cur.pn * tstep;
    S.a_ready(cur);
    if constexpr (SP2) {
        PG8_STAGE(PG8_SB(0, 0), cB, voffB); PG8_STAGE(PG8_SB(0, 1), cB + hstep, voffB); PG8_STA(PG8_SA(0, 0), cA, 0, gcur); PG8_STA(PG8_SA(0, 1), cA, 1, gcur);
        if (wr == 1) PG8_BAR;
        PG8_WAIT_V(2); PG8_BAR;
        PG8_STAGE(PG8_SB(1, 0), cB + kstep, voffB); PG8_STA(PG8_SA(1, 0), cA + kstep, 0, gcur); PG8_STAGE(PG8_SB(1, 1), cB + hstep + kstep, voffB);
        PG8_WAIT_V(6); PG8_BAR;
    } else {
        PG8_STAGE(PG8_SB(0, 0), cB, voffB); PG8_STAGE(PG8_SA(0, 0), cA, voffA); PG8_STAGE(PG8_SB(0, 1), cB + hstep, voffB); PG8_STAGE(PG8_SA(0, 1), cA + hstep, voffA);
        if (wr == 1) PG8_BAR;
        PG8_WAIT_V(4); PG8_BAR;
        PG8_STAGE(PG8_SB(1, 0), cB + kstep, voffB); PG8_STAGE(PG8_SA(1, 0), cA + kstep, voffA); PG8_STAGE(PG8_SB(1, 1), cB + hstep + kstep, voffB);
        PG8_WAIT_V(6); PG8_BAR;
    }
    for (;;) {
        const bool has_next = S.next(ui + 1, nxt);
        const char* nA = GATHER ? (const char*)g.A : (has_next ? (const char*)g.A + (size_t)nxt.pm * tstep : cA); const char* nB = has_next ? (const char*)g.Bt + (size_t)nxt.pn * tstep : cB;
        if constexpr (GATHER) {
#pragma unroll
            for (int h = 0; h < 2; ++h)
#pragma unroll
                for (int i = 0; i < 2; ++i) gnxt[h][i] = has_next ? (unsigned)(g.gtab[nxt.pm * BM + h * HALF + gR[i]] * K + gC[i]) * 2u : gcur[h][i];
        }
#pragma unroll 1
        for (int t = 0; t < nt; t += 2) {
            const bool last = (t == nt - 2);
            const char* a1 = cA + (size_t)(t + 1) * kstep;
            const char* a2 = last ? nA : cA + (size_t)(t + 2) * kstep; const char* b2 = last ? nB : cB + (size_t)(t + 2) * kstep;
            const char* a3 = a2 + kstep; const char* b3 = b2 + kstep;
            if (last && has_next) S.a_ready(nxt);
            unsigned g2[2][2];
#pragma unroll
            for (int h = 0; h < 2; ++h)
#pragma unroll
                for (int i = 0; i < 2; ++i) g2[h][i] = last ? gnxt[h][i] : gcur[h][i];
            if constexpr (SP2) {
            PG8_LDB(B0, 0, 0); PG8_LDB(B1, 0, 1); PG8_SCHED; PG8_LDA(At, 0, 0); PG8_STA(PG8_SA(1, 1), a1, 1, gcur);
            PG8_WAIT_V(8); PG8_WAIT_L(0); PG8_BAR; PG8_MMA(0, 0, At, B0); PG8_MMA(0, 1, At, B1); PG8_BAR; PG8_SCHED;
            PG8_LDA(At, 0, 1); PG8_STAGE(PG8_SB(0, 0), b2, voffB); PG8_STAGE(PG8_SB(0, 1), b2 + hstep, voffB); PG8_STA(PG8_SA(0, 0), a2, 0, g2);
            PG8_WAIT_V(8); PG8_WAIT_L(0); PG8_BAR; PG8_MMA(1, 0, At, B0); PG8_MMA(1, 1, At, B1); PG8_BAR; PG8_SCHED;
            PG8_LDB(B0, 1, 0); PG8_LDB(B1, 1, 1); PG8_SCHED; PG8_LDA(At, 1, 0); PG8_STA(PG8_SA(0, 1), a2, 1, g2);
            PG8_WAIT_V(8); PG8_WAIT_L(0); PG8_BAR; PG8_MMA(0, 0, At, B0); PG8_MMA(0, 1, At, B1); PG8_BAR; PG8_SCHED;
            PG8_LDA(At, 1, 1); PG8_STAGE(PG8_SB(1, 0), b3, voffB); PG8_STAGE(PG8_SB(1, 1), b3 + hstep, voffB); PG8_STA(PG8_SA(1, 0), a3, 0, g2);
            PG8_WAIT_V(8); PG8_WAIT_L(0); PG8_BAR; PG8_MMA(1, 0, At, B0); PG8_MMA(1, 1, At, B1); PG8_BAR; PG8_SCHED;
            } else {
            PG8_LDB(B0, 0, 0); PG8_SCHED; PG8_LDA(At, 0, 0); PG8_STAGE(PG8_SA(1, 1), a1 + hstep, voffA);
            PG8_WAIT_L(8); PG8_BAR; PG8_WAIT_L(0); PG8_MMA(0, 0, At, B0); PG8_BAR; PG8_SCHED;
            PG8_LDB(B1, 0, 1); PG8_STAGE(PG8_SB(0, 0), b2, voffB);
            PG8_BAR; PG8_WAIT_L(0); PG8_MMA(0, 1, At, B1); PG8_BAR;
            PG8_LDA(At, 0, 1); PG8_STAGE(PG8_SA(0, 0), a2, voffA);
            PG8_BAR; PG8_WAIT_L(0); PG8_MMA(1, 0, At, B0); PG8_BAR; PG8_SCHED;
            PG8_STAGE(PG8_SB(0, 1), b2 + hstep, voffB);
            PG8_WAIT_V(6); PG8_BAR; PG8_MMA(1, 1, At, B1); PG8_BAR;
            PG8_LDB(B0, 1, 0); PG8_SCHED; PG8_LDA(At, 1, 0); PG8_STAGE(PG8_SA(0, 1), a2 + hstep, voffA);
            PG8_WAIT_L(8); PG8_BAR; PG8_WAIT_L(0); PG8_MMA(0, 0, At, B0); PG8_BAR; PG8_SCHED;
            PG8_LDB(B1, 1, 1); PG8_STAGE(PG8_SB(1, 0), b3, voffB);
            PG8_BAR; PG8_WAIT_L(0); PG8_MMA(0, 1, At, B1); PG8_BAR;
            PG8_LDA(At, 1, 1); PG8_STAGE(PG8_SA(1, 0), a3, voffA);
            PG8_BAR; PG8_WAIT_L(0); PG8_MMA(1, 0, At, B0); PG8_BAR; PG8_SCHED;
            PG8_STAGE(PG8_SB(1, 1), b3 + hstep, voffB);
            PG8_WAIT_V(6); PG8_BAR; PG8_MMA(1, 1, At, B1); PG8_BAR;
            }
        }
        if constexpr (ALIGN_EPI) { if (wr == 0) PG8_BAR; }
        if constexpr (!Epi::AFTER_DRAIN) { E(acc, cur, wr, wc, fr, fq); S.done(cur); }
        if (!has_next) break;
#pragma unroll
        for (int a = 0; a < 2; ++a)
#pragma unroll
            for (int b = 0; b < 2; ++b)
#pragma unroll
                for (int m = 0; m < 4; ++m)
#pragma unroll
                    for (int n = 0; n < 2; ++n) acc[a][b][m][n] = (f32x4){0.f, 0.f, 0.f, 0.f};
        cur = nxt; cA = nA; cB = nB; ++ui;
        if constexpr (GATHER) {
#pragma unroll
            for (int h = 0; h < 2; ++h)
#pragma unroll
                for (int i = 0; i < 2; ++i) gcur[h][i] = gnxt[h][i];
        }
        if constexpr (ALIGN_EPI) { if (wr == 1) PG8_BAR; }
    }
    PG8_WAIT_V(0);
    if constexpr (!ALIGN_EPI) { if (wr == 0) PG8_BAR; }
    PG8_BAR;
    if constexpr (Epi::AFTER_DRAIN) { E.fused(acc, cur, wr, wc, fr, fq, lds, wid, lane); S.done(cur); }
#undef PG8_SA
#undef PG8_SB
#undef PG8_STAGE
#undef PG8_STA
#undef PG8_LDA
#undef PG8_LDB
#undef PG8_MMA
#undef PG8_WAIT_V
#undef PG8_WAIT_L
#undef PG8_BAR
#undef PG8_SCHED
}
}
namespace pg8 {
struct TileDst { bf16_t* base; int ldc; float scale; const float* bias; };

template <class Map> struct EpiBf16Map {
    static constexpr bool PERM = true, AFTER_DRAIN = false;
    Map map;
    __device__ __forceinline__ void operator()(const f32x4 (&acc)[2][2][4][2], const Unit& u, int wr, int wc, int fr, int fq) const {
        const TileDst d = map(u);
        const int row0 = wr * 64 + fr, col0 = wc * 32 + 8 * fq;
        f32x4 bv[2][2];
#pragma unroll
        for (int bj = 0; bj < 2; ++bj)
#pragma unroll
            for (int n = 0; n < 2; ++n) bv[bj][n] = d.bias ? *(const f32x4*)(d.bias + col0 + bj * HALF + 4 * n) : (f32x4){0.f, 0.f, 0.f, 0.f};
#pragma unroll
        for (int ai = 0; ai < 2; ++ai)
#pragma unroll
            for (int m = 0; m < 4; ++m) { bf16_t* rowp = d.base + (size_t)(row0 + ai * HALF + m * 16) * d.ldc + col0;
#pragma unroll
                for (int bj = 0; bj < 2; ++bj) { f32x4 v0 = (acc[ai][bj][m][0] + bv[bj][0]) * d.scale, v1 = (acc[ai][bj][m][1] + bv[bj][1]) * d.scale;
                    u32x4 w; w.x = cvt_pk_bf16(v0[0], v0[1]); w.y = cvt_pk_bf16(v0[2], v0[3]); w.z = cvt_pk_bf16(v1[0], v1[1]); w.w = cvt_pk_bf16(v1[2], v1[3]);
                    *(u32x4*)(rowp + bj * HALF) = w; } }
    }
};

struct EpiSwiglu {
    static constexpr bool PERM = true, AFTER_DRAIN = false;
    bf16_t* H; const float* bg; const float* bu;
    __device__ __forceinline__ void operator()(const f32x4 (&acc)[2][2][4][2], const Unit& u, int wr, int wc, int fr, int fq) const {
        const int e = u.pn >> 3, pnl = u.pn & 7;
        const int row0 = u.pm * BM + wr * 64 + fr, col0 = pnl * 128 + wc * 32 + 8 * fq;
        f32x4 g0 = *(const f32x4*)(bg + e * 1024 + col0), g1 = *(const f32x4*)(bg + e * 1024 + col0 + 4);
        f32x4 u0 = *(const f32x4*)(bu + e * 1024 + col0), u1 = *(const f32x4*)(bu + e * 1024 + col0 + 4);
#pragma unroll
        for (int ai = 0; ai < 2; ++ai)
#pragma unroll
            for (int m = 0; m < 4; ++m) {
                float r[8];
#pragma unroll
                for (int n = 0; n < 2; ++n)
#pragma unroll
                    for (int j = 0; j < 4; ++j) {
                        float hg = acc[ai][0][m][n][j] + (n ? g1[j] : g0[j]);
                        float hl = acc[ai][1][m][n][j] + (n ? u1[j] : u0[j]);
                        hg = fminf(hg, 7.0f); hl = fminf(fmaxf(hl, -7.0f), 7.0f);
                        const float sg = __builtin_amdgcn_rcpf(1.0f + __expf(-1.702f * hg));
                        r[n * 4 + j] = hg * sg * (hl + 1.0f);
                    }
                u32x4 w; w.x = cvt_pk_bf16(r[0], r[1]); w.y = cvt_pk_bf16(r[2], r[3]); w.z = cvt_pk_bf16(r[4], r[5]); w.w = cvt_pk_bf16(r[6], r[7]);
                *(u32x4*)(H + (size_t)(row0 + ai * HALF + m * 16) * 1024 + col0) = w;
            }
    }
};

struct EpiF32Res {
    static constexpr bool PERM = false, AFTER_DRAIN = false;
    const float* base; float* out; float alpha;
    __device__ __forceinline__ void operator()(const f32x4 (&acc)[2][2][4][2], const Unit& u, int wr, int wc, int fr, int fq) const {
        const int col0 = (u.pn & 3) * BM + wc * 32 + 4 * fq;
#pragma unroll
        for (int ai = 0; ai < 2; ++ai)
#pragma unroll
            for (int m = 0; m < 4; ++m) { const size_t off = (size_t)(u.pm * BM + ai * HALF + wr * 64 + m * 16 + fr) * 1024 + col0;
#pragma unroll
                for (int bj = 0; bj < 2; ++bj)
#pragma unroll
                    for (int n = 0; n < 2; ++n) { const f32x4 bs = *(const f32x4*)(base + off + bj * HALF + n * 16);
                        *(f32x4*)(out + off + bj * HALF + n * 16) = bs * alpha + acc[ai][bj][m][n]; } }
    }
};

struct EpiResBf16 {
    static constexpr bool PERM = false, AFTER_DRAIN = false;
    const float* base; bf16_t* out; float alpha;
    __device__ __forceinline__ void operator()(const f32x4 (&acc)[2][2][4][2], const Unit& u, int wr, int wc, int fr, int fq) const {
        typedef unsigned u32x2v __attribute__((ext_vector_type(2)));
        const int col0 = (u.pn & 3) * BM + wc * 32 + 4 * fq;
#pragma unroll
        for (int ai = 0; ai < 2; ++ai)
#pragma unroll
            for (int m = 0; m < 4; ++m) { const size_t off = (size_t)(u.pm * BM + ai * HALF + wr * 64 + m * 16 + fr) * 1024 + col0;
#pragma unroll
                for (int bj = 0; bj < 2; ++bj)
#pragma unroll
                    for (int n = 0; n < 2; ++n) { const f32x4 bs = *(const f32x4*)(base + off + bj * HALF + n * 16); const f32x4 v = bs * alpha + acc[ai][bj][m][n];
                        u32x2v w; w.x = cvt_pk_bf16(v[0], v[1]); w.y = cvt_pk_bf16(v[2], v[3]); *(u32x2v*)(out + off + bj * HALF + n * 16) = w; } }
    }
};

struct EpiResBf16B {
    static constexpr bool PERM = false, AFTER_DRAIN = false;
    const bf16_t* base; bf16_t* out; float alpha;
    __device__ __forceinline__ void operator()(const f32x4 (&acc)[2][2][4][2], const Unit& u, int wr, int wc, int fr, int fq) const {
        typedef unsigned u32x2v __attribute__((ext_vector_type(2)));
        const int col0 = (u.pn & 3) * BM + wc * 32 + 4 * fq;
#pragma unroll
        for (int ai = 0; ai < 2; ++ai)
#pragma unroll
            for (int m = 0; m < 4; ++m) { const size_t off = (size_t)(u.pm * BM + ai * HALF + wr * 64 + m * 16 + fr) * 1024 + col0;
#pragma unroll
                for (int bj = 0; bj < 2; ++bj)
#pragma unroll
                    for (int n = 0; n < 2; ++n) { const u32x2v w = *(const u32x2v*)(base + off + bj * HALF + n * 16);
                        const f32x4 bs = {__builtin_bit_cast(float, w.x << 16), __builtin_bit_cast(float, w.x & 0xffff0000u), __builtin_bit_cast(float, w.y << 16), __builtin_bit_cast(float, w.y & 0xffff0000u)};
                        const f32x4 v = bs * alpha + acc[ai][bj][m][n];
                        u32x2v o; o.x = cvt_pk_bf16(v[0], v[1]); o.y = cvt_pk_bf16(v[2], v[3]); *(u32x2v*)(out + off + bj * HALF + n * 16) = o; } }
    }
};

struct EpiF32ResB {
    static constexpr bool PERM = false, AFTER_DRAIN = false;
    const bf16_t* base; float* out; float alpha;
    __device__ __forceinline__ void operator()(const f32x4 (&acc)[2][2][4][2], const Unit& u, int wr, int wc, int fr, int fq) const {
        typedef unsigned u32x2v __attribute__((ext_vector_type(2)));
        const int col0 = (u.pn & 3) * BM + wc * 32 + 4 * fq;
#pragma unroll
        for (int ai = 0; ai < 2; ++ai)
#pragma unroll
            for (int m = 0; m < 4; ++m) { const size_t off = (size_t)(u.pm * BM + ai * HALF + wr * 64 + m * 16 + fr) * 1024 + col0;
#pragma unroll
                for (int bj = 0; bj < 2; ++bj)
#pragma unroll
                    for (int n = 0; n < 2; ++n) { const u32x2v w = *(const u32x2v*)(base + off + bj * HALF + n * 16);
                        const f32x4 bs = {__builtin_bit_cast(float, w.x << 16), __builtin_bit_cast(float, w.x & 0xffff0000u), __builtin_bit_cast(float, w.y << 16), __builtin_bit_cast(float, w.y & 0xffff0000u)};
                        *(f32x4*)(out + off + bj * HALF + n * 16) = bs * alpha + acc[ai][bj][m][n]; } }
    }
};

struct EpiSoftmax {
    static constexpr bool PERM = true, AFTER_DRAIN = true;
    bf16_t* P;
    __device__ __forceinline__ void fused(f32x4 (&acc)[2][2][4][2], const Unit& u, int wr, int wc, int fr, int fq, PG8_LAS unsigned char* lds, int wid, int lane) const {
        PG8_LAS float* X = (PG8_LAS float*)lds;
        PG8_LAS float* Y = (PG8_LAS float*)(lds + 4096);
#pragma unroll
        for (int ai = 0; ai < 2; ++ai)
#pragma unroll
            for (int m = 0; m < 4; ++m) {
                float mx = -INFINITY;
#pragma unroll
                for (int bj = 0; bj < 2; ++bj)
#pragma unroll
                    for (int n = 0; n < 2; ++n) { const f32x4 x = acc[ai][bj][m][n]; mx = fmaxf(mx, fmaxf(fmaxf(x[0], x[1]), fmaxf(x[2], x[3]))); }
                mx = fmaxf(mx, __shfl_xor(mx, 16)); mx = fmaxf(mx, __shfl_xor(mx, 32));
                if (fq == 0) X[(ai * HALF + wr * 64 + m * 16 + fr) * 4 + wc] = mx;
            }
        asm volatile("s_waitcnt lgkmcnt(0)" ::: "memory"); __builtin_amdgcn_s_barrier(); asm volatile("" ::: "memory");
#pragma unroll
        for (int ai = 0; ai < 2; ++ai)
#pragma unroll
            for (int m = 0; m < 4; ++m) {
                const int r = ai * HALF + wr * 64 + m * 16 + fr;
                const f32x4 q = *(const PG8_LAS f32x4*)(X + r * 4);
                const float mx = fmaxf(fmaxf(q[0], q[1]), fmaxf(q[2], q[3]));
                float s = 0.f;
#pragma unroll
                for (int bj = 0; bj < 2; ++bj)
#pragma unroll
                    for (int n = 0; n < 2; ++n) { f32x4 x = acc[ai][bj][m][n];
                        x[0] = __builtin_amdgcn_exp2f(x[0] - mx); x[1] = __builtin_amdgcn_exp2f(x[1] - mx); x[2] = __builtin_amdgcn_exp2f(x[2] - mx); x[3] = __builtin_amdgcn_exp2f(x[3] - mx);
                        acc[ai][bj][m][n] = x; s += (x[0] + x[1]) + (x[2] + x[3]); }
                s += __shfl_xor(s, 16); s += __shfl_xor(s, 32);
                if (fq == 0) Y[r * 4 + wc] = s;
            }
        asm volatile("s_waitcnt lgkmcnt(0)" ::: "memory"); __builtin_amdgcn_s_barrier(); asm volatile("" ::: "memory");
        const int col0 = (u.pn & 3) * BM + wc * 32 + 8 * fq;
#pragma unroll
        for (int ai = 0; ai < 2; ++ai)
#pragma unroll
            for (int m = 0; m < 4; ++m) {
                const int r = ai * HALF + wr * 64 + m * 16 + fr;
                const f32x4 q = *(const PG8_LAS f32x4*)(Y + r * 4);
                const float inv = 1.0f / ((q[0] + q[1]) + (q[2] + q[3]));
                bf16_t* rowp = P + (size_t)(u.pm * BM + r) * 1024 + col0;
#pragma unroll
                for (int bj = 0; bj < 2; ++bj) { const f32x4 v0 = acc[ai][bj][m][0] * inv, v1 = acc[ai][bj][m][1] * inv;
                    u32x4 w; w.x = cvt_pk_bf16(v0[0], v0[1]); w.y = cvt_pk_bf16(v0[2], v0[3]); w.z = cvt_pk_bf16(v1[0], v1[1]); w.w = cvt_pk_bf16(v1[2], v1[3]);
                    *(u32x4*)(rowp + bj * HALF) = w; }
            }
        asm volatile("s_waitcnt lgkmcnt(0)" ::: "memory"); __builtin_amdgcn_s_barrier(); asm volatile("" ::: "memory");
    }
};

struct BatchOrder {
    StaticOrder so;
    __device__ void init(int M, int N, int G_, int c_) { so.init(M, N, G_, c_); }
    __device__ bool next(int i, Unit& u) const { if (!so.next(i, u)) return false; u.pn += (u.pm >> 5) * 4; return true; }
    __device__ __forceinline__ void a_ready(const Unit&) const {}
    __device__ __forceinline__ void done(const Unit&) const {}
};
struct WqkOrder {
    int G, c;
    __device__ bool next(int i, Unit& u) const { const int L = i * G + c; if (L >= 32) return false; const int b = L >> 4, h = (L >> 2) & 3, kt = L & 3; u.pm = b * 4 + h; u.pn = h * 4 + kt; return true; }
    __device__ __forceinline__ void a_ready(const Unit&) const {}
    __device__ __forceinline__ void done(const Unit&) const {}
};
struct VwoOrder {
    int G, c;
    __device__ bool next(int i, Unit& u) const { const int L = i * G + c; if (L >= 32) return false; const int b = L >> 4, h = (L >> 2) & 3, nt = L & 3; u.pm = h * 4 + nt; u.pn = b * 4 + h; return true; }
    __device__ __forceinline__ void a_ready(const Unit&) const {}
    __device__ __forceinline__ void done(const Unit&) const {}
};
struct MoeOrder {
    int G, c, nN, n_mt; const PG8_LAS int* tile_e;
    __device__ bool next(int i, Unit& u) const {
        const int x = c & 7, j = c >> 3, tpx = 32 / nN  , tpr = 8 * tpx  ;
        const int full = n_mt / tpr;
        int pm, pnl;
        if (i < full) { pm = (i * 8 + x) * tpx + j / nN; pnl = j % nN; }
        else if (i == full) {
            const int rem = n_mt - full * tpr, t = j / nN;
            const int idx = t * 8 + x; if (idx >= rem) return false;
            pm = full * tpr + idx; pnl = j % nN; }
        else return false;
        if (j >= 32) return false;
        const int e = __builtin_amdgcn_readfirstlane(tile_e[pm]); u.pm = pm; u.pn = e * nN + pnl; return true; }
    __device__ __forceinline__ void a_ready(const Unit&) const {}
    __device__ __forceinline__ void done(const Unit&) const {}
};
}
#include <hip/hip_bf16.h>
#include <cmath>
namespace attn_body {
using bf16=__hip_bfloat16;
using bf16x8=__attribute__((ext_vector_type(8)))short;
using s16x4=__attribute__((ext_vector_type(4)))short;
using f32x16=__attribute__((ext_vector_type(16)))float;
using u32x4=__attribute__((ext_vector_type(4)))unsigned;
constexpr int BATCH=2,NHEAD=16,SEQ=8192,D=64,DM=NHEAD*D;
constexpr int PQKV=512;
constexpr int NW=8,QBLK=32,QB=QBLK*NW,KVBLK=64,NQB=SEQ/QB;
constexpr int ATTN_PITCH=DM, ATTN_UNIT_ROWS=QB;
__device__ __forceinline__ int crow(int r,int hi){return (r&3)+8*(r>>2)+4*hi;}
#define SBAR() __builtin_amdgcn_sched_barrier(0)
__device__ __forceinline__ void cmask(f32x16&p0,f32x16&p1,int jb,int qrel,int hi){
  const float NEG=-INFINITY; int kb=64*jb+4*hi;
  #pragma unroll
  for(int r=0;r<16;++r){int kv=kb+(r&3)+8*(r>>2); if(kv>qrel)p0[r]=NEG; if(kv+32>qrel)p1[r]=NEG;}
}

constexpr int NSLOT=3, SLOTB=8192;
constexpr int LDS_K=0, LDS_V=NSLOT*SLOTB, LDS_WS=2*NSLOT*SLOTB, LDS_OST=LDS_WS+NW*64*4, LDS_BYTES=LDS_OST+NW*4096;
constexpr float C2=0.125f*1.4426950408889634f;
__device__ __forceinline__ void glds16(const void*gsrc,unsigned lds_dst){unsigned keep;
  asm volatile("s_mov_b32 %0, m0\n\ts_mov_b32 m0, %2\n\ts_nop 0\n\tglobal_load_lds_dwordx4 %1, off\n\ts_mov_b32 m0, %0":"=&s"(keep):"v"(gsrc),"s"(lds_dst):"memory");}
__device__ __forceinline__ float max3f(float a,float b,float c){float r;asm("v_max3_f32 %0, %1, %2, %3":"=v"(r):"v"(a),"v"(b),"v"(c));return r;}
__device__ __forceinline__ float max2f(float a,float b){float r;asm("v_max_f32_e32 %0, %1, %2":"=v"(r):"v"(a),"v"(b));return r;}
__device__ __forceinline__ float fadd_s(float a,float b){float r;asm("v_add_f32_e32 %0, %1, %2":"=v"(r):"v"(a),"v"(b));return r;}
__device__ __forceinline__ float fsub_s(float a,float b){float r;asm("v_sub_f32_e32 %0, %1, %2":"=v"(r):"v"(a),"v"(b));return r;}
typedef float f32x2_t __attribute__((ext_vector_type(2))); typedef __bf16 bf16x2_t __attribute__((ext_vector_type(2)));
__device__ __forceinline__ unsigned cvtpk_s(float lo,float hi){f32x2_t v={lo,hi};bf16x2_t b=__builtin_convertvector(v,bf16x2_t);return __builtin_bit_cast(unsigned,b);}
#define WAIT_BAR(N) asm volatile("s_waitcnt vmcnt(" #N ") lgkmcnt(0)\n\ts_barrier":::"memory")

__device__ __forceinline__ void qkt(f32x16&p0,f32x16&p1,const char*Kslot,const bf16x8*qr,const f32x16&negm,int r32,int hi){
  const char*kb=Kslot+hi*1024+r32*16;
  #pragma unroll
  for(int d0=0;d0<4;++d0){
    const bf16x8 b0=*reinterpret_cast<const bf16x8*>(kb+d0*2048);
    const bf16x8 b1=*reinterpret_cast<const bf16x8*>(kb+d0*2048+512);
    if(d0==0){p0=__builtin_amdgcn_mfma_f32_32x32x16_bf16(b0,qr[0],negm,0,0,0);p1=__builtin_amdgcn_mfma_f32_32x32x16_bf16(b1,qr[0],negm,0,0,0);}
    else{p0=__builtin_amdgcn_mfma_f32_32x32x16_bf16(b0,qr[d0],p0,0,0,0);p1=__builtin_amdgcn_mfma_f32_32x32x16_bf16(b1,qr[d0],p1,0,0,0);}}
}
typedef __attribute__((address_space(3))) const char* lds_cptr;
typedef short v4i16_t __attribute__((ext_vector_type(4)));
__device__ __forceinline__ void kload8(bf16x8*kf,lds_cptr kp){
  kf[0]=*(const __attribute__((address_space(3))) bf16x8*)(kp);      kf[1]=*(const __attribute__((address_space(3))) bf16x8*)(kp+512);
  kf[2]=*(const __attribute__((address_space(3))) bf16x8*)(kp+2048); kf[3]=*(const __attribute__((address_space(3))) bf16x8*)(kp+2560);
  kf[4]=*(const __attribute__((address_space(3))) bf16x8*)(kp+4096); kf[5]=*(const __attribute__((address_space(3))) bf16x8*)(kp+4608);
  kf[6]=*(const __attribute__((address_space(3))) bf16x8*)(kp+6144); kf[7]=*(const __attribute__((address_space(3))) bf16x8*)(kp+6656);
}
__device__ __forceinline__ void kload2(bf16x8*kf,lds_cptr kp,int j){ kf[2*j]=*(const __attribute__((address_space(3))) bf16x8*)(kp+j*2048); kf[2*j+1]=*(const __attribute__((address_space(3))) bf16x8*)(kp+j*2048+512); }
__device__ __forceinline__ s16x4 vtr(lds_cptr p){ return __builtin_bit_cast(s16x4,__builtin_amdgcn_ds_read_tr16_b64_v4i16((__attribute__((address_space(3))) v4i16_t*)p)); }
__device__ __forceinline__ float rowmax(const f32x16&p0,const f32x16&p1){
  float a=max3f(p0[0],p0[1],p1[0]),b=max3f(p0[2],p0[3],p1[1]);a=max3f(a,p1[2],p1[3]);
  #pragma unroll
  for(int r=4;r<16;r+=4){a=max3f(a,p0[r],p0[r+1]);b=max3f(b,p0[r+2],p0[r+3]);a=max3f(a,p1[r],p1[r+1]);b=max3f(b,p1[r+2],p1[r+3]);}
  const float m=max2f(a,b);
  auto rr=__builtin_amdgcn_permlane32_swap(__float_as_uint(m),__float_as_uint(m),false,false);
  return max2f(__uint_as_float(rr[0]),__uint_as_float(rr[1]));
}
__device__ __forceinline__ void pv(f32x16*o,int vb,bf16x8 pa0,bf16x8 pa1,bf16x8 pa2,bf16x8 pa3){
  #pragma unroll
  for(int d0=0;d0<2;++d0){s16x4 lo[4],hi[4];
    #pragma unroll
    for(int ks=0;ks<4;++ks){
      asm volatile("ds_read_b64_tr_b16 %0,%1 offset:%c2":"=&v"(lo[ks]):"v"(vb),"i"(d0*4096+ks*1024):"memory");
      asm volatile("ds_read_b64_tr_b16 %0,%1 offset:%c2":"=&v"(hi[ks]):"v"(vb),"i"(d0*4096+ks*1024+512):"memory");}
    asm volatile("s_waitcnt lgkmcnt(0)":::"memory");SBAR();
    #define PK(k) (bf16x8){lo[k][0],lo[k][1],lo[k][2],lo[k][3],hi[k][0],hi[k][1],hi[k][2],hi[k][3]}
    o[d0]=__builtin_amdgcn_mfma_f32_32x32x16_bf16(pa0,PK(0),o[d0],0,0,0);
    o[d0]=__builtin_amdgcn_mfma_f32_32x32x16_bf16(pa1,PK(1),o[d0],0,0,0);
    o[d0]=__builtin_amdgcn_mfma_f32_32x32x16_bf16(pa2,PK(2),o[d0],0,0,0);
    o[d0]=__builtin_amdgcn_mfma_f32_32x32x16_bf16(pa3,PK(3),o[d0],0,0,0);
    #undef PK
  }
}

#ifndef ATTN_STORE16
#define ATTN_STORE16(p,v) (*(u32x4*)(p)=(v))
#endif
template<int THRL> __device__ __forceinline__ void attn_unit(int b,int h,int qb,const bf16*Q,const bf16*__restrict__ K,const bf16*__restrict__ V,bf16*O,char*shm){
  int tid_=threadIdx.x; asm volatile("":"+v"(tid_)); const int tid=tid_,lane=tid&63,r32=lane&31,hi=lane>>5; const int wid=__builtin_amdgcn_readfirstlane(tid>>6);
  const long rowbase=(long)b*SEQ; const int q0=qb*QB;
  const bf16*Qw=Q+(rowbase+q0+wid*QBLK)*PQKV+(h>>1)*D;
  const bf16*Kh=K+rowbase*PQKV+(h>>1)*D,*Vh=V+rowbase*PQKV+((h>>2)*2+(h&1))*D;
  const unsigned lds0=(unsigned)(uintptr_t)shm;
  float*wsf=(float*)(shm+LDS_WS)+wid*64;
  const bf16*ksrc=Kh+(long)lane*PQKV+wid*8;
  const bf16*vsrc=Vh+(long)(16*(wid&3)+(lane>>2))*PQKV+(wid>>2)*32+(lane&3)*8;
  const unsigned kdst=lds0+LDS_K+wid*1024, vdst=lds0+LDS_V+wid*1024;
  #define DMA_K(t,slot) glds16(ksrc+(long)(t)*KVBLK*PQKV,(unsigned)__builtin_amdgcn_readfirstlane(kdst+(slot)))
  #define DMA_V(t,slot) glds16(vsrc+(long)(t)*KVBLK*PQKV,(unsigned)__builtin_amdgcn_readfirstlane(vdst+(slot)))
  const int vb0=(int)(lds0+LDS_V)+((lane>>4)&1)*32+(lane&3)*8+(4*hi+((lane&15)>>2))*64;
  const char*Kbase=shm+LDS_K; bf16x8 kf[8];
  const lds_cptr shm3=(lds_cptr)shm; const lds_cptr kp0=shm3+LDS_K+hi*1024+r32*16; const lds_cptr vp0=shm3+LDS_V+((lane>>4)&1)*32+(lane&3)*8+(4*hi+((lane&15)>>2))*64;
  const int NT=(q0+QB)/KVBLK;
  DMA_K(0,0);DMA_V(0,0);DMA_K(1,SLOTB);
  bf16x8 qr[4];
  #pragma unroll
  for(int d0=0;d0<4;++d0)qr[d0]=*reinterpret_cast<const bf16x8*>(&Qw[(long)r32*PQKV+d0*16+hi*8]);
  float mhat=0.f,l_reg=0.f;f32x16 o[2];o[0]=f32x16{};o[1]=f32x16{};f32x16 negm=f32x16{};asm volatile("":"+v"(negm));
  const int qrel=wid*QBLK+r32;
  #define CMASK(P0,P1,t) do{int jb_=(t)-(NT-4); if(jb_>=0)cmask(P0,P1,jb_,qrel,hi);}while(0)
  bool resc=false;
  #define START(P0,P1) do{ const float rm=rowmax(P0,P1); resc=false; \
    { const float dl=rm; mhat=fadd_s(mhat,dl); \
      _Pragma("unroll") for(int r=0;r<16;++r){P0[r]=fsub_s(P0[r],dl);P1[r]=fsub_s(P1[r],dl);} \
      _Pragma("unroll") for(int r=0;r<16;++r)negm[r]=-mhat; asm volatile("":"+v"(negm)); } \
    _Pragma("unroll") for(int r=0;r<16;++r)P0[r]=__builtin_amdgcn_exp2f(P0[r]); }while(0)
  #define RESC() do{ if(resc){ asm volatile("s_waitcnt lgkmcnt(0)":::"memory"); \
      _Pragma("unroll") for(int d_=0;d_<2;++d_) _Pragma("unroll") for(int r=0;r<16;++r)o[d_][r]*=wsf[crow(r,hi)]; } }while(0)
  f32x16 pA0,pA1,pB0,pB1;
  int sl_prev=0,sl_cur=0,sl_next=SLOTB;
  #define ROT() do{sl_prev=sl_cur;sl_cur=sl_next;sl_next=(sl_next==(NSLOT-1)*SLOTB)?0:sl_next+SLOTB;}while(0)
  DMA_K(2,2*SLOTB);
  WAIT_BAR(3);
  qkt(pA0,pA1,Kbase,qr,negm,r32,hi);asm volatile("s_nop 15\n\ts_nop 7":"+v"(pA0),"+v"(pA1));CMASK(pA0,pA1,0);
  START(pA0,pA1);
  _Pragma("unroll") for(int r=0;r<16;++r)pA1[r]=__builtin_amdgcn_exp2f(pA1[r]);
  WAIT_BAR(0);
  DMA_K(3,0);DMA_V(1,SLOTB);
  ROT();
  kload8(kf,kp0+sl_cur);
  WAIT_BAR(2);
  s16x4 vlo[8],vhi[8]; u32x4 pw0,pw1,pw2,pw3;
  #define PKW(P,B) cvtpk_s(P[B],P[B+1])
  #define PAF(k) __builtin_bit_cast(bf16x8,pw##k)
  #define VFR(i) (bf16x8){vlo[i][0],vlo[i][1],vlo[i][2],vlo[i][3],vhi[i][0],vhi[i][1],vhi[i][2],vhi[i][3]}
  #define PIN(x) asm volatile("":"+v"(x))
  #define MX3(a,b,c) __builtin_fmaxf(__builtin_fmaxf((a),(b)),(c))
  #define GAPA(MF,A0,A1,A2,A3,W0,W1,PW) do{ MF; sacc+=A0; sacc+=A1; sacc+=A2; sacc+=A3; PIN(sacc); W0; W1; PIN(PW); SBAR(); }while(0)
  #define EX(v) __builtin_amdgcn_exp2f(v)
  #define GAPB(MF,X,B) do{ MF; X[B]=EX(X[B]); X[B+1]=EX(X[B+1]); X[B+2]=EX(X[B+2]); X[B+3]=EX(X[B+3]); PIN(X); SBAR(); }while(0)
  #define VRD(i) do{ vlo[i]=vtr(vp_+(((i)>>2)*4096+((i)&3)*1024)); vhi[i]=vtr(vp_+(((i)>>2)*4096+((i)&3)*1024+512)); }while(0)
  #define KRD(G,j) do{ if(G){ kload2(kf,kp0+sl_next,j); SBAR(); } }while(0)
  #define STEP(C0,C1,P0,P1,t,GK,GV,GL) do{ SBAR(); \
    const lds_cptr vp_=vp0+sl_prev; \
    VRD(0); SBAR(); float sacc=(P0[0]+P0[1]); \
    GAPA(C0=__builtin_amdgcn_mfma_f32_32x32x16_bf16(kf[0],qr[0],negm,0,0,0), P0[2],P0[3],P0[4],P0[5],     pw0[0]=PKW(P0,0), pw0[1]=PKW(P0,2), pw0); \
    VRD(4); SBAR(); GAPA(C1=__builtin_amdgcn_mfma_f32_32x32x16_bf16(kf[1],qr[0],negm,0,0,0), P0[6],P0[7],P0[8],P0[9],     pw0[2]=PKW(P0,4), pw0[3]=PKW(P0,6), pw0); \
    VRD(1); SBAR(); GAPA(C0=__builtin_amdgcn_mfma_f32_32x32x16_bf16(kf[2],qr[1],C0,0,0,0),   P0[10],P0[11],P0[12],P0[13], pw1[0]=PKW(P0,8), pw1[1]=PKW(P0,10), pw1); \
    VRD(5); SBAR(); GAPA(C1=__builtin_amdgcn_mfma_f32_32x32x16_bf16(kf[3],qr[1],C1,0,0,0),   P0[14],P0[15],P1[0],P1[1],   pw1[2]=PKW(P0,12),pw1[3]=PKW(P0,14), pw1); \
    VRD(2); SBAR(); GAPA(C0=__builtin_amdgcn_mfma_f32_32x32x16_bf16(kf[4],qr[2],C0,0,0,0),   P1[2],P1[3],P1[4],P1[5],     pw2[0]=PKW(P1,0), pw2[1]=PKW(P1,2), pw2); \
    VRD(6); SBAR(); GAPA(C1=__builtin_amdgcn_mfma_f32_32x32x16_bf16(kf[5],qr[2],C1,0,0,0),   P1[6],P1[7],P1[8],P1[9],     pw2[2]=PKW(P1,4), pw2[3]=PKW(P1,6), pw2); \
    VRD(3); SBAR(); GAPA(C0=__builtin_amdgcn_mfma_f32_32x32x16_bf16(kf[6],qr[3],C0,0,0,0),   P1[10],P1[11],P1[12],P1[13], pw3[0]=PKW(P1,8), pw3[1]=PKW(P1,10), pw3); \
    VRD(7); SBAR(); GAPA(C1=__builtin_amdgcn_mfma_f32_32x32x16_bf16(kf[7],qr[3],C1,0,0,0),   P1[14],P1[15],0.f,0.f,       pw3[2]=PKW(P1,12),pw3[3]=PKW(P1,14), pw3); \
    l_reg+=sacc; \
    if(GK){DMA_K((t)+3,sl_cur);} if(GV){DMA_V((t)+1,sl_next);} \
    CMASK(C0,C1,t); \
    { float a=MX3(C0[0],C0[1],C1[0]),b=MX3(C0[2],C0[3],C1[1]); a=MX3(a,C1[2],C1[3]); \
      _Pragma("unroll") for(int r=4;r<16;r+=4){a=MX3(a,C0[r],C0[r+1]);b=MX3(b,C0[r+2],C0[r+3]);a=MX3(a,C1[r],C1[r+1]);b=MX3(b,C1[r+2],C1[r+3]);} \
      float rm=__builtin_fmaxf(a,b); { auto rr=__builtin_amdgcn_permlane32_swap(__float_as_uint(rm),__float_as_uint(rm),false,false); rm=__builtin_fmaxf(__uint_as_float(rr[0]),__uint_as_float(rr[1])); } \
      resc=false; \
      if(__builtin_expect(__any(rm>(float)THRL),0)){ const float dl=__builtin_fmaxf(rm,0.f); mhat+=dl; \
        _Pragma("unroll") for(int r=0;r<16;++r){C0[r]-=dl;C1[r]-=dl;} \
        _Pragma("unroll") for(int r=0;r<16;++r)negm[r]=-mhat; asm volatile("":"+v"(negm)); \
        const float f=__builtin_amdgcn_exp2f(-dl); l_reg*=f; if(hi==0)wsf[r32]=f; resc=true; } } \
    SBAR(); \
    GAPB(o[0]=__builtin_amdgcn_mfma_f32_32x32x16_bf16(PAF(0),VFR(0),o[0],0,0,0), C0,0); \
    GAPB(o[1]=__builtin_amdgcn_mfma_f32_32x32x16_bf16(PAF(0),VFR(4),o[1],0,0,0), C0,4); \
    KRD(GL,0); GAPB(o[0]=__builtin_amdgcn_mfma_f32_32x32x16_bf16(PAF(1),VFR(1),o[0],0,0,0), C0,8); \
    KRD(GL,1); GAPB(o[1]=__builtin_amdgcn_mfma_f32_32x32x16_bf16(PAF(1),VFR(5),o[1],0,0,0), C0,12); \
    KRD(GL,2); GAPB(o[0]=__builtin_amdgcn_mfma_f32_32x32x16_bf16(PAF(2),VFR(2),o[0],0,0,0), C1,0); \
    KRD(GL,3); GAPB(o[1]=__builtin_amdgcn_mfma_f32_32x32x16_bf16(PAF(2),VFR(6),o[1],0,0,0), C1,4); \
    GAPB(o[0]=__builtin_amdgcn_mfma_f32_32x32x16_bf16(PAF(3),VFR(3),o[0],0,0,0), C1,8); \
    GAPB(o[1]=__builtin_amdgcn_mfma_f32_32x32x16_bf16(PAF(3),VFR(7),o[1],0,0,0), C1,12); \
    }while(0)
  int t=1;
  #undef CMASK
  #define CMASK(P0,P1,t) do{}while(0)
  for(;t+5<NT;t+=2){
    STEP(pB0,pB1,pA0,pA1,t,true,true,true);     WAIT_BAR(2); RESC(); ROT();
    STEP(pA0,pA1,pB0,pB1,t+1,true,true,true);   WAIT_BAR(2); RESC(); ROT();
  }
  #undef CMASK
  #define CMASK(P0,P1,t) do{int jb_=(t)-(NT-4); if(jb_>=0)cmask(P0,P1,jb_,qrel,hi);}while(0)
  #define ENDW(tt) do{ if((tt)+3<NT){WAIT_BAR(2);} else if((tt)+2<NT){WAIT_BAR(1);} else {WAIT_BAR(0);} }while(0)
  for(;t+1<NT;t+=2){
    STEP(pB0,pB1,pA0,pA1,t,(t+3<NT),(t+1<NT),(t+1<NT));       ENDW(t);   RESC(); ROT();
    STEP(pA0,pA1,pB0,pB1,t+1,(t+4<NT),(t+2<NT),(t+2<NT));     ENDW(t+1); RESC(); ROT();
  }
  STEP(pB0,pB1,pA0,pA1,NT-1,false,false,false); RESC();
  { float sacc=pB0[0]+pB0[1]; _Pragma("unroll") for(int r=2;r<16;++r)sacc+=pB0[r]; _Pragma("unroll") for(int r=0;r<16;++r)sacc+=pB1[r]; l_reg+=sacc;
    pw0=(u32x4){PKW(pB0,0),PKW(pB0,2),PKW(pB0,4),PKW(pB0,6)};pw1=(u32x4){PKW(pB0,8),PKW(pB0,10),PKW(pB0,12),PKW(pB0,14)};pw2=(u32x4){PKW(pB1,0),PKW(pB1,2),PKW(pB1,4),PKW(pB1,6)};pw3=(u32x4){PKW(pB1,8),PKW(pB1,10),PKW(pB1,12),PKW(pB1,14)};
    SBAR(); pv(o,vb0+sl_cur,PAF(0),PAF(1),PAF(2),PAF(3)); }
  #undef PKW
  #undef PAF
  #undef VFR
  #undef PIN
  #undef MX3
  #undef GAPA
  #undef GAPB
  #undef EX
  #undef VRD
  #undef KRD
  #undef STEP
  #undef ENDW
  {auto rr=__builtin_amdgcn_permlane32_swap(__float_as_uint(l_reg),__float_as_uint(l_reg),false,false);l_reg=__uint_as_float(rr[0])+__uint_as_float(rr[1]);}
  if(hi==0)wsf[32+r32]=l_reg;asm volatile("s_waitcnt lgkmcnt(0)":::"memory");
  float rli[16];
  #pragma unroll
  for(int r=0;r<16;++r)rli[r]=__builtin_amdgcn_rcpf(wsf[32+crow(r,hi)]);
  bf16*Ow=O+(rowbase+q0+wid*QBLK)*DM+h*D;
  { bf16*stg=(bf16*)(shm+LDS_OST)+wid*2048;
    #pragma unroll
    for(int r=0;r<16;++r){const int orow=crow(r,hi);
      #pragma unroll
      for(int d0=0;d0<2;++d0)stg[orow*64+d0*32+r32]=__float2bfloat16(o[d0][r]*rli[r]);}
    asm volatile("s_waitcnt lgkmcnt(0)":::"memory");
    #pragma unroll
    for(int i=0;i<4;++i){const int row=i*8+(lane>>3),ch=lane&7; const u32x4 v=*(const u32x4*)(stg+row*64+ch*8); ATTN_STORE16(Ow+(long)row*DM+ch*8,v);} }
  asm volatile("s_waitcnt lgkmcnt(0)\n\ts_barrier":::"memory");
  #undef DMA_K
  #undef DMA_V
  #undef CMASK
  #undef START
  #undef RESC
  #undef ROT
}
constexpr int ATTN_LDS_BYTES=LDS_BYTES;
struct AttnTensors { const bf16* Q; const bf16* K; const bf16* V; bf16* O; };
struct AttnUnit { int bh; int qb; };
struct StaticOrder {
  int vcu;
  __device__ __forceinline__ explicit StaticOrder(int grid,int block):vcu((block%8)*(grid/8)+block/8){}
  __device__ __forceinline__ bool next(int i,AttnUnit&u)const{ if(i>=4)return false; const int s=vcu&7; u.bh=vcu>>3; u.qb=(i==0)?s:(i==1)?15-s:(i==2)?16+s:31-s; return true; }
  __device__ __forceinline__ void a_ready(const AttnUnit&)const{}
  __device__ __forceinline__ void done(const AttnUnit&)const{}
};
struct QueueOrder {
  unsigned* heads; volatile __attribute__((address_space(3))) int* slot; int x;
  mutable unsigned pend; mutable int npend;
  __device__ __forceinline__ bool next(int,AttnUnit&u)const{
    if(threadIdx.x==0){ int found=-1;
      if(npend){ if(pend<128u)found=x*128+(int)pend; }
      if(found<0){
        _Pragma("unroll 1") for(int q=0;q<8;++q){ const int xq=(x+q)&7;
          if(__hip_atomic_load(heads+64*xq,__ATOMIC_RELAXED,__HIP_MEMORY_SCOPE_AGENT)>=128u)continue;
          const unsigned j=__hip_atomic_fetch_add(heads+64*xq,1u,__ATOMIC_RELAXED,__HIP_MEMORY_SCOPE_AGENT);
          if(j<128u){found=xq*128+(int)j;break;} } }
      *slot=found;
      npend=0;
      if(found>=0&&(found>>7)==x){ pend=__hip_atomic_fetch_add(heads+64*x,1u,__ATOMIC_RELAXED,__HIP_MEMORY_SCOPE_AGENT); npend=1; } }
    __syncthreads();
    const int f=*slot;
    if(f<0)return false;
    const int xq=f>>7,j=f&127; u.qb=31-(j>>2); u.bh=xq*4+(j&3); return true; }
  __device__ __forceinline__ void a_ready(const AttnUnit&)const{}
  __device__ __forceinline__ void done(const AttnUnit&)const{}
};
template<class Sched,int THRL=8> __device__ __forceinline__ void attn_phase(char*lds,const AttnTensors&T,const Sched&S){
  AttnUnit u;
  for(int i=0;S.next(i,u);++i){ S.a_ready(u); attn_unit<THRL>(u.bh/NHEAD,u.bh%NHEAD,u.qb,T.Q,T.K,T.V,T.O,lds); S.done(u); }
}
#undef SBAR
#undef WAIT_BAR
}
#define GAS __attribute__((address_space(1)))
#define LAS __attribute__((address_space(3)))
typedef unsigned short bf16;
typedef unsigned v4u __attribute__((ext_vector_type(4)));
typedef float f32x4 __attribute__((ext_vector_type(4)));
typedef short bf16x8 __attribute__((ext_vector_type(8)));
typedef GAS unsigned gu32;
typedef GAS unsigned long long gu64;
#define RLX_AGENT __ATOMIC_RELAXED, __HIP_MEMORY_SCOPE_AGENT
#define LDS_WAIT() asm volatile("s_waitcnt lgkmcnt(0)" ::: "memory")
#define VM_WAIT() asm volatile("s_waitcnt vmcnt(0)" ::: "memory")
__device__ __forceinline__ unsigned long long rt() { return __builtin_amdgcn_s_memrealtime(); }
__device__ __forceinline__ unsigned pk2(float lo, float hi) { return attn_body::cvtpk_s(lo, hi); }
__device__ __forceinline__ unsigned f2bf(float f) { return attn_body::cvtpk_s(f, 0.f) & 0xffffu; }

#define XB_TMO      128
#define XB_XCNT(j)  (256  + 64 * (j))
#define XB_XSUB(j)  (1280 + 64 * (j))
#define XB_XGEN(j)  (2304 + 64 * (j))
#define XB_TOP      3328
#define XB_TOPGEN   3392
#define XCD_BAR_WORDS 3456
#define XB_SPIN_CAP (1u << 18)
#ifndef XB_SLEEP
#define XB_SLEEP 1
#endif

__device__ __forceinline__ unsigned xb_ld(unsigned* p)              { return __hip_atomic_load(p, __ATOMIC_RELAXED, __HIP_MEMORY_SCOPE_AGENT); }
__device__ __forceinline__ unsigned xb_add(unsigned* p, unsigned v) { return __hip_atomic_fetch_add(p, v, __ATOMIC_RELAXED, __HIP_MEMORY_SCOPE_AGENT); }
__device__ __forceinline__ unsigned xb_xcc_id() { return (unsigned)__builtin_amdgcn_s_getreg((3 << 11) | 20) & 0xFu; }
#define XB_SPIN(cond, bar) do { unsigned _sp = 0; while (cond) { __builtin_amdgcn_s_sleep(XB_SLEEP); \
    if ((++_sp & 255u) == 0u) { if (xb_ld(&(bar)[XB_TMO])) break; if (_sp > XB_SPIN_CAP) { atomicAdd(&(bar)[XB_TMO], 1u); break; } } } } while (0)

struct XcdBarrier {
    unsigned* bar; unsigned x;
    volatile LAS unsigned* st;
};

__device__ __forceinline__ XcdBarrier xcd_barrier_post(unsigned* bar, volatile LAS unsigned* st) {
    XcdBarrier b; b.bar = bar; b.x = xb_xcc_id(); b.st = st;
    if (threadIdx.x == 0) (void)xb_add(&bar[XB_XCNT(b.x)], 1u);
    return b;
}
__device__ __forceinline__ void xcd_barrier_complete(unsigned* bar, unsigned x, unsigned& nloc, unsigned& nx) {
    const unsigned G = gridDim.x * gridDim.y * gridDim.z;
    unsigned sum, cnt, mine, sp = 0u;
    for (;;) {
        sum = 0u; cnt = 0u; mine = 0u;
#pragma unroll
        for (unsigned j = 0; j < 16; ++j) { const unsigned c = xb_ld(&bar[XB_XCNT(j)]); sum += c; cnt += (c > 0u) ? 1u : 0u; mine = (j == x) ? c : mine; }
        if (sum == G) break;
        __builtin_amdgcn_s_sleep(1);
        if ((++sp & 255u) == 0u) { if (xb_ld(&bar[XB_TMO])) break; if (sp > XB_SPIN_CAP) { atomicAdd(&bar[XB_TMO], 1u); break; } }
    }
    nloc = mine > 0u ? mine : 1u; nx = cnt > 0u ? cnt : 1u;
}

__device__ __forceinline__ void xcd_barrier(const XcdBarrier& b) {
    asm volatile("s_waitcnt vmcnt(0)" ::: "memory");
    __syncthreads();
    if (threadIdx.x == 0) {
        unsigned* bar = b.bar;
        __builtin_amdgcn_s_waitcnt(0);
        unsigned nloc = b.st[0], nx = b.st[1];
        if (nloc == 0u) { xcd_barrier_complete(bar, b.x, nloc, nx); b.st[0] = nloc; b.st[1] = nx; }
        const unsigned old = xb_add(&bar[XB_XSUB(b.x)], 1u);
        const unsigned gen = old / nloc;
        if (old + 1u == (gen + 1u) * nloc) {
            __builtin_amdgcn_fence(__ATOMIC_RELEASE, "agent");
            asm volatile("s_waitcnt vmcnt(0)" ::: "memory");
            const unsigned og = xb_add(&bar[XB_TOP], 1u);
            const unsigned tg = og / nx;
            if (og + 1u == (tg + 1u) * nx) xb_add(&bar[XB_TOPGEN], 1u);
            else XB_SPIN(xb_ld(&bar[XB_TOPGEN]) == tg, bar);
            __builtin_amdgcn_fence(__ATOMIC_ACQUIRE, "agent");
            xb_add(&bar[XB_XGEN(b.x)], 1u);
            asm volatile("s_waitcnt vmcnt(0)" ::: "memory");
        } else {
            XB_SPIN(xb_ld(&bar[XB_XGEN(b.x)]) == gen, bar);
            __builtin_amdgcn_fence(__ATOMIC_ACQUIRE, "agent");
            asm volatile("s_waitcnt vmcnt(0)" ::: "memory");
        }
    }
    __syncthreads();
}

__device__ __forceinline__ void split_arrive(unsigned* cnt) {
    asm volatile("s_waitcnt vmcnt(0)" ::: "memory");
    __syncthreads();
    if (threadIdx.x == 0) { __builtin_amdgcn_fence(__ATOMIC_RELEASE, "agent"); asm volatile("s_waitcnt vmcnt(0)" ::: "memory"); (void)xb_add(cnt, 1u); }
}
__device__ __forceinline__ void split_wait(unsigned* cnt, unsigned target, unsigned* bar) {
    if (threadIdx.x == 0) { XB_SPIN(xb_ld(cnt) < target, bar); __builtin_amdgcn_fence(__ATOMIC_ACQUIRE, "agent"); asm volatile("s_waitcnt vmcnt(0)" ::: "memory"); }
    __syncthreads();
}
constexpr int NWAVES = 8;
constexpr int NB = 2, SEQ = 8192, DM = 1024, NTOK = NB * SEQ;
constexpr int IN_COLS = 3592, INP_N = 3584;
constexpr int NEXP = 32, TOPK = 4, NMEM = 256;
constexpr int GCH = 64, NCHUNK = SEQ / GCH;
constexpr float DN_ALPHA = 1.189207115002721f;
constexpr float LN_EPS = 1e-5f, RMS_EPS = 1e-6f;
constexpr float LAMBDA_INIT = 0.2f;
constexpr int MOE_MAXROWS = 73728;
constexpr int MOE_MAXTILES = MOE_MAXROWS / 256;

constexpr size_t MiB = 1u << 20;
constexpr size_t WS_CTL = 0, CTL_ZERO_BYTES = 1 * MiB;
constexpr size_t WS_WD = 1 * MiB;
constexpr size_t WS_WGU = 65 * MiB;
constexpr size_t WS_Y = 65 * MiB;
constexpr size_t WS_WIN = 193 * MiB;
constexpr size_t WS_WOUT = 200 * MiB;
constexpr size_t WS_WKV = 202 * MiB;
constexpr size_t WS_WQH = 206 * MiB;
constexpr size_t WS_WOH = 208 * MiB;
constexpr size_t WS_WQK = 210 * MiB;
constexpr size_t WS_VWO = 214 * MiB;
constexpr size_t WS_KMAT = 218 * MiB;
constexpr size_t WS_VMAT = 219 * MiB;
constexpr size_t WS_MEMB = 220 * MiB;
constexpr size_t WS_GBA = 221 * MiB;
constexpr size_t WS_GL = 221 * MiB + 512 * 1024;
constexpr size_t WS_TOPI = 222 * MiB;
constexpr size_t WS_GATE = 222 * MiB + 256 * 1024;
constexpr size_t WS_DEST = 222 * MiB + 512 * 1024;
constexpr size_t WS_GCNT = 222 * MiB + 768 * 1024;
constexpr size_t WS_XB = 224 * MiB;
constexpr size_t WS_O16 = 224 * MiB;
constexpr size_t WS_GQKV = 256 * MiB;
constexpr size_t WS_OA = 256 * MiB;
constexpr size_t WS_GZ = 304 * MiB;
constexpr size_t WS_DQ = 320 * MiB, WS_DK = 336 * MiB, WS_DV = 352 * MiB;
constexpr size_t WS_GOP = 368 * MiB;
constexpr size_t WS_GOUT = 456 * MiB;
constexpr size_t WS_V1 = 288 * MiB;
constexpr size_t WS_X1F = 352 * MiB;
constexpr size_t WS_X1B = 416 * MiB;
constexpr size_t WS_PM = 448 * MiB;
constexpr size_t WS_X2B = 224 * MiB;
constexpr size_t WS_TOKTAB = 256 * MiB;
constexpr size_t WS_H = 368 * MiB;
constexpr size_t WS_XCH = 223 * MiB;
constexpr size_t WS_END = 512 * MiB;
constexpr int GOP_BYTES = 90112;
constexpr int GOP_W = 0, GOP_QD = 16384, GOP_KT = 32768, GOP_AI = 49152, GOP_UT = 57344, GOP_LDS = 57344;
constexpr int CW_BAR = 4096;
constexpr int CW_AQ = 2048;
constexpr int CW_BGQ = 8192;
constexpr int CW_BGDONE = 9216;
#ifndef SPLIT23
#define SPLIT23 1
#endif
constexpr int CW_SPLIT = 7680;
constexpr int CW_TMO = 16;
constexpr int CW_PANEL = 16384;
constexpr int CW_CNT = 64;
constexpr int CW_FILL = 128;

constexpr int RING_BYTES = 131072;
constexpr int MISC_OFF = RING_BYTES;
constexpr int LDS_BYTES = 147456;

typedef unsigned v2u __attribute__((ext_vector_type(2)));
__device__ __forceinline__ float bf2f(unsigned short b) { return __builtin_bit_cast(float, (unsigned)b << 16); }
__device__ __forceinline__ float bflo(unsigned w) { return __builtin_bit_cast(float, w << 16); }
__device__ __forceinline__ float bfhi(unsigned w) { return __builtin_bit_cast(float, w & 0xffff0000u); }
__device__ __forceinline__ float wave_sum(float v) {
    int x = __builtin_bit_cast(int, v);
#define WS_STEP(ctrl, rmask) x = __builtin_bit_cast(int, __builtin_bit_cast(float, x) + __builtin_bit_cast(float, __builtin_amdgcn_update_dpp(0, x, ctrl, rmask, 0xf, false)))
    WS_STEP(0x111, 0xf); WS_STEP(0x112, 0xf); WS_STEP(0x114, 0xf); WS_STEP(0x118, 0xf); WS_STEP(0x142, 0xa); WS_STEP(0x143, 0xc);
#undef WS_STEP
    return __builtin_bit_cast(float, __builtin_amdgcn_readlane(x, 63));
}
__device__ __forceinline__ float sigmoidf_(float x) { return __builtin_amdgcn_rcpf(1.0f + __expf(-x)); }

struct Args { const float* in[31]; float* out; unsigned char* ws; int ph_lo, ph_hi; };
struct KA {
    unsigned char* ws;
    __device__ __forceinline__ const float* in(int i) const {
        const __attribute__((address_space(4))) unsigned long long* p = (const __attribute__((address_space(4))) unsigned long long*)__builtin_amdgcn_kernarg_segment_ptr();
        asm volatile("" : "+s"(p));
        return (const float*)p[i];
    }
    __device__ __forceinline__ float* out() const {
        const __attribute__((address_space(4))) unsigned long long* p = (const __attribute__((address_space(4))) unsigned long long*)__builtin_amdgcn_kernarg_segment_ptr();
        asm volatile("" : "+s"(p));
        return (float*)p[31];
    }
};

__device__ __forceinline__ void transpose_item64(const float* src, int srcN, bf16* dst, int ld, int lane) {
    const int c = lane & 15, r4 = lane >> 4;
    const float* s = src + (size_t)(16 * r4) * srcN + 4 * c;
    f32x4 v[16];
#pragma unroll
    for (int j = 0; j < 16; ++j) v[j] = *(const GAS f32x4*)(s + (size_t)j * srcN);
#pragma unroll
    for (int i = 0; i < 4; ++i) {
        v4u o0, o1;
        o0.x = attn_body::cvtpk_s(v[0][i], v[1][i]); o0.y = attn_body::cvtpk_s(v[2][i], v[3][i]); o0.z = attn_body::cvtpk_s(v[4][i], v[5][i]); o0.w = attn_body::cvtpk_s(v[6][i], v[7][i]);
        o1.x = attn_body::cvtpk_s(v[8][i], v[9][i]); o1.y = attn_body::cvtpk_s(v[10][i], v[11][i]); o1.z = attn_body::cvtpk_s(v[12][i], v[13][i]); o1.w = attn_body::cvtpk_s(v[14][i], v[15][i]);
        bf16* d = dst + (size_t)(4 * c + i) * ld + 16 * r4;
        *(GAS v4u*)d = o0; *(GAS v4u*)(d + 8) = o1;
    }
}
enum { I_X = 0, I_MEM, I_WIN, I_CONVW, I_ALOG, I_DTB, I_GNW, I_LQ1, I_LK1, I_LQ2, I_LK2, I_DNW, I_WOUT, I_LN1G, I_LN1B, I_WQ, I_WK, I_WV, I_WO, I_LN2G, I_LN2B,
       I_RW, I_RB, I_EWG, I_EBG, I_EWU, I_EBU, I_EWD, I_EBD, I_LN3G, I_LN3B };

__device__ __forceinline__ void p0_prologue(const KA& A, LAS unsigned char* lds, int gw, int NGW, int wave, int lane, int tid) {
    unsigned char* ws = A.ws;
    constexpr int IT_WIN = 16 * 56, IT_SQ = 16 * 16;
    constexpr int O_WOUT = IT_WIN, O_EXP = O_WOUT + 4 * IT_SQ, NITEMS = O_EXP;
    for (int it = gw; it < NITEMS; it += NGW) {
        if (it < O_WOUT) { const int kb = it / 56, nb = it % 56, n0 = nb * 64, k0 = kb * 64; const int sc = n0 + (n0 >= 2048 ? 8 : 0);
            transpose_item64(A.in(I_WIN) + (size_t)k0 * IN_COLS + sc, IN_COLS, (bf16*)(ws + WS_WIN) + (size_t)n0 * 1024 + k0, 1024, lane); continue; }
        if (it < O_EXP) {
            const int r = it - O_WOUT, which = r / IT_SQ, q = r % IT_SQ, kb = q / 16, nb = q % 16, n0 = nb * 64, k0 = kb * 64;
            const float* src; bf16* dst; int ld = 1024;
            if (which == 0) { src = A.in(I_WOUT); dst = (bf16*)(ws + WS_WOUT) + (size_t)n0 * 1024 + k0; }
            else if (which == 1) { src = A.in(I_WK); dst = (bf16*)(ws + WS_WKV) + (size_t)n0 * 1024 + k0; }
            else if (which == 2) { src = A.in(I_WV); dst = (bf16*)(ws + WS_WKV) + (size_t)(1024 + n0) * 1024 + k0; }
            else { src = A.in(I_WO); dst = (bf16*)(ws + WS_WOH) + ((size_t)(k0 >> 8) * 1024 + n0) * 256 + (k0 & 255); ld = 256; }
            transpose_item64(src + (size_t)k0 * 1024 + n0, 1024, dst, ld, lane); continue;
        }
    }
    for (int r = gw; r < 1024 + NB * NMEM; r += NGW) {
        const float* srow = (r < 1024) ? A.in(I_WQ) + (size_t)r * 1024 : A.in(I_MEM) + (size_t)(r - 1024) * 1024;
#pragma unroll
        for (int j = 0; j < 4; ++j) {
            const int col = 4 * lane + 256 * j; const f32x4 v = *(const GAS f32x4*)(srow + col);
            v2u o; o.x = pk2(v.x, v.y); o.y = pk2(v.z, v.w);
            bf16* d = (r < 1024) ? (bf16*)(ws + WS_WQH) + ((size_t)(col >> 8) * 1024 + r) * 256 + (col & 255) : (bf16*)(ws + WS_MEMB) + (size_t)(r - 1024) * 1024 + col;
            *(GAS v2u*)d = o;
        }
    }
    LAS float* w8 = (LAS float*)lds;
    for (int i = tid; i < 8192; i += 512) { const int k = i >> 3, c = i & 7; w8[c * 1024 + k] = A.in(I_WIN)[(size_t)k * IN_COLS + 2048 + c]; }
    __syncthreads();
    for (int m = gw; m < NTOK; m += 2 * NGW) {
        const int m1 = m + NGW;
        const float* xr0 = A.in(I_X) + (size_t)m * 1024; const float* xr1 = A.in(I_X) + (size_t)m1 * 1024;
        float acc0[8], acc1[8];
#pragma unroll
        for (int c = 0; c < 8; ++c) { acc0[c] = 0.f; acc1[c] = 0.f; }
#pragma unroll
        for (int j = 0; j < 2; ++j) {
            const int col = 8 * lane + 512 * j;
            const f32x4 v0a = *(const GAS f32x4*)(xr0 + col), v0b = *(const GAS f32x4*)(xr0 + col + 4), v1a = *(const GAS f32x4*)(xr1 + col), v1b = *(const GAS f32x4*)(xr1 + col + 4);
            v4u o0, o1; o0.x = pk2(v0a.x, v0a.y); o0.y = pk2(v0a.z, v0a.w); o0.z = pk2(v0b.x, v0b.y); o0.w = pk2(v0b.z, v0b.w);
            o1.x = pk2(v1a.x, v1a.y); o1.y = pk2(v1a.z, v1a.w); o1.z = pk2(v1b.x, v1b.y); o1.w = pk2(v1b.z, v1b.w);
            *(GAS v4u*)((bf16*)(ws + WS_XB) + (size_t)m * 1024 + col) = o0; *(GAS v4u*)((bf16*)(ws + WS_XB) + (size_t)m1 * 1024 + col) = o1;
#pragma unroll
            for (int c = 0; c < 8; ++c) { const f32x4 wa = *(const LAS f32x4*)(w8 + c * 1024 + col), wb = *(const LAS f32x4*)(w8 + c * 1024 + col + 4);
                acc0[c] += (v0a.x * wa.x + v0a.y * wa.y + v0a.z * wa.z + v0a.w * wa.w) + (v0b.x * wb.x + v0b.y * wb.y + v0b.z * wb.z + v0b.w * wb.w);
                acc1[c] += (v1a.x * wa.x + v1a.y * wa.y + v1a.z * wa.z + v1a.w * wa.w) + (v1b.x * wb.x + v1b.y * wb.y + v1b.z * wb.z + v1b.w * wb.w); }
        }
#pragma unroll
        for (int c = 0; c < 8; ++c) { acc0[c] = wave_sum(acc0[c]); acc1[c] = wave_sum(acc1[c]); }
        if (lane == 0) { float* g = (float*)(ws + WS_GBA) + (size_t)m * 8;
            *(f32x4*)g = (f32x4){acc0[0], acc0[1], acc0[2], acc0[3]}; *(f32x4*)(g + 4) = (f32x4){acc0[4], acc0[5], acc0[6], acc0[7]};
            float* g1 = (float*)(ws + WS_GBA) + (size_t)m1 * 8;
            *(f32x4*)g1 = (f32x4){acc1[0], acc1[1], acc1[2], acc1[3]}; *(f32x4*)(g1 + 4) = (f32x4){acc1[4], acc1[5], acc1[6], acc1[7]}; }
    }
    __syncthreads();
}

constexpr int BG_GU = NEXP * 2 * 256, BG_D = NEXP * 256;
__device__ __forceinline__ void bg_item(const KA& A, unsigned char* ws, int q, int it, int lane) {
    const int e = it / (q == 0 ? 512 : 256), r2 = it % (q == 0 ? 512 : 256), which = (q == 0) ? (r2 >> 8) : 2, t = r2 & 255, kb = t >> 4, nb = t & 15, n0 = nb * 64, k0 = kb * 64;
    const float* src; bf16* dst;
    if (which == 0) { src = A.in(I_EWG) + (size_t)e * 1048576; dst = (bf16*)(ws + WS_WGU) + (size_t)e * 2097152 + (size_t)((n0 >> 7) * 256 + (n0 & 127)) * 1024 + k0; }
    else if (which == 1) { src = A.in(I_EWU) + (size_t)e * 1048576; dst = (bf16*)(ws + WS_WGU) + (size_t)e * 2097152 + (size_t)((n0 >> 7) * 256 + 128 + (n0 & 127)) * 1024 + k0; }
    else { src = A.in(I_EWD) + (size_t)e * 1048576; dst = (bf16*)(ws + WS_WD) + (size_t)e * 1048576 + (size_t)n0 * 1024 + k0; }
    transpose_item64(src + (size_t)k0 * 1024 + n0, 1024, dst, 1024, lane);
}
__device__ __forceinline__ void bg_pull(const KA& A, unsigned char* ws, LAS unsigned char* lds, int lane_in, int q0, int q1, const unsigned* done_cnt, unsigned done_at) {
    int lane = lane_in; asm volatile("" : "+v"(lane));
    unsigned* qh = (unsigned*)(ws + WS_CTL) + CW_BGQ;
    volatile LAS int* slot = (volatile LAS int*)(lds + MISC_OFF + 208);
    const int home = (int)(blockIdx.x & 7), wv = (int)(threadIdx.x >> 6);
    for (;;) {
        if (threadIdx.x < 64) {
            const int l0 = (int)threadIdx.x;
            int q = -1, base = 0, cnt = 0;
            int stop = 0; if (l0 == 0 && done_cnt) stop = __hip_atomic_load(done_cnt, __ATOMIC_RELAXED, __HIP_MEMORY_SCOPE_AGENT) >= done_at ? 1 : 0;
            stop = __builtin_amdgcn_readfirstlane(stop);
            if (!stop) {
#pragma unroll 1
                for (int pass = 0; pass < 2 && q < 0; ++pass) {
                    const int qq = pass ? q1 : q0; if (qq < 0) break;
                    const unsigned per = (unsigned)((qq == 0 ? BG_GU : BG_D) / 8);
                    unsigned hv = 0xffffffffu; if (l0 < 8) hv = __hip_atomic_load(qh + 64 * (qq * 8 + ((home + l0) & 7)), __ATOMIC_RELAXED, __HIP_MEMORY_SCOPE_AGENT);
                    unsigned mk = (unsigned)__ballot(hv < per) & 0xffu;
#pragma unroll 1
                    while (mk && q < 0) { const int t = __builtin_ctz(mk); mk &= mk - 1u; const int s = (home + t) & 7; unsigned* h = qh + 64 * (qq * 8 + s);
                        unsigned j = 0u; if (l0 == 0) j = __hip_atomic_fetch_add(h, 8u, __ATOMIC_RELAXED, __HIP_MEMORY_SCOPE_AGENT);
                        j = (unsigned)__builtin_amdgcn_readfirstlane((int)j);
                        if (j < per) { q = qq; base = (int)(s * per + j); cnt = (int)((per - j) < 8u ? (per - j) : 8u); } }
                }
            }
            if (l0 == 0) { slot[0] = q; slot[1] = base; slot[2] = cnt; }
        }
        __syncthreads();
        const int q = slot[0], base = slot[1], cnt = slot[2];
        __syncthreads();
        if (q < 0) break;
        if (wv < cnt) bg_item(A, ws, q, base + wv, lane);
    }
}
constexpr int GP_KR = 0, GP_QR = 17408, GP_KBGT = 34816, GP_VBT = 53248, GP_KTT = 71680, GP_AINV = 88064, GP_LM = 97280, GP_G = 114688, GP_CW = 115712;
__device__ __forceinline__ int sigma_pos(int idx) { const int s = idx >> 5, tl = idx & 31; return 32 * s + 8 * ((tl >> 2) & 3) + 4 * (tl >> 4) + (tl & 3); }
__device__ __forceinline__ f32x4 mfma16(bf16x8 a, bf16x8 b, f32x4 c) { return __builtin_amdgcn_mfma_f32_16x16x32_bf16(a, b, c, 0, 0, 0); }

__device__ __forceinline__ void gdn_prep_unit(const KA& A, LAS unsigned char* lds, int unit, int tid_in, int (&cw_head)[2]) {
    int tid = tid_in; asm volatile("" : "+v"(tid));
    const int lane = tid & 63, wave = __builtin_amdgcn_readfirstlane(tid >> 6);
    unsigned char* ws = A.ws;
    const int bh = unit >> 7, n = unit & 127, b = bh >> 2, h = bh & 3;
    const int m0 = b * SEQ + n * GCH;
    LAS bf16* Kr = (LAS bf16*)(lds + GP_KR); LAS bf16* Qr = (LAS bf16*)(lds + GP_QR);
    LAS bf16* KbgT = (LAS bf16*)(lds + GP_KBGT); LAS bf16* VbT = (LAS bf16*)(lds + GP_VBT); LAS bf16* KtT = (LAS bf16*)(lds + GP_KTT);
    LAS bf16* Ainv = (LAS bf16*)(lds + GP_AINV); LAS float* Lm = (LAS float*)(lds + GP_LM); LAS float* Gs = (LAS float*)(lds + GP_G);
    unsigned char* gop = ws + WS_GOP + (size_t)unit * GOP_BYTES;
    if (cw_head[h >> 1] != h) {
        cw_head[h >> 1] = h;
        const float* cw = A.in(I_CONVW);
        if (tid < 384) { const int mj = tid >> 5, d4 = (tid & 31) * 4, mat = mj >> 2, j = mj & 3;
            *(LAS f32x4*)((LAS float*)(lds + GP_CW) + (h >> 1) * 1536 + mj * 128 + d4) = *(const f32x4*)(cw + j * 1536 + mat * 512 + h * 128 + d4); }
        __syncthreads();
    }
#ifndef PREP_REP_A
#define PREP_REP_A 1
#endif
#pragma unroll 1
    for (int ra_ = 0; ra_ < PREP_REP_A; ++ra_) {
    if (wave == 0) {
        const float* gba = (const float*)(ws + WS_GBA) + (size_t)(m0 + lane) * 8;
        const float gb = gba[h], ga = gba[4 + h];
        const float beta = sigmoidf_(gb);
        const float xx = ga + A.in(I_DTB)[h];
        const float sp = fmaxf(xx, 0.f) + log1pf(__expf(-fabsf(xx)));
        float g = -__expf(A.in(I_ALOG)[h]) * sp;
#pragma unroll
        for (int o = 1; o < 64; o <<= 1) { const float v = __builtin_bit_cast(float, __builtin_amdgcn_ds_bpermute((lane - o) << 2, __builtin_bit_cast(int, g))); if (lane >= o) g += v; }
        Gs[lane] = g; Gs[64 + lane] = beta;
        if (lane == 63) ((float*)(ws + WS_GL))[unit * 32] = __expf(g);
    }
    const int tok = tid >> 3, part = tid & 7;
    float yq[16], yk[16], yv[16];
    {
        const bf16* gq = (const bf16*)(ws + WS_GQKV);
        v4u xr[2][4][2];
#define GDN_LOADX(mat, buf) do { _Pragma("unroll") for (int j = 0; j < 4; ++j) { const int rel = n * GCH + tok - 3 + j; const int relc = rel < 0 ? 0 : rel; \
            const bf16* src = gq + (size_t)(b * SEQ + relc) * 1536 + (mat) * 512 + h * 128 + part * 16; \
            xr[buf][j][0] = *(const GAS v4u*)src; xr[buf][j][1] = *(const GAS v4u*)(src + 8); \
            if (rel < 0) { xr[buf][j][0] = (v4u){0u, 0u, 0u, 0u}; xr[buf][j][1] = (v4u){0u, 0u, 0u, 0u}; } } } while (0)
        GDN_LOADX(0, 0);
        const LAS float* cwl = (const LAS float*)(lds + GP_CW) + (h >> 1) * 1536 + part * 16;
#pragma unroll
        for (int mat = 0; mat < 3; ++mat) {
            if (mat < 2) GDN_LOADX(mat + 1, (mat + 1) & 1);
            float y[16];
#pragma unroll
            for (int i = 0; i < 16; ++i) y[i] = 0.f;
#pragma unroll
            for (int j = 0; j < 4; ++j) {
                const v4u x0 = xr[mat & 1][j][0], x1 = xr[mat & 1][j][1];
                const LAS float* wj = cwl + (mat * 4 + j) * 128;
                const f32x4 w0 = *(const LAS f32x4*)wj, w1 = *(const LAS f32x4*)(wj + 4), w2 = *(const LAS f32x4*)(wj + 8), w3 = *(const LAS f32x4*)(wj + 12);
                y[0] += w0.x * bflo(x0.x); y[1] += w0.y * bfhi(x0.x); y[2] += w0.z * bflo(x0.y); y[3] += w0.w * bfhi(x0.y);
                y[4] += w1.x * bflo(x0.z); y[5] += w1.y * bfhi(x0.z); y[6] += w1.z * bflo(x0.w); y[7] += w1.w * bfhi(x0.w);
                y[8] += w2.x * bflo(x1.x); y[9] += w2.y * bfhi(x1.x); y[10] += w2.z * bflo(x1.y); y[11] += w2.w * bfhi(x1.y);
                y[12] += w3.x * bflo(x1.z); y[13] += w3.y * bfhi(x1.z); y[14] += w3.z * bflo(x1.w); y[15] += w3.w * bfhi(x1.w);
            }
#pragma unroll
            for (int i = 0; i < 16; ++i) { const float s = y[i] * sigmoidf_(y[i]); if (mat == 0) yq[i] = s; else if (mat == 1) yk[i] = s; else yv[i] = s; }
        }
#undef GDN_LOADX
        float sq = 0.f, sk = 0.f;
#pragma unroll
        for (int i = 0; i < 16; ++i) { sq += yq[i] * yq[i]; sk += yk[i] * yk[i]; }
#define SWZX(x, m) __builtin_bit_cast(float, __builtin_amdgcn_ds_swizzle(__builtin_bit_cast(int, x), ((m) << 10) | 0x1f))
        sq += SWZX(sq, 1); sq += SWZX(sq, 2); sq += SWZX(sq, 4);
        sk += SWZX(sk, 1); sk += SWZX(sk, 2); sk += SWZX(sk, 4);
#undef SWZX
        const float rq = rsqrtf(sq + RMS_EPS) * 0.08838834764831845f, rk = rsqrtf(sk + RMS_EPS);
#pragma unroll
        for (int i = 0; i < 16; ++i) { yq[i] *= rq; yk[i] *= rk; }
    }
    __syncthreads();
    {
        const float G = Gs[tok], beta = Gs[64 + tok], G63 = Gs[63];
        const float eG = __expf(G), eT = __expf(G63 - G), bG = beta * eG;
        v4u o0, o1;
        o0.x = pk2(yk[0], yk[1]); o0.y = pk2(yk[2], yk[3]); o0.z = pk2(yk[4], yk[5]); o0.w = pk2(yk[6], yk[7]);
        o1.x = pk2(yk[8], yk[9]); o1.y = pk2(yk[10], yk[11]); o1.z = pk2(yk[12], yk[13]); o1.w = pk2(yk[14], yk[15]);
        *(LAS v4u*)(Kr + tok * 136 + part * 16) = o0; *(LAS v4u*)(Kr + tok * 136 + part * 16 + 8) = o1;
        o0.x = pk2(yq[0], yq[1]); o0.y = pk2(yq[2], yq[3]); o0.z = pk2(yq[4], yq[5]); o0.w = pk2(yq[6], yq[7]);
        o1.x = pk2(yq[8], yq[9]); o1.y = pk2(yq[10], yq[11]); o1.z = pk2(yq[12], yq[13]); o1.w = pk2(yq[14], yq[15]);
        *(LAS v4u*)(Qr + tok * 136 + part * 16) = o0; *(LAS v4u*)(Qr + tok * 136 + part * 16 + 8) = o1;
        const int sp = sigma_pos(tok);
#pragma unroll
        for (int i = 0; i < 16; ++i) {
            const int d = part * 16 + i;
            KbgT[d * 72 + tok] = (bf16)f2bf(yk[i] * bG);
            VbT[d * 72 + tok] = (bf16)f2bf(yv[i] * beta);
            KtT[d * 64 + (((sp >> 3) ^ ((d >> 1) & 7)) << 3) + (sp & 7)] = (bf16)f2bf(yk[i] * eT);
        }
        bf16* qd = (bf16*)(gop + GOP_QD) + tok * 128 + 4 * (part & 1);
#pragma unroll
        for (int q4 = 0; q4 < 4; ++q4) { v2u o; o.x = pk2(yq[4 * q4] * eG, yq[4 * q4 + 1] * eG); o.y = pk2(yq[4 * q4 + 2] * eG, yq[4 * q4 + 3] * eG); *(GAS v2u*)(qd + (((4 * (part >> 1) + q4) ^ (tok & 15)) << 3)) = o; }
    }
    __syncthreads();
    }
    const int c16 = lane & 15, q4 = lane >> 4;
#ifndef PREP_REP_B
#define PREP_REP_B 1
#endif
#pragma unroll 1
    for (int rb_ = 0; rb_ < PREP_REP_B; ++rb_)
#pragma unroll 1
    for (int jj = 0; jj < 4; ++jj) {
        const int J = wave * 4 + jj, isqk = J >> 4, tm = (J >> 2) & 3, tn = J & 3;
        if (tn < tm) { if (isqk) { const int i = 16 * tn + c16; *(GAS v2u*)((bf16*)(gop + GOP_AI) + i * 64 + (((4 * (tm >> 1) + q4) ^ ((i >> 1) & 7)) << 3) + 4 * (tm & 1)) = ({ v2u z_ = {0u, 0u}; asm volatile("" : "+v"(z_)); z_; }); }        continue; }
        f32x4 acc = {0.f, 0.f, 0.f, 0.f};
        const LAS bf16* ap = Kr + (16 * tm + c16) * 136 + 8 * q4;
        const LAS bf16* bp = (isqk ? Qr : Kr) + (16 * tn + c16) * 136 + 8 * q4;
#pragma unroll
        for (int ks = 0; ks < 4; ++ks) acc = mfma16(*(const LAS bf16x8*)(ap + 32 * ks), *(const LAS bf16x8*)(bp + 32 * ks), acc);
        const int i = 16 * tn + c16, j0 = 16 * tm + 4 * q4;
        const float Gi = Gs[i], bi = Gs[64 + i];
        float r[4];
#pragma unroll
        for (int k = 0; k < 4; ++k) { const int j = j0 + k; const float dec = __expf(fminf(Gi - Gs[j], 0.f)); r[k] = acc[k] * dec; }
        if (!isqk) {
#pragma unroll
            for (int k = 0; k < 4; ++k) r[k] = (j0 + k < i) ? r[k] * bi : 0.f;
            *(LAS f32x4*)(Lm + i * 68 + j0) = (f32x4){r[0], r[1], r[2], r[3]};
        } else {
#pragma unroll
            for (int k = 0; k < 4; ++k) r[k] = (j0 + k <= i) ? r[k] : 0.f;
            v2u o; o.x = pk2(r[0], r[1]); o.y = pk2(r[2], r[3]);
            *(GAS v2u*)((bf16*)(gop + GOP_AI) + i * 64 + (((4 * (tm >> 1) + q4) ^ ((i >> 1) & 7)) << 3) + 4 * (tm & 1)) = o;
        }
    }
    __syncthreads();
#ifndef PREP_REP_C
#define PREP_REP_C 1
#endif
#pragma unroll 1
    for (int rc_ = 0; rc_ < PREP_REP_C; ++rc_)
    if (wave < 4) {
        float ap[16];
#pragma unroll
        for (int j4 = 0; j4 < 16; ++j4) ap[j4] = 0.f;
        const int col = 16 * wave + (lane >> 2), p = lane & 3;
        const float colf = (float)col;
        unsigned lmb = (unsigned)(uintptr_t)(Lm + p); asm volatile("" : "+v"(lmb));
        const LAS float* Lmo = (const LAS float*)(uintptr_t)lmb;
        float lb[2][16];
        lb[0][0] = 0.f;
#pragma unroll
        for (int i = 0; i < 64; ++i) {
            if (i + 1 < 64) {
#pragma unroll
                for (int j4 = 0; j4 < (i + 1 + 3) / 4; ++j4) lb[(i + 1) & 1][j4] = Lmo[(i + 1) * 68 + 4 * j4];
            }
            __builtin_amdgcn_sched_barrier(0);
            float s0 = 0.f, s1 = 0.f;
#pragma unroll
            for (int j4 = 0; j4 < (i + 3) / 4; ++j4) {
                if (j4 & 1) s1 += lb[i & 1][j4] * ap[j4]; else s0 += lb[i & 1][j4] * ap[j4];
            }
            float s = s0 + s1;
            s += __builtin_bit_cast(float, __builtin_amdgcn_mov_dpp(__builtin_bit_cast(int, s), 0xB1, 0xF, 0xF, true));
            s += __builtin_bit_cast(float, __builtin_amdgcn_mov_dpp(__builtin_bit_cast(int, s), 0x4E, 0xF, 0xF, true));
            const float v = fmaxf(0.f, 1.f - fabsf(colf - (float)i)) - s;
            ap[i >> 2] = (p == (i & 3)) ? v : ap[i >> 2];
            if (p == 0) Ainv[i * 72 + col] = (bf16)f2bf(v);
            __builtin_amdgcn_sched_barrier(0);
        }
    } else {
        for (int ch = tid - 256; ch < 1024; ch += 256) *(GAS v4u*)(gop + GOP_KT + ch * 16) = *(const LAS v4u*)(lds + GP_KTT + ch * 16);
    }
    __syncthreads();
#ifndef PREP_REP_D
#define PREP_REP_D 1
#endif
#pragma unroll 1
    for (int rd_ = 0; rd_ < PREP_REP_D; ++rd_)
#pragma unroll 1
    for (int jj = 0; jj < 8; ++jj) {
        const int J = wave * 8 + jj;
        f32x4 acc = {0.f, 0.f, 0.f, 0.f};
        if (J < 32) {
            const int tm = J >> 3, tn = J & 7;
            const LAS bf16* ap = Ainv + (16 * tm + c16) * 72 + 8 * q4; const LAS bf16* bp = VbT + (16 * tn + c16) * 72 + 8 * q4;
#pragma unroll
            for (int ks = 0; ks < 2; ++ks) acc = mfma16(*(const LAS bf16x8*)(ap + 32 * ks), *(const LAS bf16x8*)(bp + 32 * ks), acc);
            *(GAS f32x4*)((float*)(gop + GOP_UT) + (16 * tn + c16) * 64 + 16 * tm + 4 * q4) = acc;
        } else {
            const int Jw = J - 32, tm = Jw >> 2, tn = Jw & 3;
            const LAS bf16* ap = KbgT + (16 * tm + c16) * 72 + 8 * q4; const LAS bf16* bp = Ainv + (16 * tn + c16) * 72 + 8 * q4;
#pragma unroll
            for (int ks = 0; ks < 2; ++ks) acc = mfma16(*(const LAS bf16x8*)(ap + 32 * ks), *(const LAS bf16x8*)(bp + 32 * ks), acc);
            v2u o; o.x = pk2(-acc[0], -acc[1]); o.y = pk2(-acc[2], -acc[3]);
            *(GAS v2u*)((bf16*)(gop + GOP_W) + (16 * tn + c16) * 128 + (((4 * (tm >> 1) + q4) ^ c16) << 3) + 4 * (tm & 1)) = o;
        }
    }
    __syncthreads();
}

__device__ __forceinline__ bf16x8 pack_b(const f32x4& lo, const f32x4& hi) {
    v4u w; w.x = attn_body::cvtpk_s(lo[0], lo[1]); w.y = attn_body::cvtpk_s(lo[2], lo[3]); w.z = attn_body::cvtpk_s(hi[0], hi[1]); w.w = attn_body::cvtpk_s(hi[2], hi[3]);
    return __builtin_bit_cast(bf16x8, w);
}
__device__ __forceinline__ void gdn_step(int n, LAS unsigned char* lds, const unsigned char* gop0, float glv0, float glv1, float* gout, int tid, int cw, bool active, int c16, int q4,
                                         f32x4 (&S)[8], v4u (&P)[7], v4u (&Q)[7], f32x4 (&U)[4]) {
    LAS unsigned char* cur = lds + (n & 1) * GOP_LDS;
    const int n2 = (n + 2 < NCHUNK) ? n + 2 : NCHUNK - 1;
    const unsigned char* g2 = gop0 + (size_t)n2 * GOP_BYTES;
#pragma unroll
    for (int i = 0; i < 7; ++i) Q[i] = *(const GAS v4u*)(g2 + (size_t)(tid + 512 * i) * 16);
    f32x4 vn[4];
#pragma unroll
    for (int mt = 0; mt < 4; ++mt) vn[mt] = U[mt];
#pragma unroll
    for (int mt = 0; mt < 4; ++mt) U[mt] = *(const GAS f32x4*)((const float*)(g2 + GOP_UT) + (16 * cw + c16) * 64 + 16 * mt + 4 * q4);
    const float glast = __builtin_bit_cast(float, __builtin_amdgcn_readlane(__builtin_bit_cast(int, (n & 64) ? glv1 : glv0), n & 63));
    asm volatile("" ::: "memory");
    if (active) {
    bf16x8 bS[4];
#pragma unroll
    for (int s = 0; s < 4; ++s) bS[s] = pack_b(S[2 * s], S[2 * s + 1]);
    const LAS bf16* Wn = (const LAS bf16*)(cur + GOP_W) + c16 * 128;
    const LAS bf16* QD = (const LAS bf16*)(cur + GOP_QD) + c16 * 128;
    const LAS bf16* KT = (const LAS bf16*)(cur + GOP_KT) + c16 * 64;
    const LAS bf16* AI = (const LAS bf16*)(cur + GOP_AI) + c16 * 64;
    const int hc = c16 >> 1;
    f32x4 o[4];
#pragma unroll
    for (int mt = 0; mt < 4; ++mt) o[mt] = (f32x4){0.f, 0.f, 0.f, 0.f};
#define GD_SB() __builtin_amdgcn_sched_barrier(0)
#define GD_W(mt, s_) (*(const LAS bf16x8*)(Wn + (mt) * 16 * 128 + (((4 * (s_) + q4) ^ c16) << 3)))
#define GD_Q(mt, s_) (*(const LAS bf16x8*)(QD + (mt) * 16 * 128 + (((4 * (s_) + q4) ^ c16) << 3)))
#define GD_A(mt, s2) (*(const LAS bf16x8*)(AI + (mt) * 16 * 64 + (((4 * (s2) + q4) ^ hc) << 3)))
#define GD_K(i_, s2) (*(const LAS bf16x8*)(KT + (i_) * 16 * 64 + (((4 * (s2) + q4) ^ hc) << 3)))
    bf16x8 fa[4], fb[4];
#define GD_LDW(f, g) _Pragma("unroll") for (int j = 0; j < 4; ++j) f[j] = GD_W(2 * ((g) >> 1) + (j & 1), 2 * ((g) & 1) + (j >> 1))
#define GD_LDQ(f, g) _Pragma("unroll") for (int j = 0; j < 4; ++j) f[j] = GD_Q(2 * ((g) >> 1) + (j & 1), 2 * ((g) & 1) + (j >> 1))
#define GD_MMV(f, g) _Pragma("unroll") for (int j = 0; j < 4; ++j) vn[2 * ((g) >> 1) + (j & 1)] = mfma16(f[j], bS[2 * ((g) & 1) + (j >> 1)], vn[2 * ((g) >> 1) + (j & 1)])
#define GD_MMO(f, g) _Pragma("unroll") for (int j = 0; j < 4; ++j) o[2 * ((g) >> 1) + (j & 1)] = mfma16(f[j], bS[2 * ((g) & 1) + (j >> 1)], o[2 * ((g) >> 1) + (j & 1)])
    GD_LDW(fa, 0); GD_SB();
    GD_LDW(fb, 1); GD_MMV(fa, 0); GD_SB();
    GD_LDW(fa, 2); GD_MMV(fb, 1); GD_SB();
    GD_LDW(fb, 3); GD_MMV(fa, 2); GD_SB();
    GD_LDQ(fa, 0); GD_MMV(fb, 3); GD_SB();
    GD_LDQ(fb, 1); GD_MMO(fa, 0); GD_SB();
    GD_LDQ(fa, 2); GD_MMO(fb, 1); GD_SB();
    GD_LDQ(fb, 3); GD_MMO(fa, 2); GD_SB();
    fa[0] = GD_A(0, 0); fa[1] = GD_A(1, 0); fa[2] = GD_A(2, 0); fa[3] = GD_A(3, 0);
    GD_MMO(fb, 3);
    bf16x8 bV[2];
    bV[0] = pack_b(vn[0], vn[1]); bV[1] = pack_b(vn[2], vn[3]);
#pragma unroll
    for (int i = 0; i < 8; ++i) S[i] = S[i] * glast;
    GD_SB();
    fb[0] = GD_A(2, 1); fb[1] = GD_A(3, 1); fb[2] = GD_K(0, 0); fb[3] = GD_K(1, 0);
    o[0] = mfma16(fa[0], bV[0], o[0]); o[1] = mfma16(fa[1], bV[0], o[1]); o[2] = mfma16(fa[2], bV[0], o[2]); o[3] = mfma16(fa[3], bV[0], o[3]);
    GD_SB();
    fa[0] = GD_K(0, 1); fa[1] = GD_K(1, 1); fa[2] = GD_K(2, 0); fa[3] = GD_K(3, 0);
    o[2] = mfma16(fb[0], bV[1], o[2]); o[3] = mfma16(fb[1], bV[1], o[3]); S[0] = mfma16(fb[2], bV[0], S[0]); S[1] = mfma16(fb[3], bV[0], S[1]);
    GD_SB();
    fb[0] = GD_K(2, 1); fb[1] = GD_K(3, 1); fb[2] = GD_K(4, 0); fb[3] = GD_K(5, 0);
    S[0] = mfma16(fa[0], bV[1], S[0]); S[1] = mfma16(fa[1], bV[1], S[1]); S[2] = mfma16(fa[2], bV[0], S[2]); S[3] = mfma16(fa[3], bV[0], S[3]);
    GD_SB();
    fa[0] = GD_K(4, 1); fa[1] = GD_K(5, 1); fa[2] = GD_K(6, 0); fa[3] = GD_K(7, 0);
    S[2] = mfma16(fb[0], bV[1], S[2]); S[3] = mfma16(fb[1], bV[1], S[3]); S[4] = mfma16(fb[2], bV[0], S[4]); S[5] = mfma16(fb[3], bV[0], S[5]);
    GD_SB();
    fb[0] = GD_K(6, 1); fb[1] = GD_K(7, 1);
    S[4] = mfma16(fa[0], bV[1], S[4]); S[5] = mfma16(fa[1], bV[1], S[5]); S[6] = mfma16(fa[2], bV[0], S[6]); S[7] = mfma16(fa[3], bV[0], S[7]);
    GD_SB();
    S[6] = mfma16(fb[0], bV[1], S[6]); S[7] = mfma16(fb[1], bV[1], S[7]);
    GD_SB();
#undef GD_LDW
#undef GD_LDQ
#undef GD_MMV
#undef GD_MMO
#undef GD_SB
#undef GD_W
#undef GD_Q
#undef GD_A
#undef GD_K
    GAS float* go = (GAS float*)gout + (size_t)(n * GCH) * 512;
#pragma unroll
    for (int mt = 0; mt < 4; ++mt)
#pragma unroll
        for (int r = 0; r < 4; ++r) go[(size_t)(16 * mt + 4 * q4 + r) * 512] = o[mt][r];
    }
    if (n + 1 < NCHUNK) { LAS unsigned char* nxt = lds + ((n + 1) & 1) * GOP_LDS;
#pragma unroll
        for (int i = 0; i < 7; ++i) *(LAS v4u*)(nxt + (tid + 512 * i) * 16) = P[i]; }
    __syncthreads();
}

__device__ __forceinline__ void gdn_scan(const KA& A, LAS unsigned char* lds, int unit, int tid, int wave, int lane) {
#ifndef SCAN_SPLIT
#define SCAN_SPLIT 2
#endif
    constexpr int CWW = 8 / SCAN_SPLIT;
    const int bh = unit / SCAN_SPLIT, cw = (unit % SCAN_SPLIT) * CWW + (wave % CWW); const bool active = wave < CWW;
    unsigned char* ws = A.ws;
    const int b = bh >> 2, h = bh & 3;
    const int c16 = lane & 15, q4 = lane >> 4;
    const unsigned char* gop0 = ws + WS_GOP + (size_t)(bh * NCHUNK) * GOP_BYTES;
    const float* gl = (const float*)(ws + WS_GL) + (size_t)bh * NCHUNK * 32;
    float* gout = (float*)(ws + WS_GOUT) + (size_t)(b * SEQ) * 512 + h * 128 + 16 * cw + c16;
    const float glv0 = gl[lane * 32], glv1 = gl[(64 + lane) * 32];
    f32x4 S[8];
#pragma unroll
    for (int i = 0; i < 8; ++i) S[i] = (f32x4){0.f, 0.f, 0.f, 0.f};
    v4u stA[7], stB[7]; f32x4 uE[4], uO[4];
#pragma unroll
    for (int i = 0; i < 7; ++i) stB[i] = *(const GAS v4u*)(gop0 + (size_t)(tid + 512 * i) * 16);
#pragma unroll
    for (int i = 0; i < 7; ++i) stA[i] = *(const GAS v4u*)(gop0 + GOP_BYTES + (size_t)(tid + 512 * i) * 16);
#pragma unroll
    for (int mt = 0; mt < 4; ++mt) { uE[mt] = *(const GAS f32x4*)((const float*)(gop0 + GOP_UT) + (16 * cw + c16) * 64 + 16 * mt + 4 * q4);
                                     uO[mt] = *(const GAS f32x4*)((const float*)(gop0 + GOP_BYTES + GOP_UT) + (16 * cw + c16) * 64 + 16 * mt + 4 * q4); }
#pragma unroll
    for (int i = 0; i < 7; ++i) *(LAS v4u*)(lds + (tid + 512 * i) * 16) = stB[i];
    __syncthreads();
#pragma unroll 1
    for (int n = 0; n < NCHUNK; n += 2) {
        gdn_step(n, lds, gop0, glv0, glv1, gout, tid, cw, active, c16, q4, S, stA, stB, uE);
        gdn_step(n + 1, lds, gop0, glv0, glv1, gout, tid, cw, active, c16, q4, S, stB, stA, uO);
    }
}
__device__ __forceinline__ void mixer_post(const KA& A, int gw, int NGW, int lane) {
    unsigned char* ws = A.ws;
    float lam;
    { float a = A.in(I_LQ1)[lane] * A.in(I_LK1)[lane], c = A.in(I_LQ2)[lane] * A.in(I_LK2)[lane]; a = wave_sum(a); c = wave_sum(c); lam = __expf(a) - __expf(c) + LAMBDA_INIT; }
    const int col = lane * 8, hd = lane >> 4, dvi = (lane & 15) * 8;
    f32x4 gw0 = *(const f32x4*)(A.in(I_GNW) + dvi), gw1 = *(const f32x4*)(A.in(I_GNW) + dvi + 4);
    f32x4 dw0 = *(const f32x4*)(A.in(I_DNW) + dvi), dw1 = *(const f32x4*)(A.in(I_DNW) + dvi + 4);
    for (int m = gw; m < NTOK; m += NGW) {
        const float* go = (const float*)(ws + WS_GOUT) + (size_t)m * 512 + col;
        const f32x4 a0 = *(const GAS f32x4*)go, a1 = *(const GAS f32x4*)(go + 4);
        float ss = a0.x * a0.x + a0.y * a0.y + a0.z * a0.z + a0.w * a0.w + a1.x * a1.x + a1.y * a1.y + a1.z * a1.z + a1.w * a1.w;
        ss += __shfl_xor(ss, 1); ss += __shfl_xor(ss, 2); ss += __shfl_xor(ss, 4); ss += __shfl_xor(ss, 8);
        const float rs = rsqrtf(ss * (1.0f / 128.0f) + RMS_EPS);
        const v4u z = *(const GAS v4u*)((const bf16*)(ws + WS_GZ) + (size_t)m * 512 + col);
        float zz[8] = {bflo(z.x), bfhi(z.x), bflo(z.y), bfhi(z.y), bflo(z.z), bfhi(z.z), bflo(z.w), bfhi(z.w)};
        float ov[8] = {a0.x * gw0.x, a0.y * gw0.y, a0.z * gw0.z, a0.w * gw0.w, a1.x * gw1.x, a1.y * gw1.y, a1.z * gw1.z, a1.w * gw1.w};
#pragma unroll
        for (int i = 0; i < 8; ++i) ov[i] = ov[i] * rs * (zz[i] * sigmoidf_(zz[i]));
        v4u o; o.x = pk2(ov[0], ov[1]); o.y = pk2(ov[2], ov[3]); o.z = pk2(ov[4], ov[5]); o.w = pk2(ov[6], ov[7]);
        *(GAS v4u*)((bf16*)(ws + WS_OA) + (size_t)m * 1024 + col) = o;
        const int vh = dvi >> 6, dd = dvi & 63;
        const bf16* o16 = (const bf16*)(ws + WS_O16) + (size_t)m * 1024 + (hd * 4 + vh) * 64 + dd;
        const v4u p1 = *(const GAS v4u*)o16, p2 = *(const GAS v4u*)(o16 + 128);
        float d[8] = {bflo(p1.x) - lam * bflo(p2.x), bfhi(p1.x) - lam * bfhi(p2.x), bflo(p1.y) - lam * bflo(p2.y), bfhi(p1.y) - lam * bfhi(p2.y),
                      bflo(p1.z) - lam * bflo(p2.z), bfhi(p1.z) - lam * bfhi(p2.z), bflo(p1.w) - lam * bflo(p2.w), bfhi(p1.w) - lam * bfhi(p2.w)};
        float s2 = 0.f;
#pragma unroll
        for (int i = 0; i < 8; ++i) s2 += d[i] * d[i];
        s2 += __shfl_xor(s2, 1); s2 += __shfl_xor(s2, 2); s2 += __shfl_xor(s2, 4); s2 += __shfl_xor(s2, 8);
        const float r2 = rsqrtf(s2 * (1.0f / 128.0f) + RMS_EPS) * (1.0f - LAMBDA_INIT);
        const float dwv[8] = {dw0.x, dw0.y, dw0.z, dw0.w, dw1.x, dw1.y, dw1.z, dw1.w};
#pragma unroll
        for (int i = 0; i < 8; ++i) d[i] = d[i] * r2 * dwv[i];
        o.x = pk2(d[0], d[1]); o.y = pk2(d[2], d[3]); o.z = pk2(d[4], d[5]); o.w = pk2(d[6], d[7]);
        *(GAS v4u*)((bf16*)(ws + WS_OA) + (size_t)m * 1024 + 512 + col) = o;
    }
}

__device__ __forceinline__ void ln_pass(const float* v, const float* g, const float* bb, float* xf, bf16* xb, int gw, int NGW, int lane) {
    f32x4 gg[4], be[4];
#pragma unroll
    for (int j = 0; j < 4; ++j) { gg[j] = *(const f32x4*)(g + 4 * lane + 256 * j); be[j] = *(const f32x4*)(bb + 4 * lane + 256 * j); }
    for (int m = gw; m < NTOK; m += NGW) {
        const GAS f32x4* xr = (const GAS f32x4*)(v + (size_t)m * 1024) + lane;
        f32x4 x[4]; float s = 0.f;
#pragma unroll
        for (int j = 0; j < 4; ++j) { x[j] = xr[64 * j]; s += (x[j].x + x[j].y) + (x[j].z + x[j].w); }
        const float mean = wave_sum(s) * (1.f / 1024.f); float s2 = 0.f;
#pragma unroll
        for (int j = 0; j < 4; ++j) { x[j] = x[j] - mean; s2 += (x[j].x * x[j].x + x[j].y * x[j].y) + (x[j].z * x[j].z + x[j].w * x[j].w); }
        const float rstd = rsqrtf(wave_sum(s2) * (1.f / 1024.f) + LN_EPS);
#pragma unroll
        for (int j = 0; j < 4; ++j) {
            const f32x4 y = x[j] * rstd * gg[j] + be[j];
            if (xf) *((GAS f32x4*)(xf + (size_t)m * 1024) + lane + 64 * j) = y;
            if (xb) { v2u o; o.x = pk2(y.x, y.y); o.y = pk2(y.z, y.w); *((GAS v2u*)(xb + (size_t)m * 1024) + lane + 64 * j) = o; }
        }
    }
}

__device__ __forceinline__ void ln_pass_b(const bf16* v, const float* g, const float* bb, bf16* xb, int gw, int NGW, int lane) {
    f32x4 gg[4], be[4];
#pragma unroll
    for (int j = 0; j < 2; ++j) { gg[2 * j] = *(const f32x4*)(g + 8 * lane + 512 * j); gg[2 * j + 1] = *(const f32x4*)(g + 8 * lane + 512 * j + 4); be[2 * j] = *(const f32x4*)(bb + 8 * lane + 512 * j); be[2 * j + 1] = *(const f32x4*)(bb + 8 * lane + 512 * j + 4); }
    for (int m = gw; m < NTOK; m += NGW) {
        f32x4 x[4]; float s = 0.f;
#pragma unroll
        for (int j = 0; j < 2; ++j) { const v4u w = *((const GAS v4u*)(v + (size_t)m * 1024) + lane + 64 * j);
            x[2 * j] = (f32x4){bflo(w.x), bfhi(w.x), bflo(w.y), bfhi(w.y)}; x[2 * j + 1] = (f32x4){bflo(w.z), bfhi(w.z), bflo(w.w), bfhi(w.w)}; }
#pragma unroll
        for (int j = 0; j < 4; ++j) s += (x[j].x + x[j].y) + (x[j].z + x[j].w);
        const float mean = wave_sum(s) * (1.f / 1024.f); float s2 = 0.f;
#pragma unroll
        for (int j = 0; j < 4; ++j) { x[j] = x[j] - mean; s2 += (x[j].x * x[j].x + x[j].y * x[j].y) + (x[j].z * x[j].z + x[j].w * x[j].w); }
        const float rstd = rsqrtf(wave_sum(s2) * (1.f / 1024.f) + LN_EPS);
#pragma unroll
        for (int j = 0; j < 2; ++j) { const f32x4 y0 = x[2 * j] * rstd * gg[2 * j] + be[2 * j], y1 = x[2 * j + 1] * rstd * gg[2 * j + 1] + be[2 * j + 1];
            v4u o; o.x = pk2(y0.x, y0.y); o.y = pk2(y0.z, y0.w); o.z = pk2(y1.x, y1.y); o.w = pk2(y1.z, y1.w); *((GAS v4u*)(xb + (size_t)m * 1024) + lane + 64 * j) = o; }
    }
}

__device__ __forceinline__ void moe_route(const KA& A, LAS unsigned char* lds, int gw, int NGW, int tid, int lane, const float* v1) {
    unsigned char* ws = A.ws;
    LAS float* rw = (LAS float*)lds;
    LAS unsigned* hist = (LAS unsigned*)(lds + MISC_OFF);
    LAS float* lgb = (LAS float*)(lds + MISC_OFF + 2048);
    { const float* src = A.in(I_RW);
      for (int i = tid; i < 1024 * 32 / 4; i += 512) { const int k = i >> 3, c = i & 7, rho = (k >> 2) + 256 * (k & 3); *(LAS f32x4*)(rw + rho * 32 + ((c ^ ((rho >> 1) & 7)) << 2)) = *((const f32x4*)src + i); }
      const float* lng = A.in(I_LN2G); const float* lnb = A.in(I_LN2B);
      for (int i = tid; i < 256; i += 512) { *((LAS f32x4*)lgb + i) = *((const f32x4*)lng + i); *((LAS f32x4*)(lgb + 1024) + i) = *((const f32x4*)lnb + i); } }
    __syncthreads();
    const float rbias = A.in(I_RB)[lane & 31];
    const int wv = tid >> 6, sw = (lane >> 1) & 7;
    const LAS float* pc[2][8];
#pragma unroll
    for (int hcc = 0; hcc < 2; ++hcc)
#pragma unroll
        for (int c = 0; c < 8; ++c) { unsigned a = (unsigned)(uintptr_t)(rw + (lane + 512 * hcc) * 32 + ((c ^ sw) << 2)); asm volatile("" : "+v"(a)); pc[hcc][c] = (const LAS float*)(uintptr_t)a; }
    for (int grp = gw / NWAVES; grp < NTOK / 64; grp += NGW / NWAVES) {
    if (tid < 32) hist[tid] = 0u;
    __syncthreads();
#pragma unroll 1
    for (int pr = 0; pr < 4; ++pr) {
        const int m0 = grp * 64 + wv * 8 + pr * 2;
        typedef float f32x2r __attribute__((ext_vector_type(2)));
        f32x4 y[2][4];
#pragma unroll
        for (int t2 = 0; t2 < 2; ++t2) {
            const GAS v2u* xr = (const GAS v2u*)((const bf16*)v1 + (size_t)(m0 + t2) * 1024) + lane;
            float s = 0.f;
#pragma unroll
            for (int j = 0; j < 4; ++j) { const v2u w = xr[64 * j]; y[t2][j] = (f32x4){bflo(w.x), bfhi(w.x), bflo(w.y), bfhi(w.y)}; s += (y[t2][j].x + y[t2][j].y) + (y[t2][j].z + y[t2][j].w); }
            const float mean = wave_sum(s) * (1.f / 1024.f); float s2 = 0.f;
#pragma unroll
            for (int j = 0; j < 4; ++j) { y[t2][j] = y[t2][j] - mean; s2 += (y[t2][j].x * y[t2][j].x + y[t2][j].y * y[t2][j].y) + (y[t2][j].z * y[t2][j].z + y[t2][j].w * y[t2][j].w); }
            const float rstd = rsqrtf(wave_sum(s2) * (1.f / 1024.f) + LN_EPS);
#pragma unroll
            for (int j = 0; j < 4; ++j) { y[t2][j] = y[t2][j] * rstd * *((const LAS f32x4*)lgb + lane + 64 * j) + *((const LAS f32x4*)(lgb + 1024) + lane + 64 * j);
                v2u o; o.x = pk2(y[t2][j].x, y[t2][j].y); o.y = pk2(y[t2][j].z, y[t2][j].w); *((GAS v2u*)((bf16*)(ws + WS_X2B) + (size_t)(m0 + t2) * 1024) + lane + 64 * j) = o; }
        }
        f32x2r ac2[32];
#pragma unroll
        for (int e = 0; e < 32; ++e) ac2[e] = (f32x2r){0.f, 0.f};
#pragma unroll
        for (int j = 0; j < 4; ++j) {
#pragma unroll
            for (int cc = 0; cc < 4; ++cc) {
                const f32x2r xv = {y[0][j][cc], y[1][j][cc]};
#pragma unroll
                for (int c = 0; c < 8; ++c) { const f32x4 w = *(const LAS f32x4*)(pc[cc >> 1][c] + (64 * j + 256 * (cc & 1)) * 32);
                    ac2[4 * c] += xv * w.x; ac2[4 * c + 1] += xv * w.y; ac2[4 * c + 2] += xv * w.z; ac2[4 * c + 3] += xv * w.w; }
                asm volatile("" ::: "memory");
            }
        }
        float acc[2][32];
#pragma unroll
        for (int e = 0; e < 32; ++e) { acc[0][e] = ac2[e].x; acc[1][e] = ac2[e].y; }
#pragma unroll
        for (int t2 = 0; t2 < 2; ++t2) {
            const int m = m0 + t2;
#pragma unroll
            for (int w = 16; w >= 1; w >>= 1) {
                const bool up = (lane & w) != 0;
#pragma unroll
                for (int i = 0; i < w; ++i) { const float send = up ? acc[t2][i] : acc[t2][i + w]; const float keep = up ? acc[t2][i + w] : acc[t2][i]; acc[t2][i] = keep + __shfl_xor(send, w); }
            }
            float mine = acc[t2][0] + __shfl_xor(acc[t2][0], 32);
            mine += rbias;
            float tv[4]; int ti[4];
            float cur = mine;
#pragma unroll
            for (int k = 0; k < 4; ++k) {
                float best = cur; int bi = lane & 31;
#pragma unroll
                for (int o = 1; o < 32; o <<= 1) { const float ov = __shfl_xor(best, o); const int oi = __shfl_xor(bi, o); if (ov > best || (ov == best && oi < bi)) { best = ov; bi = oi; } }
                tv[k] = best; ti[k] = bi;
                if ((lane & 31) == bi) cur = -INFINITY;
            }
            const float e1 = __expf(tv[1] - tv[0]), e2 = __expf(tv[2] - tv[0]), e3 = __expf(tv[3] - tv[0]);
            const float inv = 1.0f / (1.0f + e1 + e2 + e3);
            if (lane == 0) {
                *(GAS v4u*)((int*)(ws + WS_TOPI) + (size_t)m * 4) = (v4u){(unsigned)ti[0], (unsigned)ti[1], (unsigned)ti[2], (unsigned)ti[3]};
                *(GAS f32x4*)((float*)(ws + WS_GATE) + (size_t)m * 4) = (f32x4){inv, e1 * inv, e2 * inv, e3 * inv};
                for (int k = 0; k < 4; ++k) __hip_atomic_fetch_add(&hist[ti[k]], 1u, __ATOMIC_RELAXED, __HIP_MEMORY_SCOPE_WORKGROUP);
            }
        }
    }
    __syncthreads();
    if (tid < 32) { ((unsigned*)(ws + WS_GCNT))[grp * 32 + tid] = hist[tid]; if (hist[tid]) atomicAdd((unsigned*)(ws + WS_CTL) + CW_CNT + tid, hist[tid]); }
    __syncthreads();
    }
}

__device__ __forceinline__ void moe_layout(const KA& A, LAS unsigned char* lds, int tid) {
    LAS int* T = (LAS int*)(lds + MISC_OFF + 256);
    LAS int* C32 = (LAS int*)(lds + MISC_OFF);
    if (tid < 32) C32[tid] = (int)__hip_atomic_load((const unsigned*)(A.ws + WS_CTL) + CW_CNT + tid, __ATOMIC_RELAXED, __HIP_MEMORY_SCOPE_AGENT);
    __syncthreads();
    if (tid == 0) {
        int row = 0;
        for (int e = 0; e < 32; ++e) {
            const int c = C32[e]; const int nt = (c + 255) >> 8;
            T[e] = row; for (int t = 0; t < nt; ++t) T[64 + (row >> 8) + t] = e; row += nt * 256;
        }
        T[32] = row >> 8;
    }
    __syncthreads();
}

__device__ __forceinline__ void moe_scatter(const KA& A, LAS unsigned char* lds, int blk, int G, int tid, int wave, int lane) {
    unsigned char* ws = A.ws;
    LAS int* T = (LAS int*)(lds + MISC_OFF + 256);
    LAS unsigned* lc = (LAS unsigned*)(lds);
    const float* x2 = A.out();
    if (blk < NEXP) {
        const int c = (int)__hip_atomic_load((const unsigned*)(ws + WS_CTL) + CW_CNT + blk, __ATOMIC_RELAXED, __HIP_MEMORY_SCOPE_AGENT);
        for (int i = T[blk] + c + tid; i < T[blk] + ((c + 255) & ~255); i += 512) ((int*)(ws + WS_TOKTAB))[i] = 0;
    }
    for (int grp = blk; grp < NTOK / 64; grp += G) {
        int e = 0;
        if (tid < 256) { e = ((const int*)(ws + WS_TOPI))[(size_t)grp * 256 + tid]; lc[320 + tid] = (unsigned)e; }
        { unsigned b = 0; const unsigned* gc = (const unsigned*)(ws + WS_GCNT) + (tid & 31);
#pragma unroll
          for (int q = 0; q < 16; ++q) { const int g2 = (tid >> 5) + 16 * q; b += (g2 < grp) ? gc[g2 * 32] : 0u; }
          lc[576 + tid] = b; }
        __syncthreads();
        if (tid < 32) { unsigned b = 0;
#pragma unroll
            for (int p = 0; p < 16; ++p) b += lc[576 + p * 32 + tid]; lc[32 + tid] = b; }
        __syncthreads();
        if (tid < 256) { unsigned rank = 0; for (int a2 = 0; a2 < tid; ++a2) rank += (lc[320 + a2] == (unsigned)e) ? 1u : 0u;
            const int slot = T[e] + (int)lc[32 + e] + (int)rank; lc[64 + tid] = (unsigned)slot; ((int*)(ws + WS_DEST))[(size_t)grp * 256 + tid] = slot;
            ((int*)(ws + WS_TOKTAB))[slot] = grp * 64 + (tid >> 2); }
        __syncthreads();
        __syncthreads();
    }
}

__device__ __forceinline__ void moe_route_mfma(const KA& A, LAS unsigned char* lds, int gw, int NGW, int tid, int lane, const float* v1) {
    unsigned char* ws = A.ws;
    LAS unsigned* hist = (LAS unsigned*)(lds + MISC_OFF);
    LAS float* lgb = (LAS float*)(lds + MISC_OFF + 2048);
    const int wv = __builtin_amdgcn_readfirstlane(tid >> 6);
    { const float* src = A.in(I_RW);
      for (int it = tid; it < 1024; it += 512) {
          const int sk = it >> 3, eq = it & 7, s = sk >> 2, kg = sk & 3;
          f32x4 v[8];
#pragma unroll
          for (int t = 0; t < 8; ++t) v[t] = *(const f32x4*)(src + (size_t)(8 * sk + t) * 32 + 4 * eq);
#pragma unroll
          for (int c = 0; c < 4; ++c) { const int e = 4 * eq + c, mb = e >> 4, i = e & 15;
              unsigned h[4], l[4];
#pragma unroll
              for (int p2 = 0; p2 < 4; ++p2) { const float x0 = v[2 * p2][c], x1 = v[2 * p2 + 1][c]; h[p2] = pk2(x0, x1); l[p2] = pk2(x0 - bflo(h[p2]), x1 - bfhi(h[p2])); }
              LAS unsigned char* d = lds + (size_t)((s * 2 + mb) * 2) * 1024 + (kg * 16 + i) * 16;
              *(LAS v4u*)d = (v4u){h[0], h[1], h[2], h[3]}; *(LAS v4u*)(d + 1024) = (v4u){l[0], l[1], l[2], l[3]}; } }
      const float* lng = A.in(I_LN2G); const float* lnb = A.in(I_LN2B);
      for (int i = tid; i < 256; i += 512) { *((LAS f32x4*)lgb + i) = *((const f32x4*)lng + i); *((LAS f32x4*)(lgb + 1024) + i) = *((const f32x4*)lnb + i); } }
    __syncthreads();
    for (int grp = gw / NWAVES; grp < NTOK / 64; grp += NGW / NWAVES) {
    if (tid < 32) hist[tid] = 0u;
    __syncthreads();
    if (wv < 4) {
        const int j = lane & 15, kg = lane >> 4;
        const int m = grp * 64 + wv * 16 + j;
        const GAS v4u* xr = (const GAS v4u*)((const bf16*)v1 + (size_t)m * 1024 + 8 * kg);
        float sm = 0.f, sq = 0.f;
        { v4u pa[8];
#pragma unroll
          for (int i = 0; i < 8; ++i) pa[i] = xr[4 * i];
#pragma unroll
          for (int blk8 = 0; blk8 < 4; ++blk8) {
              v4u pn[8];
              if (blk8 < 3) {
#pragma unroll
                  for (int i = 0; i < 8; ++i) pn[i] = xr[4 * (8 * (blk8 + 1) + i)]; }
              __builtin_amdgcn_sched_barrier(0);
              float s0 = 0.f, s1 = 0.f, q0 = 0.f, q1 = 0.f;
#pragma unroll
              for (int i = 0; i < 8; ++i) { const unsigned w[4] = {pa[i].x, pa[i].y, pa[i].z, pa[i].w};
#pragma unroll
                  for (int p2 = 0; p2 < 4; ++p2) { const float a = bflo(w[p2]), b = bfhi(w[p2]); s0 += a; s1 += b; q0 = __builtin_fmaf(a, a, q0); q1 = __builtin_fmaf(b, b, q1); } }
              sm += s0 + s1; sq += q0 + q1;
              __builtin_amdgcn_sched_barrier(0);
              if (blk8 < 3) {
#pragma unroll
                  for (int i = 0; i < 8; ++i) pa[i] = pn[i]; }
          } }
        sm += __shfl_xor(sm, 16); sm += __shfl_xor(sm, 32); sq += __shfl_xor(sq, 16); sq += __shfl_xor(sq, 32);
        const float mean = sm * (1.f / 1024.f), rstd = rsqrtf(__builtin_fmaxf(sq * (1.f / 1024.f) - mean * mean, 0.f) + LN_EPS), c0 = -mean * rstd;
        f32x4 acc[2][3];
#pragma unroll
        for (int mb = 0; mb < 2; ++mb)
#pragma unroll
            for (int q = 0; q < 3; ++q) acc[mb][q] = (f32x4){0.f, 0.f, 0.f, 0.f};
        const LAS f32x4* gp = (const LAS f32x4*)lgb + 2 * kg;
        GAS v4u* xo = (GAS v4u*)((bf16*)(ws + WS_X2B) + (size_t)m * 1024 + 8 * kg);
        const LAS unsigned char* fr = lds + lane * 16;
        v4u cur[8];
#pragma unroll
        for (int i = 0; i < 8; ++i) cur[i] = xr[4 * i];
#pragma unroll
        for (int blk8 = 0; blk8 < 4; ++blk8) {
            v4u nxt[8];
            if (blk8 < 3) {
#pragma unroll
                for (int i = 0; i < 8; ++i) nxt[i] = xr[4 * (8 * (blk8 + 1) + i)]; }
#pragma unroll
            for (int i = 0; i < 8; ++i) { const int s = 8 * blk8 + i;
                const f32x4 g0 = gp[8 * s], g1 = gp[8 * s + 1], b0 = gp[256 + 8 * s], b1 = gp[256 + 8 * s + 1];
                const float gg[8] = {g0.x, g0.y, g0.z, g0.w, g1.x, g1.y, g1.z, g1.w}, bb[8] = {b0.x, b0.y, b0.z, b0.w, b1.x, b1.y, b1.z, b1.w};
                const unsigned w[4] = {cur[i].x, cur[i].y, cur[i].z, cur[i].w};
                unsigned h[4], l[4];
#pragma unroll
                for (int p2 = 0; p2 < 4; ++p2) {
                    const float x0 = __builtin_fmaf(__builtin_fmaf(bflo(w[p2]), rstd, c0), gg[2 * p2], bb[2 * p2]), x1 = __builtin_fmaf(__builtin_fmaf(bfhi(w[p2]), rstd, c0), gg[2 * p2 + 1], bb[2 * p2 + 1]);
                    h[p2] = pk2(x0, x1); l[p2] = pk2(x0 - bflo(h[p2]), x1 - bfhi(h[p2])); }
                const v4u hv = {h[0], h[1], h[2], h[3]}, lv = {l[0], l[1], l[2], l[3]};
                xo[4 * s] = hv;
                const bf16x8 Bh = __builtin_bit_cast(bf16x8, hv), Bl = __builtin_bit_cast(bf16x8, lv);
#pragma unroll
                for (int mb = 0; mb < 2; ++mb) {
                    const bf16x8 Ah = *(const LAS bf16x8*)(fr + ((s * 2 + mb) * 2) * 1024), Al = *(const LAS bf16x8*)(fr + ((s * 2 + mb) * 2 + 1) * 1024);
                    acc[mb][0] = mfma16(Ah, Bh, acc[mb][0]); acc[mb][1] = mfma16(Ah, Bl, acc[mb][1]); acc[mb][2] = mfma16(Al, Bh, acc[mb][2]); }
                asm volatile("" ::: "memory"); __builtin_amdgcn_sched_barrier(0);
            }
            if (blk8 < 3) {
#pragma unroll
                for (int i = 0; i < 8; ++i) cur[i] = nxt[i]; }
        }
        float val[8];
#pragma unroll
        for (int c = 0; c < 8; ++c) val[c] = (acc[c >> 2][0][c & 3] + acc[c >> 2][1][c & 3]) + acc[c >> 2][2][c & 3] + A.in(I_RB)[16 * (c >> 2) + 4 * kg + (c & 3)];
        float tv[4]; int ti[4];
#pragma unroll
        for (int k = 0; k < 4; ++k) {
            float best = val[0]; int bi = 4 * kg;
#pragma unroll
            for (int c = 1; c < 8; ++c) { if (val[c] > best) { best = val[c]; bi = 16 * (c >> 2) + 4 * kg + (c & 3); } }
#pragma unroll
            for (int o = 16; o <= 32; o <<= 1) { const float ov = __shfl_xor(best, o); const int oi = __shfl_xor(bi, o); if (ov > best || (ov == best && oi < bi)) { best = ov; bi = oi; } }
            tv[k] = best; ti[k] = bi;
#pragma unroll
            for (int c = 0; c < 8; ++c) if (16 * (c >> 2) + 4 * kg + (c & 3) == bi) val[c] = -INFINITY;
        }
        const float e1 = __expf(tv[1] - tv[0]), e2 = __expf(tv[2] - tv[0]), e3 = __expf(tv[3] - tv[0]);
        const float inv = 1.0f / (1.0f + e1 + e2 + e3);
        if (kg == 0) {
            *(GAS v4u*)((int*)(ws + WS_TOPI) + (size_t)m * 4) = (v4u){(unsigned)ti[0], (unsigned)ti[1], (unsigned)ti[2], (unsigned)ti[3]};
            *(GAS f32x4*)((float*)(ws + WS_GATE) + (size_t)m * 4) = (f32x4){inv, e1 * inv, e2 * inv, e3 * inv};
#pragma unroll
            for (int k = 0; k < 4; ++k) __hip_atomic_fetch_add(&hist[ti[k]], 1u, __ATOMIC_RELAXED, __HIP_MEMORY_SCOPE_WORKGROUP);
        }
    }
    __syncthreads();
    if (tid < 32) { ((unsigned*)(ws + WS_GCNT))[grp * 32 + tid] = hist[tid]; if (hist[tid]) atomicAdd((unsigned*)(ws + WS_CTL) + CW_CNT + tid, hist[tid]); }
    __syncthreads();
    }
}

__device__ __forceinline__ void moe_combine(const KA& A, int gw, int NGW, int lane) {
    unsigned char* ws = A.ws;
    f32x4 gg[4], be[4];
#pragma unroll
    for (int j = 0; j < 4; ++j) { gg[j] = *(const f32x4*)(A.in(I_LN3G) + 4 * lane + 256 * j); be[j] = *(const f32x4*)(A.in(I_LN3B) + 4 * lane + 256 * j); }
    for (int m = gw; m < NTOK; m += NGW) {
        const v4u dst = *(const GAS v4u*)((const int*)(ws + WS_DEST) + (size_t)m * 4);
        const f32x4 gt = *(const GAS f32x4*)((const float*)(ws + WS_GATE) + (size_t)m * 4);
        const unsigned dd[4] = {dst.x, dst.y, dst.z, dst.w}; const float gk[4] = {gt.x, gt.y, gt.z, gt.w};
        f32x4 x[4]; float s = 0.f;
#pragma unroll
        for (int j = 0; j < 4; ++j) {
#if defined(PROBE_RAW16_OFF)
            f32x4 v; { const v2u y = *((const GAS v2u*)((const bf16*)(ws + (size_t)(PROBE_RAW16_OFF) * MiB) + (size_t)m * 1024) + lane + 64 * j);
                v.x = (float)(y.x & 0xffffu) * (1.0f / 65536.0f); v.y = (float)(y.x >> 16) * (1.0f / 65536.0f); v.z = (float)(y.y & 0xffffu) * (1.0f / 65536.0f); v.w = (float)(y.y >> 16) * (1.0f / 65536.0f); }
#elif defined(PROBE_BF16_OFF)
            f32x4 v; { const v2u y = *((const GAS v2u*)((const bf16*)(ws + (size_t)(PROBE_BF16_OFF) * MiB) + (size_t)m * 1024) + lane + 64 * j); v.x = bflo(y.x); v.y = bfhi(y.x); v.z = bflo(y.y); v.w = bfhi(y.y); }
#elif defined(PROBE_F32_OFF)
            f32x4 v = *((const GAS f32x4*)((const float*)(ws + (size_t)(PROBE_F32_OFF) * MiB) + (size_t)m * 1024) + lane + 64 * j);
#elif defined(PROBE_INPUT)
            f32x4 v = *((const GAS f32x4*)(A.in(I_X) + (size_t)m * 1024) + lane + 64 * j) + *((const GAS f32x4*)(A.in(I_EWD) + (size_t)m * 2048) + lane + 64 * j) + *((const GAS f32x4*)(A.in(I_WIN) + (size_t)m * 224) + lane + 64 * j);
#else
            f32x4 v; { const v2u xw = *((const GAS v2u*)((const bf16*)(ws + WS_X2B) + (size_t)m * 1024) + lane + 64 * j); v = (f32x4){bflo(xw.x), bfhi(xw.x), bflo(xw.y), bfhi(xw.y)} * DN_ALPHA; }
#endif
#ifndef SKIP_MOE
#pragma unroll
            for (int k = 0; k < 4; ++k) { const v2u y = *((const GAS v2u*)((const bf16*)(ws + WS_Y) + (size_t)dd[k] * 1024) + lane + 64 * j);
                v.x += gk[k] * bflo(y.x); v.y += gk[k] * bfhi(y.x); v.z += gk[k] * bflo(y.y); v.w += gk[k] * bfhi(y.y); }
#endif
            x[j] = v; s += (v.x + v.y) + (v.z + v.w);
        }
#if defined(PROBE_RAW16_OFF)
#pragma unroll
        for (int j = 0; j < 4; ++j) *((GAS f32x4*)(A.out() + (size_t)m * 1024) + lane + 64 * j) = x[j];
        (void)s;
#elif defined(PROBE_BITS)
#pragma unroll
        for (int j = 0; j < 4; ++j) { f32x4 q = x[j] * 4096.0f; q.x -= floorf(q.x); q.y -= floorf(q.y); q.z -= floorf(q.z); q.w -= floorf(q.w); *((GAS f32x4*)(A.out() + (size_t)m * 1024) + lane + 64 * j) = q; }
        (void)s;
#else
        const float mean = wave_sum(s) * (1.f / 1024.f); float s2 = 0.f;
#pragma unroll
        for (int j = 0; j < 4; ++j) { x[j] = x[j] - mean; s2 += (x[j].x * x[j].x + x[j].y * x[j].y) + (x[j].z * x[j].z + x[j].w * x[j].w); }
        const float rstd = rsqrtf(wave_sum(s2) * (1.f / 1024.f) + LN_EPS);
#pragma unroll
        for (int j = 0; j < 4; ++j) *((GAS f32x4*)(A.out() + (size_t)m * 1024) + lane + 64 * j) = x[j] * rstd * gg[j] + be[j];
#endif
    }
}
struct InprojMap { unsigned char* ws;
    __device__ __forceinline__ pg8::TileDst operator()(const pg8::Unit& u) const {
        pg8::TileDst d; d.bias = nullptr; d.scale = 1.f; const size_t r0 = (size_t)u.pm * 256; const int pn = u.pn;
        if (pn < 6) { d.base = (bf16*)(ws + WS_GQKV) + r0 * 1536 + pn * 256; d.ldc = 1536; }
        else if (pn < 8) { d.base = (bf16*)(ws + WS_GZ) + r0 * 512 + (pn - 6) * 256; d.ldc = 512; }
        else { const int w = (pn - 8) >> 1; d.base = (bf16*)(ws + (w == 0 ? WS_DQ : (w == 1 ? WS_DK : WS_DV))) + r0 * 512 + ((pn - 8) & 1) * 256; d.ldc = 512; if (w == 0) d.scale = attn_body::C2; }
        return d; } };
struct KvMap { unsigned char* ws;
    __device__ __forceinline__ pg8::TileDst operator()(const pg8::Unit& u) const {
        pg8::TileDst d; d.bias = nullptr; d.scale = 1.f; d.ldc = 256;
        d.base = (bf16*)(ws + ((u.pn >> 2) ? WS_VMAT : WS_KMAT)) + (size_t)((u.pm * 4 + (u.pn & 3)) * 256) * 256; return d; } };
struct WqkMap { unsigned char* ws;
    __device__ __forceinline__ pg8::TileDst operator()(const pg8::Unit& u) const {
        pg8::TileDst d; d.bias = nullptr; d.scale = 0.0625f * 1.4426950408889634f; d.ldc = 1024;
        d.base = (bf16*)(ws + WS_WQK) + (size_t)(u.pm >> 2) * 1048576 + (size_t)((u.pm & 3) * 256) * 1024 + (u.pn & 3) * 256; return d; } };
struct VwoMap { unsigned char* ws;
    __device__ __forceinline__ pg8::TileDst operator()(const pg8::Unit& u) const {
        pg8::TileDst d; d.bias = nullptr; d.scale = 1.f; d.ldc = 1024;
        d.base = (bf16*)(ws + WS_VWO) + (size_t)(u.pn >> 2) * 1048576 + (size_t)((u.pm & 3) * 256) * 1024 + (u.pm >> 2) * 256; return d; } };
struct DownMap { unsigned char* ws; const float* bd;
    __device__ __forceinline__ pg8::TileDst operator()(const pg8::Unit& u) const {
        pg8::TileDst d; d.scale = 1.f; d.ldc = 1024; const int e = u.pn >> 2, pnl = u.pn & 3;
        d.base = (bf16*)(ws + WS_Y) + (size_t)u.pm * 256 * 1024 + pnl * 256; d.bias = bd + e * 1024 + pnl * 256; return d; } };

#ifndef MK_N_LAUNCHES
#define MK_N_LAUNCHES 1
#endif
constexpr int N_PHASES = 17;
__global__ void __launch_bounds__(NWAVES * 64, 2) hybrid_fwd(Args args) {
    extern __shared__ __attribute__((aligned(16))) unsigned char lds_raw[];
    LAS unsigned char* lds = (LAS unsigned char*)lds_raw;
    const int G = gridDim.x, blk = blockIdx.x, NGW = G * NWAVES;
#define PH_IDS unsigned char* ws = WSP(); const KA KAv{ws}; (void)ws; int tid = threadIdx.x; asm volatile("" : "+v"(tid)); const int lane = tid & 63, wave = __builtin_amdgcn_readfirstlane(tid >> 6), gw = blk * NWAVES + wave; (void)lane; (void)gw
#define WSP() ({ const __attribute__((address_space(4))) unsigned long long* p_ = (const __attribute__((address_space(4))) unsigned long long*)__builtin_amdgcn_kernarg_segment_ptr(); asm volatile("" : "+s"(p_)); (unsigned char*)p_[32]; })
#if MK_N_LAUNCHES == 1
    constexpr int lo = 0, hi = N_PHASES;
#else
    const __attribute__((address_space(4))) unsigned char* kap = (const __attribute__((address_space(4))) unsigned char*)__builtin_amdgcn_kernarg_segment_ptr();
    const int lo = *(const __attribute__((address_space(4))) int*)(kap + 264), hi = *(const __attribute__((address_space(4))) int*)(kap + 268);
#endif
    { volatile LAS unsigned* bst0 = (volatile LAS unsigned*)(lds + MISC_OFF + 192);
      if (threadIdx.x < 2) bst0[threadIdx.x] = 0u;
      __syncthreads();
      (void)xcd_barrier_post((unsigned*)(WSP() + WS_CTL) + CW_BAR, bst0); }
#define MKBAR() ({ XcdBarrier b_; b_.bar = (unsigned*)(WSP() + WS_CTL) + CW_BAR; b_.x = xb_xcc_id(); b_.st = (volatile LAS unsigned*)(lds + MISC_OFF + 192); b_; })
#ifndef PH_MASK
#define PH_MASK 0xFFDFF
#endif
#define IN(k) ((((PH_MASK) >> (k)) & 1) && lo <= (k) && (k) < hi)
#ifndef REP_MASK
#define REP_MASK 0
#endif
#define REPS(k) ((((REP_MASK) >> (k)) & 1) ? 2 : 1)
#ifndef BG_MASK
#define BG_MASK 0xA
#endif
#define BG_TAIL(p) do { if (!(((BG_MASK) >> (p)) & 1)) break; __syncthreads(); unsigned* dc_ = (unsigned*)(ws + WS_CTL) + CW_BGDONE + 64 * (p); if (threadIdx.x == 0) __hip_atomic_fetch_add(dc_, 1u, __ATOMIC_RELAXED, __HIP_MEMORY_SCOPE_AGENT); \
    int bt_ = threadIdx.x; asm volatile("" : "+v"(bt_)); bg_pull(KAv, ws, lds, bt_ & 63, 0, 1, dc_, (unsigned)G); } while (0)
#ifndef BAR_REPS
#define BAR_REPS 1
#endif
#define SEAM(k) do { if (IN(k) && (k) + 1 < hi) { const XcdBarrier bar_ = MKBAR(); for (int br_ = 0; br_ < BAR_REPS; ++br_) xcd_barrier(bar_); } } while (0)

    if (IN(0)) for (int rep_ = 0; rep_ < REPS(0); ++rep_) { PH_IDS; p0_prologue(KAv, lds, gw, NGW, wave, lane, tid); }
    SEAM(0);
    if (IN(1)) for (int rep_ = 0; rep_ < REPS(1); ++rep_) { PH_IDS; (void)tid; (void)wave;
        const int GP = (G == 256) ? 224 : G;
        if (blk < GP) { pg8::Gemm g{(const bf16*)(ws + WS_XB), (const bf16*)(ws + WS_WIN), NTOK, INP_N, 1024}; pg8::StaticOrder S; S.init(NTOK, INP_N, GP, blk);
          pg8::EpiBf16Map<InprojMap> E{InprojMap{ws}};
          pg8::gemm_phase<pg8::EpiBf16Map<InprojMap>, pg8::StaticOrder, true, true>(lds, g, S, E); }
        { pg8::Gemm g{(const bf16*)(ws + WS_MEMB), (const bf16*)(ws + WS_WKV), NB * NMEM, 2048, 1024}; pg8::StaticOrder S; S.init(NB * NMEM, 2048, G, (blk + 32) % G);
          pg8::EpiBf16Map<KvMap> E{KvMap{ws}};
          pg8::gemm_phase<pg8::EpiBf16Map<KvMap>, pg8::StaticOrder, true, true>(lds, g, S, E); }
        BG_TAIL(1);
    }
    SEAM(1);
    if (IN(2)) for (int rep_ = 0; rep_ < REPS(2); ++rep_) { PH_IDS;
#ifndef P2_PARTS
#define P2_PARTS 7
#endif
#ifndef REP_PREP
#define REP_PREP 1
#endif
        int cw_head[2] = {-1, -1};
        if (P2_PARTS & 1) for (int rp_ = 0; rp_ < REP_PREP; ++rp_) for (int u = blk; u < NB * 4 * NCHUNK; u += G) gdn_prep_unit(KAv, lds, u, (int)threadIdx.x, cw_head);
        if (P2_PARTS & 2) { pg8::Gemm g{(const bf16*)(ws + WS_KMAT), (const bf16*)(ws + WS_WQH), 2048, 4096, 256}; pg8::WqkOrder S{G, blk};
          pg8::EpiBf16Map<WqkMap> E{WqkMap{ws}};
          pg8::gemm_phase<pg8::EpiBf16Map<WqkMap>, pg8::WqkOrder, true, true>(lds, g, S, E); }
        if (P2_PARTS & 4) { pg8::Gemm g{(const bf16*)(ws + WS_WOH), (const bf16*)(ws + WS_VMAT), 4096, 2048, 256}; pg8::VwoOrder S{G, blk};
          pg8::EpiBf16Map<VwoMap> E{VwoMap{ws}};
          pg8::gemm_phase<pg8::EpiBf16Map<VwoMap>, pg8::VwoOrder, true, true>(lds, g, S, E); }
        BG_TAIL(2);
#if SPLIT23
        split_arrive((unsigned*)(ws + WS_CTL) + CW_SPLIT);
#endif
    }
#if !SPLIT23
    SEAM(2);
#endif
    if (IN(3)) for (int rep_ = 0; rep_ < REPS(3); ++rep_) { PH_IDS;
        const attn_body::AttnTensors AT{(const attn_body::bf16*)(ws + WS_DQ), (const attn_body::bf16*)(ws + WS_DK), (const attn_body::bf16*)(ws + WS_DV), (attn_body::bf16*)(ws + WS_O16)};
#ifndef P3_MODE
#define P3_MODE 0
#endif
#if P3_MODE == 0
        if (blk < NB * 4 * SCAN_SPLIT) {
#if SPLIT23
            split_wait((unsigned*)(ws + WS_CTL) + CW_SPLIT, (unsigned)G, (unsigned*)(ws + WS_CTL) + CW_BAR);
#endif
            gdn_scan(KAv, lds, blk, tid, wave, lane); __syncthreads(); }
        const attn_body::QueueOrder S{(unsigned*)(ws + WS_CTL) + CW_AQ + rep_ * 512, (volatile LAS int*)(lds + MISC_OFF + 200), blk & 7, 0u, 0};
        attn_body::attn_phase<attn_body::QueueOrder>((char*)lds_raw, AT, S);
        BG_TAIL(3);
#else
        if (blk < NB * 4) { gdn_scan(KAv, lds, blk, tid, wave, lane); __syncthreads(); }
        if (P3_MODE == 2) { if (blk < NB * 4) { gdn_scan(KAv, lds, blk, tid, wave, lane); __syncthreads(); } }
        { const XcdBarrier bar_ = MKBAR(); xcd_barrier(bar_); }
        { const attn_body::QueueOrder S{(unsigned*)(ws + WS_CTL) + CW_AQ, (volatile LAS int*)(lds + MISC_OFF + 200), blk & 7, 0u, 0};
          attn_body::attn_phase<attn_body::QueueOrder>((char*)lds_raw, AT, S); }
        if (P3_MODE == 3) { const attn_body::QueueOrder S{(unsigned*)(ws + WS_CTL) + CW_AQ + 512, (volatile LAS int*)(lds + MISC_OFF + 200), blk & 7, 0u, 0};
          attn_body::attn_phase<attn_body::QueueOrder>((char*)lds_raw, AT, S); }
#endif
    }
    SEAM(3);
    if (IN(4)) for (int rep_ = 0; rep_ < REPS(4); ++rep_) { PH_IDS; mixer_post(KAv, gw, NGW, lane); }
    SEAM(4);
    if (IN(5)) for (int rep_ = 0; rep_ < REPS(5); ++rep_) { PH_IDS; (void)tid; (void)wave;
        pg8::Gemm g{(const bf16*)(ws + WS_OA), (const bf16*)(ws + WS_WOUT), NTOK, 1024, 1024}; pg8::StaticOrder S; S.init(NTOK, 1024, G, blk);
        pg8::EpiResBf16 E{KAv.in(I_X), (bf16*)(ws + WS_V1), DN_ALPHA};
        pg8::gemm_phase<pg8::EpiResBf16, pg8::StaticOrder, true, true>(lds, g, S, E);
    }
    SEAM(5);
    if (IN(6)) for (int rep_ = 0; rep_ < REPS(6); ++rep_) { PH_IDS; ln_pass_b((const bf16*)(ws + WS_V1), KAv.in(I_LN1G), KAv.in(I_LN1B), (bf16*)(ws + WS_X1B), gw, NGW, lane); }
    SEAM(6);
    if (IN(7)) for (int rep_ = 0; rep_ < REPS(7); ++rep_) { PH_IDS; (void)tid; (void)wave;
        pg8::Gemm g{(const bf16*)(ws + WS_X1B), (const bf16*)(ws + WS_WQK), NTOK, 1024, 1024}; pg8::BatchOrder S; S.init(NTOK, 1024, G, blk);
        pg8::EpiSoftmax E{(bf16*)(ws + WS_PM)};
        pg8::gemm_phase<pg8::EpiSoftmax, pg8::BatchOrder, false, true>(lds, g, S, E);
    }
    SEAM(7);
    if (IN(8)) for (int rep_ = 0; rep_ < REPS(8); ++rep_) { PH_IDS; (void)tid; (void)wave;
        pg8::Gemm g{(const bf16*)(ws + WS_PM), (const bf16*)(ws + WS_VWO), NTOK, 1024, 1024}; pg8::BatchOrder S; S.init(NTOK, 1024, G, blk);
        pg8::EpiResBf16B E{(const bf16*)(ws + WS_X1B), (bf16*)(ws + WS_V1), DN_ALPHA};
        pg8::gemm_phase<pg8::EpiResBf16B, pg8::BatchOrder, true, true>(lds, g, S, E);
    }
    SEAM(8);
    if (IN(9)) for (int rep_ = 0; rep_ < REPS(9); ++rep_) { PH_IDS; ln_pass((const float*)(ws + WS_V1), KAv.in(I_LN2G), KAv.in(I_LN2B), KAv.out(), (bf16*)(ws + WS_X2B), gw, NGW, lane); }
    SEAM(9);
    if (IN(10)) for (int rep_ = 0; rep_ < REPS(10); ++rep_) { PH_IDS;
#ifndef ROUTER_MFMA
#define ROUTER_MFMA 1
#endif
#if ROUTER_MFMA
        moe_route_mfma(KAv, lds, gw, NGW, tid, lane, (const float*)(ws + WS_V1));
#else
        moe_route(KAv, lds, gw, NGW, tid, lane, (const float*)(ws + WS_V1));
#endif
    }
    SEAM(10);
    if (IN(11)) for (int rep_ = 0; rep_ < REPS(11); ++rep_) { PH_IDS; moe_layout(KAv, lds, tid);
#ifndef P11_REP_SC
#define P11_REP_SC 1
#endif
#pragma unroll 1
        for (int sc_ = 0; sc_ < P11_REP_SC; ++sc_) moe_scatter(KAv, lds, blk, G, tid, wave, lane);
        bg_pull(KAv, ws, lds, lane, 0, -1, nullptr, 0u); }
    SEAM(11);
    if (IN(12)) for (int rep_ = 0; rep_ < REPS(12); ++rep_) { PH_IDS;
        if (!IN(11)) moe_layout(KAv, lds, tid);
        const LAS int* T = (const LAS int*)(lds + MISC_OFF + 256);
        pg8::Gemm g{(const bf16*)(ws + WS_X2B), (const bf16*)(ws + WS_WGU), MOE_MAXROWS, NEXP * 2048, 1024, (const int*)(ws + WS_TOKTAB)};
        pg8::MoeOrder S{G, blk, 8, __builtin_amdgcn_readfirstlane(T[32]), T + 64};
        pg8::EpiSwiglu E{(bf16*)(ws + WS_H), KAv.in(I_EBG), KAv.in(I_EBU)};
        pg8::gemm_phase<pg8::EpiSwiglu, pg8::MoeOrder, true, true, true>(lds, g, S, E);
        bg_pull(KAv, ws, lds, lane, 1, -1, nullptr, 0u);
    }
    SEAM(12);
    if (IN(13)) for (int rep_ = 0; rep_ < REPS(13); ++rep_) { PH_IDS;
        if (!IN(11)) moe_layout(KAv, lds, tid);
        const LAS int* T = (const LAS int*)(lds + MISC_OFF + 256);
        pg8::Gemm g{(const bf16*)(ws + WS_H), (const bf16*)(ws + WS_WD), MOE_MAXROWS, NEXP * 1024, 1024};
        pg8::MoeOrder S{G, blk, 4, __builtin_amdgcn_readfirstlane(T[32]), T + 64};
        pg8::EpiBf16Map<DownMap> E{DownMap{ws, KAv.in(I_EBD)}};
        pg8::gemm_phase<pg8::EpiBf16Map<DownMap>, pg8::MoeOrder, true, true>(lds, g, S, E);
    }
    SEAM(13);
    if (IN(14)) for (int rep_ = 0; rep_ < REPS(14); ++rep_) { PH_IDS; moe_combine(KAv, gw, NGW, lane); }
#undef IN
#undef SEAM
}


#if MK_N_LAUNCHES == 99
__global__ void dbg_chk(const unsigned* p, size_t n, unsigned long long* slot) {
    unsigned long long s = 0;
    for (size_t i = blockIdx.x * (size_t)blockDim.x + threadIdx.x; i < n; i += (size_t)gridDim.x * blockDim.x) s += (unsigned long long)p[i] * (unsigned long long)((i * 2654435761ull) | 1ull);
    atomicAdd(slot, s);
}
__global__ void dbg_cmp(float* out, size_t n, const unsigned long long* slots) {
    float f = 1.0f;
    if (slots[0] != slots[2]) f = 1.5f; else if (slots[1] != slots[3]) f = 1.2f;
    if (f != 1.0f) for (size_t i = blockIdx.x * (size_t)blockDim.x + threadIdx.x; i < n; i += (size_t)gridDim.x * blockDim.x) out[i] *= f;
}
#endif
extern "C" void kernel_launch(void* const* d_in, const int* in_sizes, int n_in, void* d_out, int out_size, void* d_ws, size_t ws_size, hipStream_t stream) {
    static int grid = 0;
    if (grid == 0) {
        if (n_in != 31 || out_size != NTOK * DM || ws_size < WS_END) { fprintf(stderr, "kernel_launch: unexpected shapes (n_in %d, out %d, ws %zu)\n", n_in, out_size, ws_size); grid = -1; return; }
        int dev = 0, cus = 0, per_cu = 0;
        if (hipGetDevice(&dev) != hipSuccess || hipDeviceGetAttribute(&cus, hipDeviceAttributeMultiprocessorCount, dev) != hipSuccess) { grid = -1; return; }
        if (hipFuncSetAttribute((const void*)hybrid_fwd, hipFuncAttributeMaxDynamicSharedMemorySize, LDS_BYTES) != hipSuccess) { fprintf(stderr, "kernel_launch: hipFuncSetAttribute failed\n"); grid = -1; return; }
        if (hipOccupancyMaxActiveBlocksPerMultiprocessor(&per_cu, (const void*)hybrid_fwd, NWAVES * 64, LDS_BYTES) != hipSuccess || per_cu < 1) { fprintf(stderr, "kernel_launch: occupancy query says %d blocks per CU\n", per_cu); (void)hipGetLastError(); per_cu = 1; }
        grid = cus;
        if (grid != 256) fprintf(stderr, "kernel_launch: %d CUs; the fused softmax epilogue assumes 256\n", grid);
    }
    if (grid < 0) return;
    (void)hipMemsetAsync((char*)d_ws + WS_CTL, 0, CTL_ZERO_BYTES, stream);
    Args a{};
    for (int i = 0; i < 31; ++i) a.in[i] = (const float*)d_in[i];
    a.out = (float*)d_out; a.ws = (unsigned char*)d_ws;
#if MK_N_LAUNCHES == 99
    unsigned long long* slots = (unsigned long long*)((char*)d_ws + 223 * MiB);
    (void)hipMemsetAsync(slots, 0, 64, stream);
    for (int rep = 0; rep < 2; ++rep) {
        for (int half = 0; half < 2; ++half) {
            (void)hipMemsetAsync((char*)d_ws + WS_CTL, 0, CTL_ZERO_BYTES, stream);
            a.ph_lo = half ? 10 : 0; a.ph_hi = half ? 15 : 10;
            hipLaunchKernelGGL(hybrid_fwd, dim3(grid), dim3(NWAVES * 64), LDS_BYTES, stream, a);
            hipLaunchKernelGGL(dbg_chk, dim3(1024), dim3(256), 0, stream, (const unsigned*)d_out, (size_t)NTOK * DM, slots + rep * 2 + half);
        }
    }
    hipLaunchKernelGGL(dbg_cmp, dim3(1024), dim3(256), 0, stream, (float*)d_out, (size_t)NTOK * DM, (const unsigned long long*)slots);
#elif MK_N_LAUNCHES == 1
    a.ph_lo = 0; a.ph_hi = N_PHASES;
    void* kargs[] = {&a};
    hipError_t e = hipLaunchCooperativeKernel((const void*)hybrid_fwd, dim3(grid), dim3(NWAVES * 64), kargs, LDS_BYTES, stream);
    if (e != hipSuccess) fprintf(stderr, "cooperative launch failed: %s (grid %d)\n", hipGetErrorString(e), grid);
#else
    for (int p = 0; p < 15; ++p) {
        a.ph_lo = p; a.ph_hi = p + 1;
        hipLaunchKernelGGL(hybrid_fwd, dim3(grid), dim3(NWAVES * 64), LDS_BYTES, stream, a);
    }
#endif
}
```

```cpp
#include <hip/hip_runtime.h>
#include <hip/hip_cooperative_groups.h>
#include <cstdio>
#include <cstdint>
namespace cg = cooperative_groups;
namespace pg8 {
#define PG8_LAS __attribute__((address_space(3)))
typedef unsigned short bf16_t;
typedef short bf16x8 __attribute__((ext_vector_type(8)));
typedef float f32x4 __attribute__((ext_vector_type(4)));
typedef unsigned u32x4 __attribute__((ext_vector_type(4)));
constexpr int BM = 256, BK = 64, HALF = 128, HTB = HALF * BK * 2  , STAGE_BYTES = 8 * HTB, NXCD = 8, WGM = 8;

__host__ __device__ __forceinline__ int lds_byte(int r, int c) { const int st = (r >> 4) * 2 + (c >> 5), rr = r & 15, cc = c & 31, ob = rr * 64 + cc * 2; return st * 1024 + (ob ^ (((ob >> 9) & 1) << 5)); }
__host__ __device__ __forceinline__ void stage_rc(int b, int& R, int& C) { const int st = b / 1024, sb = b % 1024, swz = sb ^ (((sb >> 9) & 1) << 5); R = (st >> 1) * 16 + swz / 64; C = (st & 1) * 32 + (swz % 64) / 2; }
__host__ __device__ __forceinline__ int perm32(int rho) { const int n = rho >> 4, i = rho & 15; return 8 * (i >> 2) + 4 * n + (i & 3); }

struct Unit { int pm, pn; };
struct Gemm { const bf16_t* A; const bf16_t* Bt; int M, N, K; const int* gtab = nullptr; };

struct StaticOrder {
    int nM, nN, nwg, G, c;
    __host__ __device__ void init(int M, int N, int G_, int c_) { nM = M / BM; nN = N / BM; nwg = nM * nN; G = G_; c = c_; }
    __host__ __device__ bool next(int i, Unit& u) const {
        const long L = (long)i * G + c; if (L >= nwg) return false;
        int wgid = (int)L; { const int q = nwg / NXCD, r = nwg % NXCD, xcd = wgid % NXCD, off = wgid / NXCD; wgid = (xcd < r ? xcd * (q + 1) : r * (q + 1) + (xcd - r) * q) + off; }
        const int nig = WGM * nN, gid = wgid / nig, fm = gid * WGM, gsz = (nM - fm) < WGM ? (nM - fm) : WGM;
        u.pm = fm + ((wgid % nig) % gsz); u.pn = (wgid % nig) / gsz; return true;
    }
    __device__ __forceinline__ void a_ready(const Unit&) const {}
    __device__ __forceinline__ void done(const Unit&) const {}
};

__device__ __forceinline__ unsigned cvt_pk_bf16(float lo, float hi) { unsigned r; asm volatile("v_cvt_pk_bf16_f32 %0, %1, %2" : "=v"(r) : "v"(lo), "v"(hi)); return r; }
typedef float f32x2 __attribute__((ext_vector_type(2)));
__device__ __forceinline__ f32x2 gelu_pk(f32x2 v) {
    const f32x2 av = __builtin_elementwise_abs(v), d = av * 0.2316418882f + 1.0f;
    f32x2 t; t.x = __builtin_amdgcn_rcpf(d.x); t.y = __builtin_amdgcn_rcpf(d.y);
    f32x2 q = t * 0.5307027145f + (-0.7265760135f); q = q * t + 0.7107068705f; q = q * t + (-0.142248368f); q = q * t + 0.127414796f; q = q * t;
    const f32x2 s = (v * v) * (-0.72134752044f);
    f32x2 e; e.x = __builtin_amdgcn_exp2f(s.x); e.y = __builtin_amdgcn_exp2f(s.y);
    const f32x2 m = v * (q * e), r = v - m;
    f32x2 o; o.x = v.x < 0.f ? m.x : r.x; o.y = v.y < 0.f ? m.y : r.y; return o;
}

template <int ACT  > struct EpiBf16 {
    static constexpr bool PERM = true, AFTER_DRAIN = false; static_assert(ACT == 0 || ACT == 1, "EpiBf16: ACT is 0 (none) or 1 (gelu_pk)");
    bf16_t* O; int ldc; const float* bias; int split_cols; size_t split_stride; float scale0;
    __device__ __forceinline__ void operator()(const f32x4 (&acc)[2][2][4][2], const Unit& u, int wr, int wc, int fr, int fq) const {
        const int row0 = u.pm * BM + wr * 64 + fr; int colt = u.pn * BM; bf16_t* base = O;
        float sc = 1.f; if (split_cols) { const int t = colt / split_cols; base += (size_t)t * split_stride; colt -= t * split_cols; if (t == 0) sc = scale0; }
        const int col0 = colt + wc * 32 + 8 * fq, bcol0 = u.pn * BM + wc * 32 + 8 * fq;
        f32x4 bv[2][2];
#pragma unroll
        for (int bj = 0; bj < 2; ++bj)
#pragma unroll
            for (int n = 0; n < 2; ++n) bv[bj][n] = bias ? *(const f32x4*)(bias + bcol0 + bj * HALF + 4 * n) : (f32x4){0.f, 0.f, 0.f, 0.f};
#pragma unroll
        for (int ai = 0; ai < 2; ++ai)
#pragma unroll
            for (int m = 0; m < 4; ++m) { bf16_t* rowp = base + (size_t)(row0 + ai * HALF + m * 16) * ldc + col0;
#pragma unroll
                for (int bj = 0; bj < 2; ++bj) { f32x4 v0 = acc[ai][bj][m][0] + bv[bj][0], v1 = acc[ai][bj][m][1] + bv[bj][1];
                    if (ACT == 1) { f32x2 a = gelu_pk((f32x2){v0[0], v0[1]}), b = gelu_pk((f32x2){v0[2], v0[3]}), c = gelu_pk((f32x2){v1[0], v1[1]}), d = gelu_pk((f32x2){v1[2], v1[3]});
                        v0 = (f32x4){a.x, a.y, b.x, b.y}; v1 = (f32x4){c.x, c.y, d.x, d.y}; }
                    v0 = v0 * sc; v1 = v1 * sc; u32x4 w; w.x = cvt_pk_bf16(v0[0], v0[1]); w.y = cvt_pk_bf16(v0[2], v0[3]); w.z = cvt_pk_bf16(v1[0], v1[1]); w.w = cvt_pk_bf16(v1[2], v1[3]);
                    *(u32x4*)(rowp + bj * HALF) = w; } }
    }
};

struct PanelStats {
    unsigned* xbuf;
    unsigned* cnt;
    unsigned* tmo;
    int ntn; float eps;
    unsigned code;
    __device__ __forceinline__ bool run(const f32x4 (&v)[2][2][4][2], const Unit& u, int wr, int wc, int fr, int fq, PG8_LAS unsigned char* lds, int wid, int lane) const {
        typedef float f32x2v __attribute__((ext_vector_type(2)));
        PG8_LAS f32x2v* P = (PG8_LAS f32x2v*)lds;
        PG8_LAS f32x2v* S = (PG8_LAS f32x2v*)(lds + 8192);
        PG8_LAS unsigned* flag = (PG8_LAS unsigned*)(lds + 8192 + 2048);
#pragma unroll
        for (int ai = 0; ai < 2; ++ai)
#pragma unroll
            for (int m = 0; m < 4; ++m) {
                float s = 0.f;
#pragma unroll
                for (int bj = 0; bj < 2; ++bj)
#pragma unroll
                    for (int n = 0; n < 2; ++n) { const f32x4 x = v[ai][bj][m][n]; s += (x[0] + x[1]) + (x[2] + x[3]); }
                s += __shfl_xor(s, 16); s += __shfl_xor(s, 32);
                const float mw = s * (1.0f / 64.0f); float q = 0.f;
#pragma unroll
                for (int bj = 0; bj < 2; ++bj)
#pragma unroll
                    for (int n = 0; n < 2; ++n) { const f32x4 d = v[ai][bj][m][n] - mw; q += (d[0] * d[0] + d[1] * d[1]) + (d[2] * d[2] + d[3] * d[3]); }
                q += __shfl_xor(q, 16); q += __shfl_xor(q, 32);
                if (fq == 0) P[(ai * HALF + wr * 64 + m * 16 + fr) * 4 + wc] = (f32x2v){mw, q};
            }
        asm volatile("s_waitcnt lgkmcnt(0)" ::: "memory"); __builtin_amdgcn_s_barrier(); asm volatile("" ::: "memory");
#if defined(BROKEN_EXCHANGE_NO_WAIT)
#warning BROKEN CONTROL BUILD: the row-statistics exchange does not wait; results are wrong by design
        if (blockIdx.x >= 64) { const long long t0_ = clock64(); while (clock64() - t0_ < 60000) __builtin_amdgcn_s_sleep(8); }
#endif
        const int row = wid * 32 + (lane & 31);
        if (lane < 32) {
            const f32x2v a = P[row * 4 + 0], b = P[row * 4 + 1], c = P[row * 4 + 2], d = P[row * 4 + 3];
            const float mt = (a.x + b.x + c.x + d.x) * 0.25f;
            const float da = a.x - mt, db = b.x - mt, dc = c.x - mt, dd = d.x - mt;
            const float m2 = (a.y + b.y) + (c.y + d.y) + 64.0f * ((da * da + db * db) + (dc * dc + dd * dd));
            unsigned long long* slot = (unsigned long long*)xbuf + ((size_t)(u.pm * BM + row) * 4 + u.pn);
            __hip_atomic_store(slot, ((unsigned long long)__float_as_uint(m2) << 32) | __float_as_uint(mt), __ATOMIC_RELAXED, __HIP_MEMORY_SCOPE_AGENT);
        }
        asm volatile("s_waitcnt vmcnt(0)" ::: "memory");
        if (lane == 0) __hip_atomic_fetch_add(cnt + 64 * u.pm, 1u, __ATOMIC_RELAXED, __HIP_MEMORY_SCOPE_AGENT);
        if (wid == 0) {
            bool dead = false; const unsigned long long t0 = __builtin_amdgcn_s_memrealtime(); const unsigned want = 8u * (unsigned)ntn;
            for (;;) {
#if defined(BROKEN_EXCHANGE_NO_WAIT)
                break;
#endif
                if ((unsigned)__builtin_amdgcn_readfirstlane(__hip_atomic_load(cnt + 64 * u.pm, __ATOMIC_RELAXED, __HIP_MEMORY_SCOPE_AGENT)) >= want) break;
                if (__builtin_amdgcn_s_memrealtime() - t0 > 2000000ull) {
                    if (lane == 0) { unsigned expect = 0u; __hip_atomic_compare_exchange_strong(tmo + 1, &expect, code | (unsigned)(u.pm & 0xff), __ATOMIC_RELAXED, __ATOMIC_RELAXED, __HIP_MEMORY_SCOPE_AGENT);
                                     __hip_atomic_store(tmo, 1u, __ATOMIC_RELAXED, __HIP_MEMORY_SCOPE_AGENT); }
                    dead = true; break; }
                __builtin_amdgcn_s_sleep(2);
            }
            __builtin_amdgcn_fence(__ATOMIC_ACQUIRE, "agent");
            if (lane == 0) flag[0] = dead ? 1u : 0u;
        }
        asm volatile("s_waitcnt vmcnt(0) lgkmcnt(0)" ::: "memory"); __builtin_amdgcn_s_barrier(); asm volatile("" ::: "memory");
        const bool bad = flag[0] != 0u;
        if (lane < 32) {
            const unsigned long long* slot = (const unsigned long long*)xbuf + (size_t)(u.pm * BM + row) * 4; float mt[4], m2[4]; float ms = 0.f;
#pragma unroll
            for (int t = 0; t < 4; ++t) { if (t < ntn) { const unsigned long long w = __hip_atomic_load(slot + t, __ATOMIC_RELAXED, __HIP_MEMORY_SCOPE_AGENT); mt[t] = __uint_as_float((unsigned)w); m2[t] = __uint_as_float((unsigned)(w >> 32)); } else { mt[t] = 0.f; m2[t] = 0.f; } ms += mt[t]; }
            const float mean = ms / (float)ntn; float q = 0.f;
#pragma unroll
            for (int t = 0; t < 4; ++t) if (t < ntn) { const float dm = mt[t] - mean; q += m2[t] + 256.0f * dm * dm; }
            S[row] = (f32x2v){mean, 1.0f / sqrtf(q / (256.0f * (float)ntn) + eps)};
        }
        asm volatile("s_waitcnt lgkmcnt(0)" ::: "memory"); __builtin_amdgcn_s_barrier(); asm volatile("" ::: "memory");
        return bad;
    }
};
struct EpiLnRes {
    static constexpr bool PERM = false, AFTER_DRAIN = true;
    const float* base; float* out; int ldc; const float* bias; PanelStats st; unsigned poison;
    __device__ __forceinline__ void fused(f32x4 (&acc)[2][2][4][2], const Unit& u, int wr, int wc, int fr, int fq, PG8_LAS unsigned char* lds, int wid, int lane) const {
        typedef float f32x2v __attribute__((ext_vector_type(2)));
        const PG8_LAS f32x2v* S = (const PG8_LAS f32x2v*)(lds + 8192);
        const int col0 = u.pn * BM + wc * 32 + 4 * fq;
#pragma unroll
        for (int bj = 0; bj < 2; ++bj)
#pragma unroll
            for (int n = 0; n < 2; ++n) { const f32x4 bv = bias ? *(const f32x4*)(bias + col0 + bj * HALF + n * 16) : (f32x4){0.f, 0.f, 0.f, 0.f};
#pragma unroll
                for (int ai = 0; ai < 2; ++ai)
#pragma unroll
                    for (int m = 0; m < 4; ++m) acc[ai][bj][m][n] += bv; }
        f32x4 pre[4][2][2];
#pragma unroll
        for (int m = 0; m < 4; ++m) { const size_t off = (size_t)(u.pm * BM + wr * 64 + m * 16 + fr) * ldc + col0;
#pragma unroll
            for (int bj = 0; bj < 2; ++bj)
#pragma unroll
                for (int n = 0; n < 2; ++n) pre[m][bj][n] = *(const f32x4*)(base + off + bj * HALF + n * 16); }
        const bool bad = st.run(acc, u, wr, wc, fr, fq, lds, wid, lane) || poison != 0u;
        const float qnan = __builtin_nanf("");
#pragma unroll
        for (int ai = 0; ai < 2; ++ai)
#pragma unroll
            for (int m = 0; m < 4; ++m) { const int r = ai * HALF + wr * 64 + m * 16 + fr; const f32x2v sr = S[r]; const size_t off = (size_t)(u.pm * BM + r) * ldc + col0;
#pragma unroll
                for (int bj = 0; bj < 2; ++bj)
#pragma unroll
                    for (int n = 0; n < 2; ++n) { const f32x4 bs = ai == 0 ? pre[m][bj][n] : *(const f32x4*)(base + off + bj * HALF + n * 16); f32x4 o = bs + (acc[ai][bj][m][n] - sr.x) * sr.y;
                        if (bad) o = (f32x4){qnan, qnan, qnan, qnan}; *(f32x4*)(out + off + bj * HALF + n * 16) = o; }
                if (m & 1) asm volatile("" ::: "memory"); }
    }
};
struct EpiLnResLn {
    static constexpr bool PERM = false, AFTER_DRAIN = true;
    const float* base; float* out; bf16_t* xn; int ldc; const float* bias; PanelStats st1, st2; unsigned poison;
    __device__ __forceinline__ void fused(f32x4 (&acc)[2][2][4][2], const Unit& u, int wr, int wc, int fr, int fq, PG8_LAS unsigned char* lds, int wid, int lane) const {
        typedef float f32x2v __attribute__((ext_vector_type(2))); typedef unsigned u32x2v __attribute__((ext_vector_type(2)));
        const PG8_LAS f32x2v* S = (const PG8_LAS f32x2v*)(lds + 8192);
        const int col0 = u.pn * BM + wc * 32 + 4 * fq;
#pragma unroll
        for (int bj = 0; bj < 2; ++bj)
#pragma unroll
            for (int n = 0; n < 2; ++n) { const f32x4 bv = bias ? *(const f32x4*)(bias + col0 + bj * HALF + n * 16) : (f32x4){0.f, 0.f, 0.f, 0.f};
#pragma unroll
                for (int ai = 0; ai < 2; ++ai)
#pragma unroll
                    for (int m = 0; m < 4; ++m) acc[ai][bj][m][n] += bv; }
        bool bad = st1.run(acc, u, wr, wc, fr, fq, lds, wid, lane) || poison != 0u;
        const float qnan = __builtin_nanf("");
#pragma unroll
        for (int ai = 0; ai < 2; ++ai)
#pragma unroll
            for (int m = 0; m < 4; ++m) { const int r = ai * HALF + wr * 64 + m * 16 + fr; const f32x2v sr = S[r]; const size_t off = (size_t)(u.pm * BM + r) * ldc + col0;
#pragma unroll
                for (int bj = 0; bj < 2; ++bj)
#pragma unroll
                    for (int n = 0; n < 2; ++n) { const f32x4 bs = *(const f32x4*)(base + off + bj * HALF + n * 16); acc[ai][bj][m][n] = bs + (acc[ai][bj][m][n] - sr.x) * sr.y; }
                asm volatile("" : "+v"(acc[ai][0][m][0]), "+v"(acc[ai][0][m][1]), "+v"(acc[ai][1][m][0]), "+v"(acc[ai][1][m][1]));
                if (m & 1) asm volatile("" ::: "memory"); }
        const bool bad1 = bad;
        bad = st2.run(acc, u, wr, wc, fr, fq, lds, wid, lane) || bad;
#pragma unroll
        for (int ai = 0; ai < 2; ++ai)
#pragma unroll
            for (int m = 0; m < 4; ++m) { const int r = ai * HALF + wr * 64 + m * 16 + fr; const f32x2v sr = S[r]; const size_t off = (size_t)(u.pm * BM + r) * ldc + col0;
#pragma unroll
                for (int bj = 0; bj < 2; ++bj)
#pragma unroll
                    for (int n = 0; n < 2; ++n) { const f32x4 x1 = acc[ai][bj][m][n]; *(f32x4*)(out + off + bj * HALF + n * 16) = bad1 ? (f32x4){qnan, qnan, qnan, qnan} : x1;
                        const f32x4 o = (x1 - sr.x) * sr.y; u32x2v w; w.x = cvt_pk_bf16(o[0], o[1]); w.y = cvt_pk_bf16(o[2], o[3]);
                        if (bad) { w.x = 0x7fc07fc0u; w.y = 0x7fc07fc0u; } *(u32x2v*)(xn + off + bj * HALF + n * 16) = w; }
                asm volatile("" ::: "memory"); }
    }
};

template <class Epi, class Sched, bool ALIGN_EPI = false, bool SP2 = false, bool GATHER = false>
__device__ __forceinline__ void gemm_phase(PG8_LAS unsigned char* lds, const Gemm g, const Sched& S, const Epi& E) {
    int tid_ = threadIdx.x; asm volatile("" : "+v"(tid_));
    const int tid = tid_, wid = __builtin_amdgcn_readfirstlane(tid >> 6), lane = tid & 63, wr = wid >> 2, wc = wid & 3, fr = lane & 15, fq = lane >> 4;
    const int K = g.K, nt = K / BK;
    unsigned voffA[2], voffB[2];
#pragma unroll
    for (int i = 0; i < 2; ++i) { int R, C; stage_rc(tid * 16 + i * 8192, R, C); const int Rb = Epi::PERM ? ((R & ~31) + perm32(R & 31)) : R;
        voffA[i] = (unsigned)(R * K + C) * 2u; voffB[i] = (unsigned)(Rb * K + C) * 2u; }
    const size_t kstep = (size_t)(BK * 2);
    const size_t hstep = (size_t)HALF * K * 2;
    const size_t tstep = 2 * hstep;
    const unsigned ldsw = (unsigned)wid * 1024u;
    const int aoff = lds_byte(wr * 64 + fr, fq * 8), boff = lds_byte(wc * 32 + fr, fq * 8);
#define PG8_SA(b, h) (((b) * 2 + (h)) * HTB)
#define PG8_SB(b, h) ((4 + (b) * 2 + (h)) * HTB)
#define PG8_STAGE(bufoff, gbase, voff) do { _Pragma("unroll") for (int _i = 0; _i < 2; ++_i) \
        __builtin_amdgcn_global_load_lds((const unsigned*)((const char*)(gbase) + (voff)[_i]), (PG8_LAS unsigned*)(lds + (bufoff) + ldsw + _i * 8192), 16, 0, 0); } while (0)
#define PG8_STA(bufoff, ptr, h, SET) do { if constexpr (GATHER) { PG8_STAGE(bufoff, ptr, (SET)[h]); } else { PG8_STAGE(bufoff, (ptr) + (h) * hstep, voffA); } } while (0)
#define PG8_LDA(dst, b, h) do { _Pragma("unroll") for (int m = 0; m < 4; ++m) _Pragma("unroll") for (int k = 0; k < 2; ++k) dst[m][k] = *(const PG8_LAS bf16x8*)(lds + PG8_SA(b, h) + aoff + m * 2048 + k * 1024); } while (0)
#define PG8_LDB(dst, b, h) do { _Pragma("unroll") for (int n = 0; n < 2; ++n) _Pragma("unroll") for (int k = 0; k < 2; ++k) dst[n][k] = *(const PG8_LAS bf16x8*)(lds + PG8_SB(b, h) + boff + n * 2048 + k * 1024); } while (0)
#define PG8_MMA(ai, bj, At, Bt) do { __builtin_amdgcn_s_setprio(1); _Pragma("unroll") for (int m = 0; m < 4; ++m) _Pragma("unroll") for (int n = 0; n < 2; ++n) _Pragma("unroll") for (int k = 0; k < 2; ++k) \
        acc[ai][bj][m][n] = __builtin_amdgcn_mfma_f32_16x16x32_bf16(Bt[n][k], At[m][k], acc[ai][bj][m][n], 0, 0, 0); __builtin_amdgcn_s_setprio(0); } while (0)
#define PG8_WAIT_V(n) asm volatile("s_waitcnt vmcnt(" #n ")" ::: "memory")
#define PG8_WAIT_L(n) asm volatile("s_waitcnt lgkmcnt(" #n ")" ::: "memory")
#define PG8_BAR __builtin_amdgcn_s_barrier()
#define PG8_SCHED __builtin_amdgcn_sched_barrier(0)
    Unit cur, nxt; int ui = 0;
    if (!S.next(0, cur)) return;
    static_assert(SP2 || !GATHER, "GATHER is implemented in the SP2 loop only");
    unsigned gcur[2][2] = {{0u, 0u}, {0u, 0u}}, gnxt[2][2] = {{0u, 0u}, {0u, 0u}}; int gR[2], gC[2];
    if constexpr (GATHER) {
#pragma unroll
        for (int i = 0; i < 2; ++i) stage_rc(tid * 16 + i * 8192, gR[i], gC[i]);
#pragma unroll
        for (int h = 0; h < 2; ++h)
#pragma unroll
            for (int i = 0; i < 2; ++i) gcur[h][i] = (unsigned)(g.gtab[cur.pm * BM + h * HALF + gR[i]] * K + gC[i]) * 2u;
    }
    f32x4 acc[2][2][4][2];
#pragma unroll
    for (int a = 0; a < 2; ++a)
#pragma unroll
        for (int b = 0; b < 2; ++b)
#pragma unroll
            for (int m = 0; m < 4; ++m)
#pragma unroll
                for (int n = 0; n < 2; ++n) acc[a][b][m][n] = (f32x4){0.f, 0.f, 0.f, 0.f};
    bf16x8 At[4][2], B0[2][2], B1[2][2];
    const char* cA = (const char*)g.A + (GATHER ? (size_t)0 : (size_t)cur.pm * tstep); const char* cB = (const char*)g.Bt + (size_t)cur.pn * tstep;
    S.a_ready(cur);
    if constexpr (SP2) {
        PG8_STAGE(PG8_SB(0, 0), cB, voffB); PG8_STAGE(PG8_SB(0, 1), cB + hstep, voffB); PG8_STA(PG8_SA(0, 0), cA, 0, gcur); PG8_STA(PG8_SA(0, 1), cA, 1, gcur);
        if (wr == 1) PG8_BAR;
        PG8_WAIT_V(2); PG8_BAR;
        PG8_STAGE(PG8_SB(1, 0), cB + kstep, voffB); PG8_STA(PG8_SA(1, 0), cA + kstep, 0, gcur); PG8_STAGE(PG8_SB(1, 1), cB + hstep + kstep, voffB);
        PG8_WAIT_V(6); PG8_BAR;
    } else {
        PG8_STAGE(PG8_SB(0, 0), cB, voffB); PG8_STAGE(PG8_SA(0, 0), cA, voffA); PG8_STAGE(PG8_SB(0, 1), cB + hstep, voffB); PG8_STAGE(PG8_SA(0, 1), cA + hstep, voffA);
        if (wr == 1) PG8_BAR;
        PG8_WAIT_V(4); PG8_BAR;
        PG8_STAGE(PG8_SB(1, 0), cB + kstep, voffB); PG8_STAGE(PG8_SA(1, 0), cA + kstep, voffA); PG8_STAGE(PG8_SB(1, 1), cB + hstep + kstep, voffB);
        PG8_WAIT_V(6); PG8_BAR;
    }
    for (;;) {
        const bool has_next = S.next(ui + 1, nxt);
        const char* nA = GATHER ? (const char*)g.A : (has_next ? (const char*)g.A + (size_t)nxt.pm * tstep : cA); const char* nB = has_next ? (const char*)g.Bt + (size_t)nxt.pn * tstep : cB;
        if constexpr (GATHER) {
#pragma unroll
            for (int h = 0; h < 2; ++h)
#pragma unroll
                for (int i = 0; i < 2; ++i) gnxt[h][i] = has_next ? (unsigned)(g.gtab[nxt.pm * BM + h * HALF + gR[i]] * K + gC[i]) * 2u : gcur[h][i];
        }
#pragma unroll 1
        for (int t = 0; t < nt; t += 2) {
            const bool last = (t == nt - 2);
            const char* a1 = cA + (size_t)(t + 1) * kstep;
            const char* a2 = last ? nA : cA + (size_t)(t + 2) * kstep; const char* b2 = last ? nB : cB + (size_t)(t + 2) * kstep;
            const char* a3 = a2 + kstep; const char* b3 = b2 + kstep;
            if (last && has_next) S.a_ready(nxt);
            unsigned g2[2][2];
#pragma unroll
            for (int h = 0; h < 2; ++h)
#pragma unroll
                for (int i = 0; i < 2; ++i) g2[h][i] = last ? gnxt[h][i] : gcur[h][i];
            if constexpr (SP2) {
            PG8_LDB(B0, 0, 0); PG8_LDB(B1, 0, 1); PG8_SCHED; PG8_LDA(At, 0, 0); PG8_STA(PG8_SA(1, 1), a1, 1, gcur);
            PG8_WAIT_V(8); PG8_WAIT_L(0); PG8_BAR; PG8_MMA(0, 0, At, B0); PG8_MMA(0, 1, At, B1); PG8_BAR; PG8_SCHED;
            PG8_LDA(At, 0, 1); PG8_STAGE(PG8_SB(0, 0), b2, voffB); PG8_STAGE(PG8_SB(0, 1), b2 + hstep, voffB); PG8_STA(PG8_SA(0, 0), a2, 0, g2);
            PG8_WAIT_V(8); PG8_WAIT_L(0); PG8_BAR; PG8_MMA(1, 0, At, B0); PG8_MMA(1, 1, At, B1); PG8_BAR; PG8_SCHED;
            PG8_LDB(B0, 1, 0); PG8_LDB(B1, 1, 1); PG8_SCHED; PG8_LDA(At, 1, 0); PG8_STA(PG8_SA(0, 1), a2, 1, g2);
            PG8_WAIT_V(8); PG8_WAIT_L(0); PG8_BAR; PG8_MMA(0, 0, At, B0); PG8_MMA(0, 1, At, B1); PG8_BAR; PG8_SCHED;
            PG8_LDA(At, 1, 1); PG8_STAGE(PG8_SB(1, 0), b3, voffB); PG8_STAGE(PG8_SB(1, 1), b3 + hstep, voffB); PG8_STA(PG8_SA(1, 0), a3, 0, g2);
            PG8_WAIT_V(8); PG8_WAIT_L(0); PG8_BAR; PG8_MMA(1, 0, At, B0); PG8_MMA(1, 1, At, B1); PG8_BAR; PG8_SCHED;
            } else {
            PG8_LDB(B0, 0, 0); PG8_SCHED; PG8_LDA(At, 0, 0); PG8_STAGE(PG8_SA(1, 1), a1 + hstep, voffA);
            PG8_WAIT_L(8); PG8_BAR; PG8_WAIT_L(0); PG8_MMA(0, 0, At, B0); PG8_BAR; PG8_SCHED;
            PG8_LDB(B1, 0, 1); PG8_STAGE(PG8_SB(0, 0), b2, voffB);
            PG8_BAR; PG8_WAIT_L(0); PG8_MMA(0, 1, At, B1); PG8_BAR;
            PG8_LDA(At, 0, 1); PG8_STAGE(PG8_SA(0, 0), a2, voffA);
            PG8_BAR; PG8_WAIT_L(0); PG8_MMA(1, 0, At, B0); PG8_BAR; PG8_SCHED;
            PG8_STAGE(PG8_SB(0, 1), b2 + hstep, voffB);
            PG8_WAIT_V(6); PG8_BAR; PG8_MMA(1, 1, At, B1); PG8_BAR;
            PG8_LDB(B0, 1, 0); PG8_SCHED; PG8_LDA(At, 1, 0); PG8_STAGE(PG8_SA(0, 1), a2 + hstep, voffA);
            PG8_WAIT_L(8); PG8_BAR; PG8_WAIT_L(0); PG8_MMA(0, 0, At, B0); PG8_BAR; PG8_SCHED;
            PG8_LDB(B1, 1, 1); PG8_STAGE(PG8_SB(1, 0), b3, voffB);
            PG8_BAR; PG8_WAIT_L(0); PG8_MMA(0, 1, At, B1); PG8_BAR;
            PG8_LDA(At, 1, 1); PG8_STAGE(PG8_SA(1, 0), a3, voffA);
            PG8_BAR; PG8_WAIT_L(0); PG8_MMA(1, 0, At, B0); PG8_BAR; PG8_SCHED;
            PG8_STAGE(PG8_SB(1, 1), b3 + hstep, voffB);
            PG8_WAIT_V(6); PG8_BAR; PG8_MMA(1, 1, At, B1); PG8_BAR;
            }
        }
        if constexpr (ALIGN_EPI) { if (wr == 0) PG8_BAR; }
        if constexpr (!Epi::AFTER_DRAIN) { E(acc, cur, wr, wc, fr, fq); S.done(cur); }
        if (!has_next) break;
#pragma unroll
        for (int a = 0; a < 2; ++a)
#pragma unroll
            for (int b = 0; b < 2; ++b)
#pragma unroll
                for (int m = 0; m < 4; ++m)
#pragma unroll
                    for (int n = 0; n < 2; ++n) acc[a][b][m][n] = (f32x4){0.f, 0.f, 0.f, 0.f};
        cur = nxt; cA = nA; cB = nB; ++ui;
        if constexpr (GATHER) {
#pragma unroll
            for (int h = 0; h < 2; ++h)
#pragma unroll
                for (int i = 0; i < 2; ++i) gcur[h][i] = gnxt[h][i];
        }
        if constexpr (ALIGN_EPI) { if (wr == 1) PG8_BAR; }
    }
    PG8_WAIT_V(0);
    if constexpr (!ALIGN_EPI) { if (wr == 0) PG8_BAR; }
    PG8_BAR;
    if constexpr (Epi::AFTER_DRAIN) { E.fused(acc, cur, wr, wc, fr, fq, lds, wid, lane); S.done(cur); }
#undef PG8_SA
#undef PG8_SB
#undef PG8_STAGE
#undef PG8_STA
#undef PG8_LDA
#undef PG8_LDB
#undef PG8_MMA
#undef PG8_WAIT_V
#undef PG8_WAIT_L
#undef PG8_BAR
#undef PG8_SCHED
}
}
namespace pg8 {
struct TileDst { bf16_t* base; int ldc; float scale; const float* bias; };

template <class Map> struct EpiBf16Map {
    static constexpr bool PERM = true, AFTER_DRAIN = false;
    Map map;
    __device__ __forceinline__ void operator()(const f32x4 (&acc)[2][2][4][2], const Unit& u, int wr, int wc, int fr, int fq) const {
        const TileDst d = map(u);
        const int row0 = wr * 64 + fr, col0 = wc * 32 + 8 * fq;
        f32x4 bv[2][2];
#pragma unroll
        for (int bj = 0; bj < 2; ++bj)
#pragma unroll
            for (int n = 0; n < 2; ++n) bv[bj][n] = d.bias ? *(const f32x4*)(d.bias + col0 + bj * HALF + 4 * n) : (f32x4){0.f, 0.f, 0.f, 0.f};
#pragma unroll
        for (int ai = 0; ai < 2; ++ai)
#pragma unroll
            for (int m = 0; m < 4; ++m) { bf16_t* rowp = d.base + (size_t)(row0 + ai * HALF + m * 16) * d.ldc + col0;
#pragma unroll
                for (int bj = 0; bj < 2; ++bj) { f32x4 v0 = (acc[ai][bj][m][0] + bv[bj][0]) * d.scale, v1 = (acc[ai][bj][m][1] + bv[bj][1]) * d.scale;
                    u32x4 w; w.x = cvt_pk_bf16(v0[0], v0[1]); w.y = cvt_pk_bf16(v0[2], v0[3]); w.z = cvt_pk_bf16(v1[0], v1[1]); w.w = cvt_pk_bf16(v1[2], v1[3]);
                    *(u32x4*)(rowp + bj * HALF) = w; } }
    }
};

struct EpiSwiglu {
    static constexpr bool PERM = true, AFTER_DRAIN = false;
    bf16_t* H; const float* bg; const float* bu;
    __device__ __forceinline__ void operator()(const f32x4 (&acc)[2][2][4][2], const Unit& u, int wr, int wc, int fr, int fq) const {
        const int e = u.pn >> 3, pnl = u.pn & 7;
        const int row0 = u.pm * BM + wr * 64 + fr, col0 = pnl * 128 + wc * 32 + 8 * fq;
        f32x4 g0 = *(const f32x4*)(bg + e * 1024 + col0), g1 = *(const f32x4*)(bg + e * 1024 + col0 + 4);
        f32x4 u0 = *(const f32x4*)(bu + e * 1024 + col0), u1 = *(const f32x4*)(bu + e * 1024 + col0 + 4);
#pragma unroll
        for (int ai = 0; ai < 2; ++ai)
#pragma unroll
            for (int m = 0; m < 4; ++m) {
                float r[8];
#pragma unroll
                for (int n = 0; n < 2; ++n)
#pragma unroll
                    for (int j = 0; j < 4; ++j) {
                        float hg = acc[ai][0][m][n][j] + (n ? g1[j] : g0[j]);
                        float hl = acc[ai][1][m][n][j] + (n ? u1[j] : u0[j]);
                        hg = fminf(hg, 7.0f); hl = fminf(fmaxf(hl, -7.0f), 7.0f);
                        const float sg = __builtin_amdgcn_rcpf(1.0f + __expf(-1.702f * hg));
                        r[n * 4 + j] = hg * sg * (hl + 1.0f);
                    }
                u32x4 w; w.x = cvt_pk_bf16(r[0], r[1]); w.y = cvt_pk_bf16(r[2], r[3]); w.z = cvt_pk_bf16(r[4], r[5]); w.w = cvt_pk_bf16(r[6], r[7]);
                *(u32x4*)(H + (size_t)(row0 + ai * HALF + m * 16) * 1024 + col0) = w;
            }
    }
};

struct EpiF32Res {
    static constexpr bool PERM = false, AFTER_DRAIN = false;
    const float* base; float* out; float alpha;
    __device__ __forceinline__ void operator()(const f32x4 (&acc)[2][2][4][2], const Unit& u, int wr, int wc, int fr, int fq) const {
        const int col0 = (u.pn & 3) * BM + wc * 32 + 4 * fq;
#pragma unroll
        for (int ai = 0; ai < 2; ++ai)
#pragma unroll
            for (int m = 0; m < 4; ++m) { const size_t off = (size_t)(u.pm * BM + ai * HALF + wr * 64 + m * 16 + fr) * 1024 + col0;
#pragma unroll
                for (int bj = 0; bj < 2; ++bj)
#pragma unroll
                    for (int n = 0; n < 2; ++n) { const f32x4 bs = *(const f32x4*)(base + off + bj * HALF + n * 16);
                        *(f32x4*)(out + off + bj * HALF + n * 16) = bs * alpha + acc[ai][bj][m][n]; } }
    }
};

struct EpiResBf16 {
    static constexpr bool PERM = false, AFTER_DRAIN = false;
    const float* base; bf16_t* out; float alpha;
    __device__ __forceinline__ void operator()(const f32x4 (&acc)[2][2][4][2], const Unit& u, int wr, int wc, int fr, int fq) const {
        typedef unsigned u32x2v __attribute__((ext_vector_type(2)));
        const int col0 = (u.pn & 3) * BM + wc * 32 + 4 * fq;
#pragma unroll
        for (int ai = 0; ai < 2; ++ai)
#pragma unroll
            for (int m = 0; m < 4; ++m) { const size_t off = (size_t)(u.pm * BM + ai * HALF + wr * 64 + m * 16 + fr) * 1024 + col0;
#pragma unroll
                for (int bj = 0; bj < 2; ++bj)
#pragma unroll
                    for (int n = 0; n < 2; ++n) { const f32x4 bs = *(const f32x4*)(base + off + bj * HALF + n * 16); const f32x4 v = bs * alpha + acc[ai][bj][m][n];
                        u32x2v w; w.x = cvt_pk_bf16(v[0], v[1]); w.y = cvt_pk_bf16(v[2], v[3]); *(u32x2v*)(out + off + bj * HALF + n * 16) = w; } }
    }
};

struct EpiResBf16B {
    static constexpr bool PERM = false, AFTER_DRAIN = false;
    const bf16_t* base; bf16_t* out; float alpha;
    __device__ __forceinline__ void operator()(const f32x4 (&acc)[2][2][4][2], const Unit& u, int wr, int wc, int fr, int fq) const {
        typedef unsigned u32x2v __attribute__((ext_vector_type(2)));
        const int col0 = (u.pn & 3) * BM + wc * 32 + 4 * fq;
#pragma unroll
        for (int ai = 0; ai < 2; ++ai)
#pragma unroll
            for (int m = 0; m < 4; ++m) { const size_t off = (size_t)(u.pm * BM + ai * HALF + wr * 64 + m * 16 + fr) * 1024 + col0;
#pragma unroll
                for (int bj = 0; bj < 2; ++bj)
#pragma unroll
                    for (int n = 0; n < 2; ++n) { const u32x2v w = *(const u32x2v*)(base + off + bj * HALF + n * 16);
                        const f32x4 bs = {__builtin_bit_cast(float, w.x << 16), __builtin_bit_cast(float, w.x & 0xffff0000u), __builtin_bit_cast(float, w.y << 16), __builtin_bit_cast(float, w.y & 0xffff0000u)};
                        const f32x4 v = bs * alpha + acc[ai][bj][m][n];
                        u32x2v o; o.x = cvt_pk_bf16(v[0], v[1]); o.y = cvt_pk_bf16(v[2], v[3]); *(u32x2v*)(out + off + bj * HALF + n * 16) = o; } }
    }
};

struct EpiF32ResB {
    static constexpr bool PERM = false, AFTER_DRAIN = false;
    const bf16_t* base; float* out; float alpha;
    __device__ __forceinline__ void operator()(const f32x4 (&acc)[2][2][4][2], const Unit& u, int wr, int wc, int fr, int fq) const {
        typedef unsigned u32x2v __attribute__((ext_vector_type(2)));
        const int col0 = (u.pn & 3) * BM + wc * 32 + 4 * fq;
#pragma unroll
        for (int ai = 0; ai < 2; ++ai)
#pragma unroll
            for (int m = 0; m < 4; ++m) { const size_t off = (size_t)(u.pm * BM + ai * HALF + wr * 64 + m * 16 + fr) * 1024 + col0;
#pragma unroll
                for (int bj = 0; bj < 2; ++bj)
#pragma unroll
                    for (int n = 0; n < 2; ++n) { const u32x2v w = *(const u32x2v*)(base + off + bj * HALF + n * 16);
                        const f32x4 bs = {__builtin_bit_cast(float, w.x << 16), __builtin_bit_cast(float, w.x & 0xffff0000u), __builtin_bit_cast(float, w.y << 16), __builtin_bit_cast(float, w.y & 0xffff0000u)};
                        *(f32x4*)(out + off + bj * HALF + n * 16) = bs * alpha + acc[ai][bj][m][n]; } }
    }
};

struct EpiSoftmax {
    static constexpr bool PERM = true, AFTER_DRAIN = true;
    bf16_t* P;
    __device__ __forceinline__ void fused(f32x4 (&acc)[2][2][4][2], const Unit& u, int wr, int wc, int fr, int fq, PG8_LAS unsigned char* lds, int wid, int lane) const {
        PG8_LAS float* X = (PG8_LAS float*)lds;
        PG8_LAS float* Y = (PG8_LAS float*)(lds + 4096);
#pragma unroll
        for (int ai = 0; ai < 2; ++ai)
#pragma unroll
            for (int m = 0; m < 4; ++m) {
                float mx = -INFINITY;
#pragma unroll
                for (int bj = 0; bj < 2; ++bj)
#pragma unroll
                    for (int n = 0; n < 2; ++n) { const f32x4 x = acc[ai][bj][m][n]; mx = fmaxf(mx, fmaxf(fmaxf(x[0], x[1]), fmaxf(x[2], x[3]))); }
                mx = fmaxf(mx, __shfl_xor(mx, 16)); mx = fmaxf(mx, __shfl_xor(mx, 32));
                if (fq == 0) X[(ai * HALF + wr * 64 + m * 16 + fr) * 4 + wc] = mx;
            }
        asm volatile("s_waitcnt lgkmcnt(0)" ::: "memory"); __builtin_amdgcn_s_barrier(); asm volatile("" ::: "memory");
#pragma unroll
        for (int ai = 0; ai < 2; ++ai)
#pragma unroll
            for (int m = 0; m < 4; ++m) {
                const int r = ai * HALF + wr * 64 + m * 16 + fr;
                const f32x4 q = *(const PG8_LAS f32x4*)(X + r * 4);
                const float mx = fmaxf(fmaxf(q[0], q[1]), fmaxf(q[2], q[3]));
                float s = 0.f;
#pragma unroll
                for (int bj = 0; bj < 2; ++bj)
#pragma unroll
                    for (int n = 0; n < 2; ++n) { f32x4 x = acc[ai][bj][m][n];
                        x[0] = __builtin_amdgcn_exp2f(x[0] - mx); x[1] = __builtin_amdgcn_exp2f(x[1] - mx); x[2] = __builtin_amdgcn_exp2f(x[2] - mx); x[3] = __builtin_amdgcn_exp2f(x[3] - mx);
                        acc[ai][bj][m][n] = x; s += (x[0] + x[1]) + (x[2] + x[3]); }
                s += __shfl_xor(s, 16); s += __shfl_xor(s, 32);
                if (fq == 0) Y[r * 4 + wc] = s;
            }
        asm volatile("s_waitcnt lgkmcnt(0)" ::: "memory"); __builtin_amdgcn_s_barrier(); asm volatile("" ::: "memory");
        const int col0 = (u.pn & 3) * BM + wc * 32 + 8 * fq;
#pragma unroll
        for (int ai = 0; ai < 2; ++ai)
#pragma unroll
            for (int m = 0; m < 4; ++m) {
                const int r = ai * HALF + wr * 64 + m * 16 + fr;
                const f32x4 q = *(const PG8_LAS f32x4*)(Y + r * 4);
                const float inv = 1.0f / ((q[0] + q[1]) + (q[2] + q[3]));
                bf16_t* rowp = P + (size_t)(u.pm * BM + r) * 1024 + col0;
#pragma unroll
                for (int bj = 0; bj < 2; ++bj) { const f32x4 v0 = acc[ai][bj][m][0] * inv, v1 = acc[ai][bj][m][1] * inv;
                    u32x4 w; w.x = cvt_pk_bf16(v0[0], v0[1]); w.y = cvt_pk_bf16(v0[2], v0[3]); w.z = cvt_pk_bf16(v1[0], v1[1]); w.w = cvt_pk_bf16(v1[2], v1[3]);
                    *(u32x4*)(rowp + bj * HALF) = w; }
            }
        asm volatile("s_waitcnt lgkmcnt(0)" ::: "memory"); __builtin_amdgcn_s_barrier(); asm volatile("" ::: "memory");
    }
};

struct BatchOrder {
    StaticOrder so;
    __device__ void init(int M, int N, int G_, int c_) { so.init(M, N, G_, c_); }
    __device__ bool next(int i, Unit& u) const { if (!so.next(i, u)) return false; u.pn += (u.pm >> 5) * 4; return true; }
    __device__ __forceinline__ void a_ready(const Unit&) const {}
    __device__ __forceinline__ void done(const Unit&) const {}
};
struct WqkOrder {
    int G, c;
    __device__ bool next(int i, Unit& u) const { const int L = i * G + c; if (L >= 32) return false; const int b = L >> 4, h = (L >> 2) & 3, kt = L & 3; u.pm = b * 4 + h; u.pn = h * 4 + kt; return true; }
    __device__ __forceinline__ void a_ready(const Unit&) const {}
    __device__ __forceinline__ void done(const Unit&) const {}
};
struct VwoOrder {
    int G, c;
    __device__ bool next(int i, Unit& u) const { const int L = i * G + c; if (L >= 32) return false; const int b = L >> 4, h = (L >> 2) & 3, nt = L & 3; u.pm = h * 4 + nt; u.pn = b * 4 + h; return true; }
    __device__ __forceinline__ void a_ready(const Unit&) const {}
    __device__ __forceinline__ void done(const Unit&) const {}
};
struct MoeOrder {
    int G, c, nN, n_mt; const PG8_LAS int* tile_e;
    __device__ bool next(int i, Unit& u) const {
        const int x = c & 7, j = c >> 3, tpx = 32 / nN  , tpr = 8 * tpx  ;
        const int full = n_mt / tpr;
        int pm, pnl;
        if (i < full) { pm = (i * 8 + x) * tpx + j / nN; pnl = j % nN; }
        else if (i == full) {
            const int rem = n_mt - full * tpr, t = j / nN;
            const int idx = t * 8 + x; if (idx >= rem) return false;
            pm = full * tpr + idx; pnl = j % nN; }
        else return false;
        if (j >= 32) return false;
        const int e = __builtin_amdgcn_readfirstlane(tile_e[pm]); u.pm = pm; u.pn = e * nN + pnl; return true; }
    __device__ __forceinline__ void a_ready(const Unit&) const {}
    __device__ __forceinline__ void done(const Unit&) const {}
};
}
#include <hip/hip_bf16.h>
#include <cmath>
namespace attn_body {
using bf16=__hip_bfloat16;
using bf16x8=__attribute__((ext_vector_type(8)))short;
using s16x4=__attribute__((ext_vector_type(4)))short;
using f32x16=__attribute__((ext_vector_type(16)))float;
using u32x4=__attribute__((ext_vector_type(4)))unsigned;
constexpr int BATCH=2,NHEAD=16,SEQ=8192,D=64,DM=NHEAD*D;
constexpr int PQKV=512;
constexpr int NW=8,QBLK=32,QB=QBLK*NW,KVBLK=64,NQB=SEQ/QB;
constexpr int ATTN_PITCH=DM, ATTN_UNIT_ROWS=QB;
__device__ __forceinline__ int crow(int r,int hi){return (r&3)+8*(r>>2)+4*hi;}
#define SBAR() __builtin_amdgcn_sched_barrier(0)
__device__ __forceinline__ void cmask(f32x16&p0,f32x16&p1,int jb,int qrel,int hi){
  const float NEG=-INFINITY; int kb=64*jb+4*hi;
  #pragma unroll
  for(int r=0;r<16;++r){int kv=kb+(r&3)+8*(r>>2); if(kv>qrel)p0[r]=NEG; if(kv+32>qrel)p1[r]=NEG;}
}

constexpr int NSLOT=3, SLOTB=8192;
constexpr int LDS_K=0, LDS_V=NSLOT*SLOTB, LDS_WS=2*NSLOT*SLOTB, LDS_OST=LDS_WS+NW*64*4, LDS_BYTES=LDS_OST+NW*4096;
constexpr float C2=0.125f*1.4426950408889634f;
__device__ __forceinline__ void glds16(const void*gsrc,unsigned lds_dst){unsigned keep;
  asm volatile("s_mov_b32 %0, m0\n\ts_mov_b32 m0, %2\n\ts_nop 0\n\tglobal_load_lds_dwordx4 %1, off\n\ts_mov_b32 m0, %0":"=&s"(keep):"v"(gsrc),"s"(lds_dst):"memory");}
__device__ __forceinline__ float max3f(float a,float b,float c){float r;asm("v_max3_f32 %0, %1, %2, %3":"=v"(r):"v"(a),"v"(b),"v"(c));return r;}
__device__ __forceinline__ float max2f(float a,float b){float r;asm("v_max_f32_e32 %0, %1, %2":"=v"(r):"v"(a),"v"(b));return r;}
__device__ __forceinline__ float fadd_s(float a,float b){float r;asm("v_add_f32_e32 %0, %1, %2":"=v"(r):"v"(a),"v"(b));return r;}
__device__ __forceinline__ float fsub_s(float a,float b){float r;asm("v_sub_f32_e32 %0, %1, %2":"=v"(r):"v"(a),"v"(b));return r;}
typedef float f32x2_t __attribute__((ext_vector_type(2))); typedef __bf16 bf16x2_t __attribute__((ext_vector_type(2)));
__device__ __forceinline__ unsigned cvtpk_s(float lo,float hi){f32x2_t v={lo,hi};bf16x2_t b=__builtin_convertvector(v,bf16x2_t);return __builtin_bit_cast(unsigned,b);}
#define WAIT_BAR(N) asm volatile("s_waitcnt vmcnt(" #N ") lgkmcnt(0)\n\ts_barrier":::"memory")

__device__ __forceinline__ void qkt(f32x16&p0,f32x16&p1,const char*Kslot,const bf16x8*qr,const f32x16&negm,int r32,int hi){
  const char*kb=Kslot+hi*1024+r32*16;
  #pragma unroll
  for(int d0=0;d0<4;++d0){
    const bf16x8 b0=*reinterpret_cast<const bf16x8*>(kb+d0*2048);
    const bf16x8 b1=*reinterpret_cast<const bf16x8*>(kb+d0*2048+512);
    if(d0==0){p0=__builtin_amdgcn_mfma_f32_32x32x16_bf16(b0,qr[0],negm,0,0,0);p1=__builtin_amdgcn_mfma_f32_32x32x16_bf16(b1,qr[0],negm,0,0,0);}
    else{p0=__builtin_amdgcn_mfma_f32_32x32x16_bf16(b0,qr[d0],p0,0,0,0);p1=__builtin_amdgcn_mfma_f32_32x32x16_bf16(b1,qr[d0],p1,0,0,0);}}
}
typedef __attribute__((address_space(3))) const char* lds_cptr;
typedef short v4i16_t __attribute__((ext_vector_type(4)));
__device__ __forceinline__ void kload8(bf16x8*kf,lds_cptr kp){
  kf[0]=*(const __attribute__((address_space(3))) bf16x8*)(kp);      kf[1]=*(const __attribute__((address_space(3))) bf16x8*)(kp+512);
  kf[2]=*(const __attribute__((address_space(3))) bf16x8*)(kp+2048); kf[3]=*(const __attribute__((address_space(3))) bf16x8*)(kp+2560);
  kf[4]=*(const __attribute__((address_space(3))) bf16x8*)(kp+4096); kf[5]=*(const __attribute__((address_space(3))) bf16x8*)(kp+4608);
  kf[6]=*(const __attribute__((address_space(3))) bf16x8*)(kp+6144); kf[7]=*(const __attribute__((address_space(3))) bf16x8*)(kp+6656);
}
__device__ __forceinline__ void kload2(bf16x8*kf,lds_cptr kp,int j){ kf[2*j]=*(const __attribute__((address_space(3))) bf16x8*)(kp+j*2048); kf[2*j+1]=*(const __attribute__((address_space(3))) bf16x8*)(kp+j*2048+512); }
__device__ __forceinline__ s16x4 vtr(lds_cptr p){ return __builtin_bit_cast(s16x4,__builtin_amdgcn_ds_read_tr16_b64_v4i16((__attribute__((address_space(3))) v4i16_t*)p)); }
__device__ __forceinline__ float rowmax(const f32x16&p0,const f32x16&p1){
  float a=max3f(p0[0],p0[1],p1[0]),b=max3f(p0[2],p0[3],p1[1]);a=max3f(a,p1[2],p1[3]);
  #pragma unroll
  for(int r=4;r<16;r+=4){a=max3f(a,p0[r],p0[r+1]);b=max3f(b,p0[r+2],p0[r+3]);a=max3f(a,p1[r],p1[r+1]);b=max3f(b,p1[r+2],p1[r+3]);}
  const float m=max2f(a,b);
  auto rr=__builtin_amdgcn_permlane32_swap(__float_as_uint(m),__float_as_uint(m),false,false);
  return max2f(__uint_as_float(rr[0]),__uint_as_float(rr[1]));
}
__device__ __forceinline__ void pv(f32x16*o,int vb,bf16x8 pa0,bf16x8 pa1,bf16x8 pa2,bf16x8 pa3){
  #pragma unroll
  for(int d0=0;d0<2;++d0){s16x4 lo[4],hi[4];
    #pragma unroll
    for(int ks=0;ks<4;++ks){
      asm volatile("ds_read_b64_tr_b16 %0,%1 offset:%c2":"=&v"(lo[ks]):"v"(vb),"i"(d0*4096+ks*1024):"memory");
      asm volatile("ds_read_b64_tr_b16 %0,%1 offset:%c2":"=&v"(hi[ks]):"v"(vb),"i"(d0*4096+ks*1024+512):"memory");}
    asm volatile("s_waitcnt lgkmcnt(0)":::"memory");SBAR();
    #define PK(k) (bf16x8){lo[k][0],lo[k][1],lo[k][2],lo[k][3],hi[k][0],hi[k][1],hi[k][2],hi[k][3]}
    o[d0]=__builtin_amdgcn_mfma_f32_32x32x16_bf16(pa0,PK(0),o[d0],0,0,0);
    o[d0]=__builtin_amdgcn_mfma_f32_32x32x16_bf16(pa1,PK(1),o[d0],0,0,0);
    o[d0]=__builtin_amdgcn_mfma_f32_32x32x16_bf16(pa2,PK(2),o[d0],0,0,0);
    o[d0]=__builtin_amdgcn_mfma_f32_32x32x16_bf16(pa3,PK(3),o[d0],0,0,0);
    #undef PK
  }
}

#ifndef ATTN_STORE16
#define ATTN_STORE16(p,v) (*(u32x4*)(p)=(v))
#endif
template<int THRL> __device__ __forceinline__ void attn_unit(int b,int h,int qb,const bf16*Q,const bf16*__restrict__ K,const bf16*__restrict__ V,bf16*O,char*shm){
  int tid_=threadIdx.x; asm volatile("":"+v"(tid_)); const int tid=tid_,lane=tid&63,r32=lane&31,hi=lane>>5; const int wid=__builtin_amdgcn_readfirstlane(tid>>6);
  const long rowbase=(long)b*SEQ; const int q0=qb*QB;
  const bf16*Qw=Q+(rowbase+q0+wid*QBLK)*PQKV+(h>>1)*D;
  const bf16*Kh=K+rowbase*PQKV+(h>>1)*D,*Vh=V+rowbase*PQKV+((h>>2)*2+(h&1))*D;
  const unsigned lds0=(unsigned)(uintptr_t)shm;
  float*wsf=(float*)(shm+LDS_WS)+wid*64;
  const bf16*ksrc=Kh+(long)lane*PQKV+wid*8;
  const bf16*vsrc=Vh+(long)(16*(wid&3)+(lane>>2))*PQKV+(wid>>2)*32+(lane&3)*8;
  const unsigned kdst=lds0+LDS_K+wid*1024, vdst=lds0+LDS_V+wid*1024;
  #define DMA_K(t,slot) glds16(ksrc+(long)(t)*KVBLK*PQKV,(unsigned)__builtin_amdgcn_readfirstlane(kdst+(slot)))
  #define DMA_V(t,slot) glds16(vsrc+(long)(t)*KVBLK*PQKV,(unsigned)__builtin_amdgcn_readfirstlane(vdst+(slot)))
  const int vb0=(int)(lds0+LDS_V)+((lane>>4)&1)*32+(lane&3)*8+(4*hi+((lane&15)>>2))*64;
  const char*Kbase=shm+LDS_K; bf16x8 kf[8];
  const lds_cptr shm3=(lds_cptr)shm; const lds_cptr kp0=shm3+LDS_K+hi*1024+r32*16; const lds_cptr vp0=shm3+LDS_V+((lane>>4)&1)*32+(lane&3)*8+(4*hi+((lane&15)>>2))*64;
  const int NT=(q0+QB)/KVBLK;
  DMA_K(0,0);DMA_V(0,0);DMA_K(1,SLOTB);
  bf16x8 qr[4];
  #pragma unroll
  for(int d0=0;d0<4;++d0)qr[d0]=*reinterpret_cast<const bf16x8*>(&Qw[(long)r32*PQKV+d0*16+hi*8]);
  float mhat=0.f,l_reg=0.f;f32x16 o[2];o[0]=f32x16{};o[1]=f32x16{};f32x16 negm=f32x16{};asm volatile("":"+v"(negm));
  const int qrel=wid*QBLK+r32;
  #define CMASK(P0,P1,t) do{int jb_=(t)-(NT-4); if(jb_>=0)cmask(P0,P1,jb_,qrel,hi);}while(0)
  bool resc=false;
  #define START(P0,P1) do{ const float rm=rowmax(P0,P1); resc=false; \
    { const float dl=rm; mhat=fadd_s(mhat,dl); \
      _Pragma("unroll") for(int r=0;r<16;++r){P0[r]=fsub_s(P0[r],dl);P1[r]=fsub_s(P1[r],dl);} \
      _Pragma("unroll") for(int r=0;r<16;++r)negm[r]=-mhat; asm volatile("":"+v"(negm)); } \
    _Pragma("unroll") for(int r=0;r<16;++r)P0[r]=__builtin_amdgcn_exp2f(P0[r]); }while(0)
  #define RESC() do{ if(resc){ asm volatile("s_waitcnt lgkmcnt(0)":::"memory"); \
      _Pragma("unroll") for(int d_=0;d_<2;++d_) _Pragma("unroll") for(int r=0;r<16;++r)o[d_][r]*=wsf[crow(r,hi)]; } }while(0)
  f32x16 pA0,pA1,pB0,pB1;
  int sl_prev=0,sl_cur=0,sl_next=SLOTB;
  #define ROT() do{sl_prev=sl_cur;sl_cur=sl_next;sl_next=(sl_next==(NSLOT-1)*SLOTB)?0:sl_next+SLOTB;}while(0)
  DMA_K(2,2*SLOTB);
  WAIT_BAR(3);
  qkt(pA0,pA1,Kbase,qr,negm,r32,hi);asm volatile("s_nop 15\n\ts_nop 7":"+v"(pA0),"+v"(pA1));CMASK(pA0,pA1,0);
  START(pA0,pA1);
  _Pragma("unroll") for(int r=0;r<16;++r)pA1[r]=__builtin_amdgcn_exp2f(pA1[r]);
  WAIT_BAR(0);
  DMA_K(3,0);DMA_V(1,SLOTB);
  ROT();
  kload8(kf,kp0+sl_cur);
  WAIT_BAR(2);
  s16x4 vlo[8],vhi[8]; u32x4 pw0,pw1,pw2,pw3;
  #define PKW(P,B) cvtpk_s(P[B],P[B+1])
  #define PAF(k) __builtin_bit_cast(bf16x8,pw##k)
  #define VFR(i) (bf16x8){vlo[i][0],vlo[i][1],vlo[i][2],vlo[i][3],vhi[i][0],vhi[i][1],vhi[i][2],vhi[i][3]}
  #define PIN(x) asm volatile("":"+v"(x))
  #define MX3(a,b,c) __builtin_fmaxf(__builtin_fmaxf((a),(b)),(c))
  #define GAPA(MF,A0,A1,A2,A3,W0,W1,PW) do{ MF; sacc+=A0; sacc+=A1; sacc+=A2; sacc+=A3; PIN(sacc); W0; W1; PIN(PW); SBAR(); }while(0)
  #define EX(v) __builtin_amdgcn_exp2f(v)
  #define GAPB(MF,X,B) do{ MF; X[B]=EX(X[B]); X[B+1]=EX(X[B+1]); X[B+2]=EX(X[B+2]); X[B+3]=EX(X[B+3]); PIN(X); SBAR(); }while(0)
  #define VRD(i) do{ vlo[i]=vtr(vp_+(((i)>>2)*4096+((i)&3)*1024)); vhi[i]=vtr(vp_+(((i)>>2)*4096+((i)&3)*1024+512)); }while(0)
  #define KRD(G,j) do{ if(G){ kload2(kf,kp0+sl_next,j); SBAR(); } }while(0)
  #define STEP(C0,C1,P0,P1,t,GK,GV,GL) do{ SBAR(); \
    const lds_cptr vp_=vp0+sl_prev; \
    VRD(0); SBAR(); float sacc=(P0[0]+P0[1]); \
    GAPA(C0=__builtin_amdgcn_mfma_f32_32x32x16_bf16(kf[0],qr[0],negm,0,0,0), P0[2],P0[3],P0[4],P0[5],     pw0[0]=PKW(P0,0), pw0[1]=PKW(P0,2), pw0); \
    VRD(4); SBAR(); GAPA(C1=__builtin_amdgcn_mfma_f32_32x32x16_bf16(kf[1],qr[0],negm,0,0,0), P0[6],P0[7],P0[8],P0[9],     pw0[2]=PKW(P0,4), pw0[3]=PKW(P0,6), pw0); \
    VRD(1); SBAR(); GAPA(C0=__builtin_amdgcn_mfma_f32_32x32x16_bf16(kf[2],qr[1],C0,0,0,0),   P0[10],P0[11],P0[12],P0[13], pw1[0]=PKW(P0,8), pw1[1]=PKW(P0,10), pw1); \
    VRD(5); SBAR(); GAPA(C1=__builtin_amdgcn_mfma_f32_32x32x16_bf16(kf[3],qr[1],C1,0,0,0),   P0[14],P0[15],P1[0],P1[1],   pw1[2]=PKW(P0,12),pw1[3]=PKW(P0,14), pw1); \
    VRD(2); SBAR(); GAPA(C0=__builtin_amdgcn_mfma_f32_32x32x16_bf16(kf[4],qr[2],C0,0,0,0),   P1[2],P1[3],P1[4],P1[5],     pw2[0]=PKW(P1,0), pw2[1]=PKW(P1,2), pw2); \
    VRD(6); SBAR(); GAPA(C1=__builtin_amdgcn_mfma_f32_32x32x16_bf16(kf[5],qr[2],C1,0,0,0),   P1[6],P1[7],P1[8],P1[9],     pw2[2]=PKW(P1,4), pw2[3]=PKW(P1,6), pw2); \
    VRD(3); SBAR(); GAPA(C0=__builtin_amdgcn_mfma_f32_32x32x16_bf16(kf[6],qr[3],C0,0,0,0),   P1[10],P1[11],P1[12],P1[13], pw3[0]=PKW(P1,8), pw3[1]=PKW(P1,10), pw3); \
    VRD(7); SBAR(); GAPA(C1=__builtin_amdgcn_mfma_f32_32x32x16_bf16(kf[7],qr[3],C1,0,0,0),   P1[14],P1[15],0.f,0.f,       pw3[2]=PKW(P1,12),pw3[3]=PKW(P1,14), pw3); \
    l_reg+=sacc; \
    if(GK){DMA_K((t)+3,sl_cur);} if(GV){DMA_V((t)+1,sl_next);} \
    CMASK(C0,C1,t); \
    { float a=MX3(C0[0],C0[1],C1[0]),b=MX3(C0[2],C0[3],C1[1]); a=MX3(a,C1[2],C1[3]); \
      _Pragma("unroll") for(int r=4;r<16;r+=4){a=MX3(a,C0[r],C0[r+1]);b=MX3(b,C0[r+2],C0[r+3]);a=MX3(a,C1[r],C1[r+1]);b=MX3(b,C1[r+2],C1[r+3]);} \
      float rm=__builtin_fmaxf(a,b); { auto rr=__builtin_amdgcn_permlane32_swap(__float_as_uint(rm),__float_as_uint(rm),false,false); rm=__builtin_fmaxf(__uint_as_float(rr[0]),__uint_as_float(rr[1])); } \
      resc=false; \
      if(__builtin_expect(__any(rm>(float)THRL),0)){ const float dl=__builtin_fmaxf(rm,0.f); mhat+=dl; \
        _Pragma("unroll") for(int r=0;r<16;++r){C0[r]-=dl;C1[r]-=dl;} \
        _Pragma("unroll") for(int r=0;r<16;++r)negm[r]=-mhat; asm volatile("":"+v"(negm)); \
        const float f=__builtin_amdgcn_exp2f(-dl); l_reg*=f; if(hi==0)wsf[r32]=f; resc=true; } } \
    SBAR(); \
    GAPB(o[0]=__builtin_amdgcn_mfma_f32_32x32x16_bf16(PAF(0),VFR(0),o[0],0,0,0), C0,0); \
    GAPB(o[1]=__builtin_amdgcn_mfma_f32_32x32x16_bf16(PAF(0),VFR(4),o[1],0,0,0), C0,4); \
    KRD(GL,0); GAPB(o[0]=__builtin_amdgcn_mfma_f32_32x32x16_bf16(PAF(1),VFR(1),o[0],0,0,0), C0,8); \
    KRD(GL,1); GAPB(o[1]=__builtin_amdgcn_mfma_f32_32x32x16_bf16(PAF(1),VFR(5),o[1],0,0,0), C0,12); \
    KRD(GL,2); GAPB(o[0]=__builtin_amdgcn_mfma_f32_32x32x16_bf16(PAF(2),VFR(2),o[0],0,0,0), C1,0); \
    KRD(GL,3); GAPB(o[1]=__builtin_amdgcn_mfma_f32_32x32x16_bf16(PAF(2),VFR(6),o[1],0,0,0), C1,4); \
    GAPB(o[0]=__builtin_amdgcn_mfma_f32_32x32x16_bf16(PAF(3),VFR(3),o[0],0,0,0), C1,8); \
    GAPB(o[1]=__builtin_amdgcn_mfma_f32_32x32x16_bf16(PAF(3),VFR(7),o[1],0,0,0), C1,12); \
    }while(0)
  int t=1;
  #undef CMASK
  #define CMASK(P0,P1,t) do{}while(0)
  for(;t+5<NT;t+=2){
    STEP(pB0,pB1,pA0,pA1,t,true,true,true);     WAIT_BAR(2); RESC(); ROT();
    STEP(pA0,pA1,pB0,pB1,t+1,true,true,true);   WAIT_BAR(2); RESC(); ROT();
  }
  #undef CMASK
  #define CMASK(P0,P1,t) do{int jb_=(t)-(NT-4); if(jb_>=0)cmask(P0,P1,jb_,qrel,hi);}while(0)
  #define ENDW(tt) do{ if((tt)+3<NT){WAIT_BAR(2);} else if((tt)+2<NT){WAIT_BAR(1);} else {WAIT_BAR(0);} }while(0)
  for(;t+1<NT;t+=2){
    STEP(pB0,pB1,pA0,pA1,t,(t+3<NT),(t+1<NT),(t+1<NT));       ENDW(t);   RESC(); ROT();
    STEP(pA0,pA1,pB0,pB1,t+1,(t+4<NT),(t+2<NT),(t+2<NT));     ENDW(t+1); RESC(); ROT();
  }
  STEP(pB0,pB1,pA0,pA1,NT-1,false,false,false); RESC();
  { float sacc=pB0[0]+pB0[1]; _Pragma("unroll") for(int r=2;r<16;++r)sacc+=pB0[r]; _Pragma("unroll") for(int r=0;r<16;++r)sacc+=pB1[r]; l_reg+=sacc;
    pw0=(u32x4){PKW(pB0,0),PKW(pB0,2),PKW(pB0,4),PKW(pB0,6)};pw1=(u32x4){PKW(pB0,8),PKW(pB0,10),PKW(pB0,12),PKW(pB0,14)};pw2=(u32x4){PKW(pB1,0),PKW(pB1,2),PKW(pB1,4),PKW(pB1,6)};pw3=(u32x4){PKW(pB1,8),PKW(pB1,10),PKW(pB1,12),PKW(pB1,14)};
    SBAR(); pv(o,vb0+sl_cur,PAF(0),PAF(1),PAF(2),PAF(3)); }
  #undef PKW
  #undef PAF
  #undef VFR
  #undef PIN
  #undef MX3
  #undef GAPA
  #undef GAPB
  #undef EX
  #undef VRD
  #undef KRD
  #undef STEP
  #undef ENDW
  {auto rr=__builtin_amdgcn_permlane32_swap(__float_as_uint(l_reg),__float_as_uint(l_reg),false,false);l_reg=__uint_as_float(rr[0])+__uint_as_float(rr[1]);}
  if(hi==0)wsf[32+r32]=l_reg;asm volatile("s_waitcnt lgkmcnt(0)":::"memory");
  float rli[16];
  #pragma unroll
  for(int r=0;r<16;++r)rli[r]=__builtin_amdgcn_rcpf(wsf[32+crow(r,hi)]);
  bf16*Ow=O+(rowbase+q0+wid*QBLK)*DM+h*D;
  { bf16*stg=(bf16*)(shm+LDS_OST)+wid*2048;
    #pragma unroll
    for(int r=0;r<16;++r){const int orow=crow(r,hi);
      #pragma unroll
      for(int d0=0;d0<2;++d0)stg[orow*64+d0*32+r32]=__float2bfloat16(o[d0][r]*rli[r]);}
    asm volatile("s_waitcnt lgkmcnt(0)":::"memory");
    #pragma unroll
    for(int i=0;i<4;++i){const int row=i*8+(lane>>3),ch=lane&7; const u32x4 v=*(const u32x4*)(stg+row*64+ch*8); ATTN_STORE16(Ow+(long)row*DM+ch*8,v);} }
  asm volatile("s_waitcnt lgkmcnt(0)\n\ts_barrier":::"memory");
  #undef DMA_K
  #undef DMA_V
  #undef CMASK
  #undef START
  #undef RESC
  #undef ROT
}
constexpr int ATTN_LDS_BYTES=LDS_BYTES;
struct AttnTensors { const bf16* Q; const bf16* K; const bf16* V; bf16* O; };
struct AttnUnit { int bh; int qb; };
struct StaticOrder {
  int vcu;
  __device__ __forceinline__ explicit StaticOrder(int grid,int block):vcu((block%8)*(grid/8)+block/8){}
  __device__ __forceinline__ bool next(int i,AttnUnit&u)const{ if(i>=4)return false; const int s=vcu&7; u.bh=vcu>>3; u.qb=(i==0)?s:(i==1)?15-s:(i==2)?16+s:31-s; return true; }
  __device__ __forceinline__ void a_ready(const AttnUnit&)const{}
  __device__ __forceinline__ void done(const AttnUnit&)const{}
};
struct QueueOrder {
  unsigned* heads; volatile __attribute__((address_space(3))) int* slot; int x;
  mutable unsigned pend; mutable int npend;
  __device__ __forceinline__ bool next(int,AttnUnit&u)const{
    if(threadIdx.x==0){ int found=-1;
      if(npend){ if(pend<128u)found=x*128+(int)pend; }
      if(found<0){
        _Pragma("unroll 1") for(int q=0;q<8;++q){ const int xq=(x+q)&7;
          if(__hip_atomic_load(heads+64*xq,__ATOMIC_RELAXED,__HIP_MEMORY_SCOPE_AGENT)>=128u)continue;
          const unsigned j=__hip_atomic_fetch_add(heads+64*xq,1u,__ATOMIC_RELAXED,__HIP_MEMORY_SCOPE_AGENT);
          if(j<128u){found=xq*128+(int)j;break;} } }
      *slot=found;
      npend=0;
      if(found>=0&&(found>>7)==x){ pend=__hip_atomic_fetch_add(heads+64*x,1u,__ATOMIC_RELAXED,__HIP_MEMORY_SCOPE_AGENT); npend=1; } }
    __syncthreads();
    const int f=*slot;
    if(f<0)return false;
    const int xq=f>>7,j=f&127; u.qb=31-(j>>2); u.bh=xq*4+(j&3); return true; }
  __device__ __forceinline__ void a_ready(const AttnUnit&)const{}
  __device__ __forceinline__ void done(const AttnUnit&)const{}
};
template<class Sched,int THRL=8> __device__ __forceinline__ void attn_phase(char*lds,const AttnTensors&T,const Sched&S){
  AttnUnit u;
  for(int i=0;S.next(i,u);++i){ S.a_ready(u); attn_unit<THRL>(u.bh/NHEAD,u.bh%NHEAD,u.qb,T.Q,T.K,T.V,T.O,lds); S.done(u); }
}
#undef SBAR
#undef WAIT_BAR
}
#define GAS __attribute__((address_space(1)))
#define LAS __attribute__((address_space(3)))
typedef unsigned short bf16;
typedef unsigned v4u __attribute__((ext_vector_type(4)));
typedef float f32x4 __attribute__((ext_vector_type(4)));
typedef short bf16x8 __attribute__((ext_vector_type(8)));
typedef GAS unsigned gu32;
typedef GAS unsigned long long gu64;
#define RLX_AGENT __ATOMIC_RELAXED, __HIP_MEMORY_SCOPE_AGENT
#define LDS_WAIT() asm volatile("s_waitcnt lgkmcnt(0)" ::: "memory")
#define VM_WAIT() asm volatile("s_waitcnt vmcnt(0)" ::: "memory")
__device__ __forceinline__ unsigned long long rt() { return __builtin_amdgcn_s_memrealtime(); }
__device__ __forceinline__ unsigned pk2(float lo, float hi) { return attn_body::cvtpk_s(lo, hi); }
__device__ __forceinline__ unsigned f2bf(float f) { return attn_body::cvtpk_s(f, 0.f) & 0xffffu; }

#define XB_TMO      128
#define XB_XCNT(j)  (256  + 64 * (j))
#define XB_XSUB(j)  (1280 + 64 * (j))
#define XB_XGEN(j)  (2304 + 64 * (j))
#define XB_TOP      3328
#define XB_TOPGEN   3392
#define XCD_BAR_WORDS 3456
#define XB_SPIN_CAP (1u << 18)
#ifndef XB_SLEEP
#define XB_SLEEP 1
#endif

__device__ __forceinline__ unsigned xb_ld(unsigned* p)              { return __hip_atomic_load(p, __ATOMIC_RELAXED, __HIP_MEMORY_SCOPE_AGENT); }
__device__ __forceinline__ unsigned xb_add(unsigned* p, unsigned v) { return __hip_atomic_fetch_add(p, v, __ATOMIC_RELAXED, __HIP_MEMORY_SCOPE_AGENT); }
__device__ __forceinline__ unsigned xb_xcc_id() { return (unsigned)__builtin_amdgcn_s_getreg((3 << 11) | 20) & 0xFu; }
#define XB_SPIN(cond, bar) do { unsigned _sp = 0; while (cond) { __builtin_amdgcn_s_sleep(XB_SLEEP); \
    if ((++_sp & 255u) == 0u) { if (xb_ld(&(bar)[XB_TMO])) break; if (_sp > XB_SPIN_CAP) { atomicAdd(&(bar)[XB_TMO], 1u); break; } } } } while (0)

struct XcdBarrier {
    unsigned* bar; unsigned x;
    volatile LAS unsigned* st;
};

__device__ __forceinline__ XcdBarrier xcd_barrier_post(unsigned* bar, volatile LAS unsigned* st) {
    XcdBarrier b; b.bar = bar; b.x = xb_xcc_id(); b.st = st;
    if (threadIdx.x == 0) (void)xb_add(&bar[XB_XCNT(b.x)], 1u);
    return b;
}
__device__ __forceinline__ void xcd_barrier_complete(unsigned* bar, unsigned x, unsigned& nloc, unsigned& nx) {
    const unsigned G = gridDim.x * gridDim.y * gridDim.z;
    unsigned sum, cnt, mine, sp = 0u;
    for (;;) {
        sum = 0u; cnt = 0u; mine = 0u;
#pragma unroll
        for (unsigned j = 0; j < 16; ++j) { const unsigned c = xb_ld(&bar[XB_XCNT(j)]); sum += c; cnt += (c > 0u) ? 1u : 0u; mine = (j == x) ? c : mine; }
        if (sum == G) break;
        __builtin_amdgcn_s_sleep(1);
        if ((++sp & 255u) == 0u) { if (xb_ld(&bar[XB_TMO])) break; if (sp > XB_SPIN_CAP) { atomicAdd(&bar[XB_TMO], 1u); break; } }
    }
    nloc = mine > 0u ? mine : 1u; nx = cnt > 0u ? cnt : 1u;
}

__device__ __forceinline__ void xcd_barrier(const XcdBarrier& b) {
    asm volatile("s_waitcnt vmcnt(0)" ::: "memory");
    __syncthreads();
    if (threadIdx.x == 0) {
        unsigned* bar = b.bar;
        __builtin_amdgcn_s_waitcnt(0);
        unsigned nloc = b.st[0], nx = b.st[1];
        if (nloc == 0u) { xcd_barrier_complete(bar, b.x, nloc, nx); b.st[0] = nloc; b.st[1] = nx; }
        const unsigned old = xb_add(&bar[XB_XSUB(b.x)], 1u);
        const unsigned gen = old / nloc;
        if (old + 1u == (gen + 1u) * nloc) {
            __builtin_amdgcn_fence(__ATOMIC_RELEASE, "agent");
            asm volatile("s_waitcnt vmcnt(0)" ::: "memory");
            const unsigned og = xb_add(&bar[XB_TOP], 1u);
            const unsigned tg = og / nx;
            if (og + 1u == (tg + 1u) * nx) xb_add(&bar[XB_TOPGEN], 1u);
            else XB_SPIN(xb_ld(&bar[XB_TOPGEN]) == tg, bar);
            __builtin_amdgcn_fence(__ATOMIC_ACQUIRE, "agent");
            xb_add(&bar[XB_XGEN(b.x)], 1u);
            asm volatile("s_waitcnt vmcnt(0)" ::: "memory");
        } else {
            XB_SPIN(xb_ld(&bar[XB_XGEN(b.x)]) == gen, bar);
            __builtin_amdgcn_fence(__ATOMIC_ACQUIRE, "agent");
            asm volatile("s_waitcnt vmcnt(0)" ::: "memory");
        }
    }
    __syncthreads();
}

__device__ __forceinline__ void split_arrive(unsigned* cnt) {
    asm volatile("s_waitcnt vmcnt(0)" ::: "memory");
    __syncthreads();
    if (threadIdx.x == 0) { __builtin_amdgcn_fence(__ATOMIC_RELEASE, "agent"); asm volatile("s_waitcnt vmcnt(0)" ::: "memory"); (void)xb_add(cnt, 1u); }
}
__device__ __forceinline__ void split_wait(unsigned* cnt, unsigned target, unsigned* bar) {
    if (threadIdx.x == 0) { XB_SPIN(xb_ld(cnt) < target, bar); __builtin_amdgcn_fence(__ATOMIC_ACQUIRE, "agent"); asm volatile("s_waitcnt vmcnt(0)" ::: "memory"); }
    __syncthreads();
}
constexpr int NWAVES = 8;
constexpr int NB = 2, SEQ = 8192, DM = 1024, NTOK = NB * SEQ;
constexpr int IN_COLS = 3592, INP_N = 3584;
constexpr int NEXP = 32, TOPK = 4, NMEM = 256;
constexpr int GCH = 64, NCHUNK = SEQ / GCH;
constexpr float DN_ALPHA = 1.189207115002721f;
constexpr float LN_EPS = 1e-5f, RMS_EPS = 1e-6f;
constexpr float LAMBDA_INIT = 0.2f;
constexpr int MOE_MAXROWS = 73728;
constexpr int MOE_MAXTILES = MOE_MAXROWS / 256;

constexpr size_t MiB = 1u << 20;
constexpr size_t WS_CTL = 0, CTL_ZERO_BYTES = 1 * MiB;
constexpr size_t WS_WD = 1 * MiB;
constexpr size_t WS_WGU = 65 * MiB;
constexpr size_t WS_Y = 65 * MiB;
constexpr size_t WS_WIN = 193 * MiB;
constexpr size_t WS_WOUT = 200 * MiB;
constexpr size_t WS_WKV = 202 * MiB;
constexpr size_t WS_WQH = 206 * MiB;
constexpr size_t WS_WOH = 208 * MiB;
constexpr size_t WS_WQK = 210 * MiB;
constexpr size_t WS_VWO = 214 * MiB;
constexpr size_t WS_KMAT = 218 * MiB;
constexpr size_t WS_VMAT = 219 * MiB;
constexpr size_t WS_MEMB = 220 * MiB;
constexpr size_t WS_GBA = 221 * MiB;
constexpr size_t WS_GL = 221 * MiB + 512 * 1024;
constexpr size_t WS_TOPI = 222 * MiB;
constexpr size_t WS_GATE = 222 * MiB + 256 * 1024;
constexpr size_t WS_DEST = 222 * MiB + 512 * 1024;
constexpr size_t WS_GCNT = 222 * MiB + 768 * 1024;
constexpr size_t WS_XB = 224 * MiB;
constexpr size_t WS_O16 = 224 * MiB;
constexpr size_t WS_GQKV = 256 * MiB;
constexpr size_t WS_OA = 256 * MiB;
constexpr size_t WS_GZ = 304 * MiB;
constexpr size_t WS_DQ = 320 * MiB, WS_DK = 336 * MiB, WS_DV = 352 * MiB;
constexpr size_t WS_GOP = 368 * MiB;
constexpr size_t WS_GOUT = 456 * MiB;
constexpr size_t WS_V1 = 288 * MiB;
constexpr size_t WS_X1F = 352 * MiB;
constexpr size_t WS_X1B = 416 * MiB;
constexpr size_t WS_PM = 448 * MiB;
constexpr size_t WS_X2B = 224 * MiB;
constexpr size_t WS_TOKTAB = 256 * MiB;
constexpr size_t WS_H = 368 * MiB;
constexpr size_t WS_XCH = 223 * MiB;
constexpr size_t WS_END = 512 * MiB;
constexpr int GOP_BYTES = 90112;
constexpr int GOP_W = 0, GOP_QD = 16384, GOP_KT = 32768, GOP_AI = 49152, GOP_UT = 57344, GOP_LDS = 57344;
constexpr int CW_BAR = 4096;
constexpr int CW_AQ = 2048;
constexpr int CW_BGQ = 8192;
constexpr int CW_BGDONE = 9216;
#ifndef SPLIT23
#define SPLIT23 1
#endif
constexpr int CW_SPLIT = 7680;
constexpr int CW_TMO = 16;
constexpr int CW_PANEL = 16384;
constexpr int CW_CNT = 64;
constexpr int CW_FILL = 128;

constexpr int RING_BYTES = 131072;
constexpr int MISC_OFF = RING_BYTES;
constexpr int LDS_BYTES = 147456;

typedef unsigned v2u __attribute__((ext_vector_type(2)));
__device__ __forceinline__ float bf2f(unsigned short b) { return __builtin_bit_cast(float, (unsigned)b << 16); }
__device__ __forceinline__ float bflo(unsigned w) { return __builtin_bit_cast(float, w << 16); }
__device__ __forceinline__ float bfhi(unsigned w) { return __builtin_bit_cast(float, w & 0xffff0000u); }
__device__ __forceinline__ float wave_sum(float v) {
    int x = __builtin_bit_cast(int, v);
#define WS_STEP(ctrl, rmask) x = __builtin_bit_cast(int, __builtin_bit_cast(float, x) + __builtin_bit_cast(float, __builtin_amdgcn_update_dpp(0, x, ctrl, rmask, 0xf, false)))
    WS_STEP(0x111, 0xf); WS_STEP(0x112, 0xf); WS_STEP(0x114, 0xf); WS_STEP(0x118, 0xf); WS_STEP(0x142, 0xa); WS_STEP(0x143, 0xc);
#undef WS_STEP
    return __builtin_bit_cast(float, __builtin_amdgcn_readlane(x, 63));
}
__device__ __forceinline__ float sigmoidf_(float x) { return __builtin_amdgcn_rcpf(1.0f + __expf(-x)); }

struct Args { const float* in[31]; float* out; unsigned char* ws; int ph_lo, ph_hi; };
struct KA {
    unsigned char* ws;
    __device__ __forceinline__ const float* in(int i) const {
        const __attribute__((address_space(4))) unsigned long long* p = (const __attribute__((address_space(4))) unsigned long long*)__builtin_amdgcn_kernarg_segment_ptr();
        asm volatile("" : "+s"(p));
        return (const float*)p[i];
    }
    __device__ __forceinline__ float* out() const {
        const __attribute__((address_space(4))) unsigned long long* p = (const __attribute__((address_space(4))) unsigned long long*)__builtin_amdgcn_kernarg_segment_ptr();
        asm volatile("" : "+s"(p));
        return (float*)p[31];
    }
};

__device__ __forceinline__ void transpose_item64(const float* src, int srcN, bf16* dst, int ld, int lane) {
    const int c = lane & 15, r4 = lane >> 4;
    const float* s = src + (size_t)(16 * r4) * srcN + 4 * c;
    f32x4 v[16];
#pragma unroll
    for (int j = 0; j < 16; ++j) v[j] = *(const GAS f32x4*)(s + (size_t)j * srcN);
#pragma unroll
    for (int i = 0; i < 4; ++i) {
        v4u o0, o1;
        o0.x = attn_body::cvtpk_s(v[0][i], v[1][i]); o0.y = attn_body::cvtpk_s(v[2][i], v[3][i]); o0.z = attn_body::cvtpk_s(v[4][i], v[5][i]); o0.w = attn_body::cvtpk_s(v[6][i], v[7][i]);
        o1.x = attn_body::cvtpk_s(v[8][i], v[9][i]); o1.y = attn_body::cvtpk_s(v[10][i], v[11][i]); o1.z = attn_body::cvtpk_s(v[12][i], v[13][i]); o1.w = attn_body::cvtpk_s(v[14][i], v[15][i]);
        bf16* d = dst + (size_t)(4 * c + i) * ld + 16 * r4;
        *(GAS v4u*)d = o0; *(GAS v4u*)(d + 8) = o1;
    }
}
enum { I_X = 0, I_MEM, I_WIN, I_CONVW, I_ALOG, I_DTB, I_GNW, I_LQ1, I_LK1, I_LQ2, I_LK2, I_DNW, I_WOUT, I_LN1G, I_LN1B, I_WQ, I_WK, I_WV, I_WO, I_LN2G, I_LN2B,
       I_RW, I_RB, I_EWG, I_EBG, I_EWU, I_EBU, I_EWD, I_EBD, I_LN3G, I_LN3B };

__device__ __forceinline__ void p0_prologue(const KA& A, LAS unsigned char* lds, int gw, int NGW, int wave, int lane, int tid) {
    unsigned char* ws = A.ws;
    constexpr int IT_WIN = 16 * 56, IT_SQ = 16 * 16;
    constexpr int O_WOUT = IT_WIN, O_EXP = O_WOUT + 4 * IT_SQ, NITEMS = O_EXP;
    for (int it = gw; it < NITEMS; it += NGW) {
        if (it < O_WOUT) { const int kb = it / 56, nb = it % 56, n0 = nb * 64, k0 = kb * 64; const int sc = n0 + (n0 >= 2048 ? 8 : 0);
            transpose_item64(A.in(I_WIN) + (size_t)k0 * IN_COLS + sc, IN_COLS, (bf16*)(ws + WS_WIN) + (size_t)n0 * 1024 + k0, 1024, lane); continue; }
        if (it < O_EXP) {
            const int r = it - O_WOUT, which = r / IT_SQ, q = r % IT_SQ, kb = q / 16, nb = q % 16, n0 = nb * 64, k0 = kb * 64;
            const float* src; bf16* dst; int ld = 1024;
            if (which == 0) { src = A.in(I_WOUT); dst = (bf16*)(ws + WS_WOUT) + (size_t)n0 * 1024 + k0; }
            else if (which == 1) { src = A.in(I_WK); dst = (bf16*)(ws + WS_WKV) + (size_t)n0 * 1024 + k0; }
            else if (which == 2) { src = A.in(I_WV); dst = (bf16*)(ws + WS_WKV) + (size_t)(1024 + n0) * 1024 + k0; }
            else { src = A.in(I_WO); dst = (bf16*)(ws + WS_WOH) + ((size_t)(k0 >> 8) * 1024 + n0) * 256 + (k0 & 255); ld = 256; }
            transpose_item64(src + (size_t)k0 * 1024 + n0, 1024, dst, ld, lane); continue;
        }
    }
    for (int r = gw; r < 1024 + NB * NMEM; r += NGW) {
        const float* srow = (r < 1024) ? A.in(I_WQ) + (size_t)r * 1024 : A.in(I_MEM) + (size_t)(r - 1024) * 1024;
#pragma unroll
        for (int j = 0; j < 4; ++j) {
            const int col = 4 * lane + 256 * j; const f32x4 v = *(const GAS f32x4*)(srow + col);
            v2u o; o.x = pk2(v.x, v.y); o.y = pk2(v.z, v.w);
            bf16* d = (r < 1024) ? (bf16*)(ws + WS_WQH) + ((size_t)(col >> 8) * 1024 + r) * 256 + (col & 255) : (bf16*)(ws + WS_MEMB) + (size_t)(r - 1024) * 1024 + col;
            *(GAS v2u*)d = o;
        }
    }
    LAS float* w8 = (LAS float*)lds;
    for (int i = tid; i < 8192; i += 512) { const int k = i >> 3, c = i & 7; w8[c * 1024 + k] = A.in(I_WIN)[(size_t)k * IN_COLS + 2048 + c]; }
    __syncthreads();
    for (int m = gw; m < NTOK; m += 2 * NGW) {
        const int m1 = m + NGW;
        const float* xr0 = A.in(I_X) + (size_t)m * 1024; const float* xr1 = A.in(I_X) + (size_t)m1 * 1024;
        float acc0[8], acc1[8];
#pragma unroll
        for (int c = 0; c < 8; ++c) { acc0[c] = 0.f; acc1[c] = 0.f; }
#pragma unroll
        for (int j = 0; j < 4; ++j) {
            const int col = 4 * lane + 256 * j; const f32x4 v0 = *(const GAS f32x4*)(xr0 + col); const f32x4 v1 = *(const GAS f32x4*)(xr1 + col);
            v2u o0, o1; o0.x = pk2(v0.x, v0.y); o0.y = pk2(v0.z, v0.w); o1.x = pk2(v1.x, v1.y); o1.y = pk2(v1.z, v1.w);
            *(GAS v2u*)((bf16*)(ws + WS_XB) + (size_t)m * 1024 + col) = o0; *(GAS v2u*)((bf16*)(ws + WS_XB) + (size_t)m1 * 1024 + col) = o1;
#pragma unroll
            for (int c = 0; c < 8; ++c) { const f32x4 w = *(const LAS f32x4*)(w8 + c * 1024 + col);
                acc0[c] += v0.x * w.x + v0.y * w.y + v0.z * w.z + v0.w * w.w; acc1[c] += v1.x * w.x + v1.y * w.y + v1.z * w.z + v1.w * w.w; }
        }
#pragma unroll
        for (int c = 0; c < 8; ++c) { acc0[c] = wave_sum(acc0[c]); acc1[c] = wave_sum(acc1[c]); }
        if (lane == 0) { float* g = (float*)(ws + WS_GBA) + (size_t)m * 8;
            *(f32x4*)g = (f32x4){acc0[0], acc0[1], acc0[2], acc0[3]}; *(f32x4*)(g + 4) = (f32x4){acc0[4], acc0[5], acc0[6], acc0[7]};
            float* g1 = (float*)(ws + WS_GBA) + (size_t)m1 * 8;
            *(f32x4*)g1 = (f32x4){acc1[0], acc1[1], acc1[2], acc1[3]}; *(f32x4*)(g1 + 4) = (f32x4){acc1[4], acc1[5], acc1[6], acc1[7]}; }
    }
    __syncthreads();
}

constexpr int BG_GU = NEXP * 2 * 256, BG_D = NEXP * 256;
__device__ __forceinline__ void bg_item(const KA& A, unsigned char* ws, int q, int it, int lane) {
    const int e = it / (q == 0 ? 512 : 256), r2 = it % (q == 0 ? 512 : 256), which = (q == 0) ? (r2 >> 8) : 2, t = r2 & 255, kb = t >> 4, nb = t & 15, n0 = nb * 64, k0 = kb * 64;
    const float* src; bf16* dst;
    if (which == 0) { src = A.in(I_EWG) + (size_t)e * 1048576; dst = (bf16*)(ws + WS_WGU) + (size_t)e * 2097152 + (size_t)((n0 >> 7) * 256 + (n0 & 127)) * 1024 + k0; }
    else if (which == 1) { src = A.in(I_EWU) + (size_t)e * 1048576; dst = (bf16*)(ws + WS_WGU) + (size_t)e * 2097152 + (size_t)((n0 >> 7) * 256 + 128 + (n0 & 127)) * 1024 + k0; }
    else { src = A.in(I_EWD) + (size_t)e * 1048576; dst = (bf16*)(ws + WS_WD) + (size_t)e * 1048576 + (size_t)n0 * 1024 + k0; }
    transpose_item64(src + (size_t)k0 * 1024 + n0, 1024, dst, 1024, lane);
}
__device__ __forceinline__ void bg_pull(const KA& A, unsigned char* ws, LAS unsigned char* lds, int lane_in, int q0, int q1, const unsigned* done_cnt, unsigned done_at) {
    int lane = lane_in; asm volatile("" : "+v"(lane));
    unsigned* qh = (unsigned*)(ws + WS_CTL) + CW_BGQ;
    volatile LAS int* slot = (volatile LAS int*)(lds + MISC_OFF + 208);
    const int home = (int)(blockIdx.x & 7), wv = (int)(threadIdx.x >> 6);
    for (;;) {
        if (threadIdx.x < 64) {
            const int l0 = (int)threadIdx.x;
            int q = -1, base = 0, cnt = 0;
            int stop = 0; if (l0 == 0 && done_cnt) stop = __hip_atomic_load(done_cnt, __ATOMIC_RELAXED, __HIP_MEMORY_SCOPE_AGENT) >= done_at ? 1 : 0;
            stop = __builtin_amdgcn_readfirstlane(stop);
            if (!stop) {
#pragma unroll 1
                for (int pass = 0; pass < 2 && q < 0; ++pass) {
                    const int qq = pass ? q1 : q0; if (qq < 0) break;
                    const unsigned per = (unsigned)((qq == 0 ? BG_GU : BG_D) / 8);
                    unsigned hv = 0xffffffffu; if (l0 < 8) hv = __hip_atomic_load(qh + 64 * (qq * 8 + ((home + l0) & 7)), __ATOMIC_RELAXED, __HIP_MEMORY_SCOPE_AGENT);
                    unsigned mk = (unsigned)__ballot(hv < per) & 0xffu;
#pragma unroll 1
                    while (mk && q < 0) { const int t = __builtin_ctz(mk); mk &= mk - 1u; const int s = (home + t) & 7; unsigned* h = qh + 64 * (qq * 8 + s);
                        unsigned j = 0u; if (l0 == 0) j = __hip_atomic_fetch_add(h, 8u, __ATOMIC_RELAXED, __HIP_MEMORY_SCOPE_AGENT);
                        j = (unsigned)__builtin_amdgcn_readfirstlane((int)j);
                        if (j < per) { q = qq; base = (int)(s * per + j); cnt = (int)((per - j) < 8u ? (per - j) : 8u); } }
                }
            }
            if (l0 == 0) { slot[0] = q; slot[1] = base; slot[2] = cnt; }
        }
        __syncthreads();
        const int q = slot[0], base = slot[1], cnt = slot[2];
        __syncthreads();
        if (q < 0) break;
        if (wv < cnt) bg_item(A, ws, q, base + wv, lane);
    }
}
constexpr int GP_KR = 0, GP_QR = 17408, GP_KBGT = 34816, GP_VBT = 53248, GP_KTT = 71680, GP_AINV = 88064, GP_LM = 97280, GP_G = 114688, GP_CW = 115712;
__device__ __forceinline__ int sigma_pos(int idx) { const int s = idx >> 5, tl = idx & 31; return 32 * s + 8 * ((tl >> 2) & 3) + 4 * (tl >> 4) + (tl & 3); }
__device__ __forceinline__ f32x4 mfma16(bf16x8 a, bf16x8 b, f32x4 c) { return __builtin_amdgcn_mfma_f32_16x16x32_bf16(a, b, c, 0, 0, 0); }

__device__ __forceinline__ void gdn_prep_unit(const KA& A, LAS unsigned char* lds, int unit, int tid_in, int (&cw_head)[2]) {
    int tid = tid_in; asm volatile("" : "+v"(tid));
    const int lane = tid & 63, wave = __builtin_amdgcn_readfirstlane(tid >> 6);
    unsigned char* ws = A.ws;
    const int bh = unit >> 7, n = unit & 127, b = bh >> 2, h = bh & 3;
    const int m0 = b * SEQ + n * GCH;
    LAS bf16* Kr = (LAS bf16*)(lds + GP_KR); LAS bf16* Qr = (LAS bf16*)(lds + GP_QR);
    LAS bf16* KbgT = (LAS bf16*)(lds + GP_KBGT); LAS bf16* VbT = (LAS bf16*)(lds + GP_VBT); LAS bf16* KtT = (LAS bf16*)(lds + GP_KTT);
    LAS bf16* Ainv = (LAS bf16*)(lds + GP_AINV); LAS float* Lm = (LAS float*)(lds + GP_LM); LAS float* Gs = (LAS float*)(lds + GP_G);
    unsigned char* gop = ws + WS_GOP + (size_t)unit * GOP_BYTES;
    if (cw_head[h >> 1] != h) {
        cw_head[h >> 1] = h;
        const float* cw = A.in(I_CONVW);
        if (tid < 384) { const int mj = tid >> 5, d4 = (tid & 31) * 4, mat = mj >> 2, j = mj & 3;
            *(LAS f32x4*)((LAS float*)(lds + GP_CW) + (h >> 1) * 1536 + mj * 128 + d4) = *(const f32x4*)(cw + j * 1536 + mat * 512 + h * 128 + d4); }
        __syncthreads();
    }
#ifndef PREP_REP_A
#define PREP_REP_A 1
#endif
#pragma unroll 1
    for (int ra_ = 0; ra_ < PREP_REP_A; ++ra_) {
    if (wave == 0) {
        const float* gba = (const float*)(ws + WS_GBA) + (size_t)(m0 + lane) * 8;
        const float gb = gba[h], ga = gba[4 + h];
        const float beta = sigmoidf_(gb);
        const float xx = ga + A.in(I_DTB)[h];
        const float sp = fmaxf(xx, 0.f) + log1pf(__expf(-fabsf(xx)));
        float g = -__expf(A.in(I_ALOG)[h]) * sp;
#pragma unroll
        for (int o = 1; o < 64; o <<= 1) { const float v = __builtin_bit_cast(float, __builtin_amdgcn_ds_bpermute((lane - o) << 2, __builtin_bit_cast(int, g))); if (lane >= o) g += v; }
        Gs[lane] = g; Gs[64 + lane] = beta;
        if (lane == 63) ((float*)(ws + WS_GL))[unit * 32] = __expf(g);
    }
    const int tok = tid >> 3, part = tid & 7;
    float yq[16], yk[16], yv[16];
    {
        const bf16* gq = (const bf16*)(ws + WS_GQKV);
        v4u xr[2][4][2];
#define GDN_LOADX(mat, buf) do { _Pragma("unroll") for (int j = 0; j < 4; ++j) { const int rel = n * GCH + tok - 3 + j; const int relc = rel < 0 ? 0 : rel; \
            const bf16* src = gq + (size_t)(b * SEQ + relc) * 1536 + (mat) * 512 + h * 128 + part * 16; \
            xr[buf][j][0] = *(const GAS v4u*)src; xr[buf][j][1] = *(const GAS v4u*)(src + 8); \
            if (rel < 0) { xr[buf][j][0] = (v4u){0u, 0u, 0u, 0u}; xr[buf][j][1] = (v4u){0u, 0u, 0u, 0u}; } } } while (0)
        GDN_LOADX(0, 0);
        const LAS float* cwl = (const LAS float*)(lds + GP_CW) + (h >> 1) * 1536 + part * 16;
#pragma unroll
        for (int mat = 0; mat < 3; ++mat) {
            if (mat < 2) GDN_LOADX(mat + 1, (mat + 1) & 1);
            float y[16];
#pragma unroll
            for (int i = 0; i < 16; ++i) y[i] = 0.f;
#pragma unroll
            for (int j = 0; j < 4; ++j) {
                const v4u x0 = xr[mat & 1][j][0], x1 = xr[mat & 1][j][1];
                const LAS float* wj = cwl + (mat * 4 + j) * 128;
                const f32x4 w0 = *(const LAS f32x4*)wj, w1 = *(const LAS f32x4*)(wj + 4), w2 = *(const LAS f32x4*)(wj + 8), w3 = *(const LAS f32x4*)(wj + 12);
                y[0] += w0.x * bflo(x0.x); y[1] += w0.y * bfhi(x0.x); y[2] += w0.z * bflo(x0.y); y[3] += w0.w * bfhi(x0.y);
                y[4] += w1.x * bflo(x0.z); y[5] += w1.y * bfhi(x0.z); y[6] += w1.z * bflo(x0.w); y[7] += w1.w * bfhi(x0.w);
                y[8] += w2.x * bflo(x1.x); y[9] += w2.y * bfhi(x1.x); y[10] += w2.z * bflo(x1.y); y[11] += w2.w * bfhi(x1.y);
                y[12] += w3.x * bflo(x1.z); y[13] += w3.y * bfhi(x1.z); y[14] += w3.z * bflo(x1.w); y[15] += w3.w * bfhi(x1.w);
            }
#pragma unroll
            for (int i = 0; i < 16; ++i) { const float s = y[i] * sigmoidf_(y[i]); if (mat == 0) yq[i] = s; else if (mat == 1) yk[i] = s; else yv[i] = s; }
        }
#undef GDN_LOADX
        float sq = 0.f, sk = 0.f;
#pragma unroll
        for (int i = 0; i < 16; ++i) { sq += yq[i] * yq[i]; sk += yk[i] * yk[i]; }
#define SWZX(x, m) __builtin_bit_cast(float, __builtin_amdgcn_ds_swizzle(__builtin_bit_cast(int, x), ((m) << 10) | 0x1f))
        sq += SWZX(sq, 1); sq += SWZX(sq, 2); sq += SWZX(sq, 4);
        sk += SWZX(sk, 1); sk += SWZX(sk, 2); sk += SWZX(sk, 4);
#undef SWZX
        const float rq = rsqrtf(sq + RMS_EPS) * 0.08838834764831845f, rk = rsqrtf(sk + RMS_EPS);
#pragma unroll
        for (int i = 0; i < 16; ++i) { yq[i] *= rq; yk[i] *= rk; }
    }
    __syncthreads();
    {
        const float G = Gs[tok], beta = Gs[64 + tok], G63 = Gs[63];
        const float eG = __expf(G), eT = __expf(G63 - G), bG = beta * eG;
        v4u o0, o1;
        o0.x = pk2(yk[0], yk[1]); o0.y = pk2(yk[2], yk[3]); o0.z = pk2(yk[4], yk[5]); o0.w = pk2(yk[6], yk[7]);
        o1.x = pk2(yk[8], yk[9]); o1.y = pk2(yk[10], yk[11]); o1.z = pk2(yk[12], yk[13]); o1.w = pk2(yk[14], yk[15]);
        *(LAS v4u*)(Kr + tok * 136 + part * 16) = o0; *(LAS v4u*)(Kr + tok * 136 + part * 16 + 8) = o1;
        o0.x = pk2(yq[0], yq[1]); o0.y = pk2(yq[2], yq[3]); o0.z = pk2(yq[4], yq[5]); o0.w = pk2(yq[6], yq[7]);
        o1.x = pk2(yq[8], yq[9]); o1.y = pk2(yq[10], yq[11]); o1.z = pk2(yq[12], yq[13]); o1.w = pk2(yq[14], yq[15]);
        *(LAS v4u*)(Qr + tok * 136 + part * 16) = o0; *(LAS v4u*)(Qr + tok * 136 + part * 16 + 8) = o1;
        const int sp = sigma_pos(tok);
#pragma unroll
        for (int i = 0; i < 16; ++i) {
            const int d = part * 16 + i;
            KbgT[d * 72 + tok] = (bf16)f2bf(yk[i] * bG);
            VbT[d * 72 + tok] = (bf16)f2bf(yv[i] * beta);
            KtT[d * 64 + (((sp >> 3) ^ ((d >> 1) & 7)) << 3) + (sp & 7)] = (bf16)f2bf(yk[i] * eT);
        }
        bf16* qd = (bf16*)(gop + GOP_QD) + tok * 128 + 4 * (part & 1);
#pragma unroll
        for (int q4 = 0; q4 < 4; ++q4) { v2u o; o.x = pk2(yq[4 * q4] * eG, yq[4 * q4 + 1] * eG); o.y = pk2(yq[4 * q4 + 2] * eG, yq[4 * q4 + 3] * eG); *(GAS v2u*)(qd + (((4 * (part >> 1) + q4) ^ (tok & 15)) << 3)) = o; }
    }
    __syncthreads();
    }
    const int c16 = lane & 15, q4 = lane >> 4;
#ifndef PREP_REP_B
#define PREP_REP_B 1
#endif
#pragma unroll 1
    for (int rb_ = 0; rb_ < PREP_REP_B; ++rb_)
#pragma unroll 1
    for (int jj = 0; jj < 4; ++jj) {
        const int J = wave * 4 + jj, isqk = J >> 4, tm = (J >> 2) & 3, tn = J & 3;
        if (tn < tm) { if (isqk) { const int i = 16 * tn + c16; *(GAS v2u*)((bf16*)(gop + GOP_AI) + i * 64 + (((4 * (tm >> 1) + q4) ^ ((i >> 1) & 7)) << 3) + 4 * (tm & 1)) = ({ v2u z_ = {0u, 0u}; asm volatile("" : "+v"(z_)); z_; }); }        continue; }
        f32x4 acc = {0.f, 0.f, 0.f, 0.f};
        const LAS bf16* ap = Kr + (16 * tm + c16) * 136 + 8 * q4;
        const LAS bf16* bp = (isqk ? Qr : Kr) + (16 * tn + c16) * 136 + 8 * q4;
#pragma unroll
        for (int ks = 0; ks < 4; ++ks) acc = mfma16(*(const LAS bf16x8*)(ap + 32 * ks), *(const LAS bf16x8*)(bp + 32 * ks), acc);
        const int i = 16 * tn + c16, j0 = 16 * tm + 4 * q4;
        const float Gi = Gs[i], bi = Gs[64 + i];
        float r[4];
#pragma unroll
        for (int k = 0; k < 4; ++k) { const int j = j0 + k; const float dec = __expf(fminf(Gi - Gs[j], 0.f)); r[k] = acc[k] * dec; }
        if (!isqk) {
#pragma unroll
            for (int k = 0; k < 4; ++k) r[k] = (j0 + k < i) ? r[k] * bi : 0.f;
            *(LAS f32x4*)(Lm + i * 68 + j0) = (f32x4){r[0], r[1], r[2], r[3]};
        } else {
#pragma unroll
            for (int k = 0; k < 4; ++k) r[k] = (j0 + k <= i) ? r[k] : 0.f;
            v2u o; o.x = pk2(r[0], r[1]); o.y = pk2(r[2], r[3]);
            *(GAS v2u*)((bf16*)(gop + GOP_AI) + i * 64 + (((4 * (tm >> 1) + q4) ^ ((i >> 1) & 7)) << 3) + 4 * (tm & 1)) = o;
        }
    }
    __syncthreads();
#ifndef PREP_REP_C
#define PREP_REP_C 1
#endif
    LAS float* Xf = (LAS float*)(lds + MISC_OFF + 1024);
#define GI_XB(I_, J_) (Xf + (((I_) * ((I_) + 1)) / 2 + (J_)) * 272)
#pragma unroll 1
    for (int rc_ = 0; rc_ < PREP_REP_C; ++rc_) {
    if (wave < 4) {
        for (int e = lane; e < 16 * 16 * (3 - wave); e += 64) { const int r = e / (16 * (3 - wave)), c = e % (16 * (3 - wave)); Ainv[(16 * wave + r) * 72 + 16 * (wave + 1) + c] = (bf16)f2bf(0.f); }
        float ap[4];
#pragma unroll
        for (int j4 = 0; j4 < 4; ++j4) ap[j4] = 0.f;
        const int col = lane >> 2, p = lane & 3;
        const float colf = (float)col;
        const LAS float* Ld = Lm + (16 * wave) * 68 + 16 * wave + p;
        LAS float* Xd = GI_XB(wave, wave);
#pragma unroll
        for (int i = 0; i < 16; ++i) {
            float s = 0.f;
#pragma unroll
            for (int j4 = 0; j4 < (i + 3) / 4; ++j4) s += Ld[i * 68 + 4 * j4] * ap[j4];
            s += __builtin_bit_cast(float, __builtin_amdgcn_mov_dpp(__builtin_bit_cast(int, s), 0xB1, 0xF, 0xF, true));
            s += __builtin_bit_cast(float, __builtin_amdgcn_mov_dpp(__builtin_bit_cast(int, s), 0x4E, 0xF, 0xF, true));
            const float v = fmaxf(0.f, 1.f - fabsf(colf - (float)i)) - s;
            ap[i >> 2] = (p == (i & 3)) ? v : ap[i >> 2];
            if (p == 0) { Xd[i * 17 + col] = v; Ainv[(16 * wave + i) * 72 + 16 * wave + col] = (bf16)f2bf(v); }
        }
    } else {
        for (int ch = tid - 256; ch < 1024; ch += 256) *(GAS v4u*)(gop + GOP_KT + ch * 16) = *(const LAS v4u*)(lds + GP_KTT + ch * 16);
    }
    __syncthreads();
#pragma unroll
    for (int lev = 1; lev < 4; ++lev) {
        if (wave < 4 - lev) {
            const int J = wave, I = wave + lev, c16_ = lane & 15, g4 = lane >> 4;
            LAS float* Tm = Xf + (10 + wave) * 272;
            f32x4 sacc = {0.f, 0.f, 0.f, 0.f};
#pragma unroll
            for (int dk = 0; dk < lev; ++dk) { const int K = J + dk;
                const LAS float* La = Lm + (16 * I + c16_) * 68 + 16 * K + g4; const LAS float* Xb = GI_XB(K, J) + g4 * 17 + c16_;
#pragma unroll
                for (int kk = 0; kk < 4; ++kk) sacc = __builtin_amdgcn_mfma_f32_16x16x4f32(La[4 * kk], Xb[4 * kk * 17], sacc, 0, 0, 0); }
#pragma unroll
            for (int r = 0; r < 4; ++r) Tm[(4 * g4 + r) * 17 + c16_] = sacc[r];
            f32x4 xacc = {0.f, 0.f, 0.f, 0.f};
            { const LAS float* Xa = GI_XB(I, I) + c16_ * 17 + g4; const LAS float* Tb = Tm + g4 * 17 + c16_;
#pragma unroll
              for (int kk = 0; kk < 4; ++kk) xacc = __builtin_amdgcn_mfma_f32_16x16x4f32(Xa[4 * kk], Tb[4 * kk * 17], xacc, 0, 0, 0); }
            LAS float* Xo = GI_XB(I, J);
#pragma unroll
            for (int r = 0; r < 4; ++r) { const float v = -xacc[r]; Xo[(4 * g4 + r) * 17 + c16_] = v; Ainv[(16 * I + 4 * g4 + r) * 72 + 16 * J + c16_] = (bf16)f2bf(v); }
        }
        __syncthreads();
    }
    }
#undef GI_XB
#ifndef PREP_REP_D
#define PREP_REP_D 1
#endif
#pragma unroll 1
    for (int rd_ = 0; rd_ < PREP_REP_D; ++rd_)
#pragma unroll 1
    for (int jj = 0; jj < 8; ++jj) {
        const int J = wave * 8 + jj;
        f32x4 acc = {0.f, 0.f, 0.f, 0.f};
        if (J < 32) {
            const int tm = J >> 3, tn = J & 7;
            const LAS bf16* ap = Ainv + (16 * tm + c16) * 72 + 8 * q4; const LAS bf16* bp = VbT + (16 * tn + c16) * 72 + 8 * q4;
#pragma unroll
            for (int ks = 0; ks < 2; ++ks) acc = mfma16(*(const LAS bf16x8*)(ap + 32 * ks), *(const LAS bf16x8*)(bp + 32 * ks), acc);
            *(GAS f32x4*)((float*)(gop + GOP_UT) + (16 * tn + c16) * 64 + 16 * tm + 4 * q4) = acc;
        } else {
            const int Jw = J - 32, tm = Jw >> 2, tn = Jw & 3;
            const LAS bf16* ap = KbgT + (16 * tm + c16) * 72 + 8 * q4; const LAS bf16* bp = Ainv + (16 * tn + c16) * 72 + 8 * q4;
#pragma unroll
            for (int ks = 0; ks < 2; ++ks) acc = mfma16(*(const LAS bf16x8*)(ap + 32 * ks), *(const LAS bf16x8*)(bp + 32 * ks), acc);
            v2u o; o.x = pk2(-acc[0], -acc[1]); o.y = pk2(-acc[2], -acc[3]);
            *(GAS v2u*)((bf16*)(gop + GOP_W) + (16 * tn + c16) * 128 + (((4 * (tm >> 1) + q4) ^ c16) << 3) + 4 * (tm & 1)) = o;
        }
    }
    __syncthreads();
}

__device__ __forceinline__ bf16x8 pack_b(const f32x4& lo, const f32x4& hi) {
    v4u w; w.x = attn_body::cvtpk_s(lo[0], lo[1]); w.y = attn_body::cvtpk_s(lo[2], lo[3]); w.z = attn_body::cvtpk_s(hi[0], hi[1]); w.w = attn_body::cvtpk_s(hi[2], hi[3]);
    return __builtin_bit_cast(bf16x8, w);
}
__device__ __forceinline__ void gdn_step(int n, LAS unsigned char* lds, const unsigned char* gop0, float glv0, float glv1, float* gout, int tid, int cw, bool active, int c16, int q4,
                                         f32x4 (&S)[8], v4u (&P)[7], v4u (&Q)[7], f32x4 (&U)[4]) {
    LAS unsigned char* cur = lds + (n & 1) * GOP_LDS;
    const int n2 = (n + 2 < NCHUNK) ? n + 2 : NCHUNK - 1;
    const unsigned char* g2 = gop0 + (size_t)n2 * GOP_BYTES;
#pragma unroll
    for (int i = 0; i < 7; ++i) Q[i] = *(const GAS v4u*)(g2 + (size_t)(tid + 512 * i) * 16);
    f32x4 vn[4];
#pragma unroll
    for (int mt = 0; mt < 4; ++mt) vn[mt] = U[mt];
#pragma unroll
    for (int mt = 0; mt < 4; ++mt) U[mt] = *(const GAS f32x4*)((const float*)(g2 + GOP_UT) + (16 * cw + c16) * 64 + 16 * mt + 4 * q4);
    const float glast = __builtin_bit_cast(float, __builtin_amdgcn_readlane(__builtin_bit_cast(int, (n & 64) ? glv1 : glv0), n & 63));
    asm volatile("" ::: "memory");
    if (active) {
    bf16x8 bS[4];
#pragma unroll
    for (int s = 0; s < 4; ++s) bS[s] = pack_b(S[2 * s], S[2 * s + 1]);
    const LAS bf16* Wn = (const LAS bf16*)(cur + GOP_W) + c16 * 128;
    const LAS bf16* QD = (const LAS bf16*)(cur + GOP_QD) + c16 * 128;
    const LAS bf16* KT = (const LAS bf16*)(cur + GOP_KT) + c16 * 64;
    const LAS bf16* AI = (const LAS bf16*)(cur + GOP_AI) + c16 * 64;
    const int hc = c16 >> 1;
    f32x4 o[4];
#pragma unroll
    for (int mt = 0; mt < 4; ++mt) o[mt] = (f32x4){0.f, 0.f, 0.f, 0.f};
#define GD_SB() __builtin_amdgcn_sched_barrier(0)
#define GD_W(mt, s_) (*(const LAS bf16x8*)(Wn + (mt) * 16 * 128 + (((4 * (s_) + q4) ^ c16) << 3)))
#define GD_Q(mt, s_) (*(const LAS bf16x8*)(QD + (mt) * 16 * 128 + (((4 * (s_) + q4) ^ c16) << 3)))
#define GD_A(mt, s2) (*(const LAS bf16x8*)(AI + (mt) * 16 * 64 + (((4 * (s2) + q4) ^ hc) << 3)))
#define GD_K(i_, s2) (*(const LAS bf16x8*)(KT + (i_) * 16 * 64 + (((4 * (s2) + q4) ^ hc) << 3)))
    bf16x8 fa[4], fb[4];
#define GD_LDW(f, g) _Pragma("unroll") for (int j = 0; j < 4; ++j) f[j] = GD_W(2 * ((g) >> 1) + (j & 1), 2 * ((g) & 1) + (j >> 1))
#define GD_LDQ(f, g) _Pragma("unroll") for (int j = 0; j < 4; ++j) f[j] = GD_Q(2 * ((g) >> 1) + (j & 1), 2 * ((g) & 1) + (j >> 1))
#define GD_MMV(f, g) _Pragma("unroll") for (int j = 0; j < 4; ++j) vn[2 * ((g) >> 1) + (j & 1)] = mfma16(f[j], bS[2 * ((g) & 1) + (j >> 1)], vn[2 * ((g) >> 1) + (j & 1)])
#define GD_MMO(f, g) _Pragma("unroll") for (int j = 0; j < 4; ++j) o[2 * ((g) >> 1) + (j & 1)] = mfma16(f[j], bS[2 * ((g) & 1) + (j >> 1)], o[2 * ((g) >> 1) + (j & 1)])
    GD_LDW(fa, 0); GD_SB();
    GD_LDW(fb, 1); GD_MMV(fa, 0); GD_SB();
    GD_LDW(fa, 2); GD_MMV(fb, 1); GD_SB();
    GD_LDW(fb, 3); GD_MMV(fa, 2); GD_SB();
    GD_LDQ(fa, 0); GD_MMV(fb, 3); GD_SB();
    GD_LDQ(fb, 1); GD_MMO(fa, 0); GD_SB();
    GD_LDQ(fa, 2); GD_MMO(fb, 1); GD_SB();
    GD_LDQ(fb, 3); GD_MMO(fa, 2); GD_SB();
    fa[0] = GD_A(0, 0); fa[1] = GD_A(1, 0); fa[2] = GD_A(2, 0); fa[3] = GD_A(3, 0);
    GD_MMO(fb, 3);
    bf16x8 bV[2];
    bV[0] = pack_b(vn[0], vn[1]); bV[1] = pack_b(vn[2], vn[3]);
#pragma unroll
    for (int i = 0; i < 8; ++i) S[i] = S[i] * glast;
    GD_SB();
    fb[0] = GD_A(2, 1); fb[1] = GD_A(3, 1); fb[2] = GD_K(0, 0); fb[3] = GD_K(1, 0);
    o[0] = mfma16(fa[0], bV[0], o[0]); o[1] = mfma16(fa[1], bV[0], o[1]); o[2] = mfma16(fa[2], bV[0], o[2]); o[3] = mfma16(fa[3], bV[0], o[3]);
    GD_SB();
    fa[0] = GD_K(0, 1); fa[1] = GD_K(1, 1); fa[2] = GD_K(2, 0); fa[3] = GD_K(3, 0);
    o[2] = mfma16(fb[0], bV[1], o[2]); o[3] = mfma16(fb[1], bV[1], o[3]); S[0] = mfma16(fb[2], bV[0], S[0]); S[1] = mfma16(fb[3], bV[0], S[1]);
    GD_SB();
    fb[0] = GD_K(2, 1); fb[1] = GD_K(3, 1); fb[2] = GD_K(4, 0); fb[3] = GD_K(5, 0);
    S[0] = mfma16(fa[0], bV[1], S[0]); S[1] = mfma16(fa[1], bV[1], S[1]); S[2] = mfma16(fa[2], bV[0], S[2]); S[3] = mfma16(fa[3], bV[0], S[3]);
    GD_SB();
    fa[0] = GD_K(4, 1); fa[1] = GD_K(5, 1); fa[2] = GD_K(6, 0); fa[3] = GD_K(7, 0);
    S[2] = mfma16(fb[0], bV[1], S[2]); S[3] = mfma16(fb[1], bV[1], S[3]); S[4] = mfma16(fb[2], bV[0], S[4]); S[5] = mfma16(fb[3], bV[0], S[5]);
    GD_SB();
    fb[0] = GD_K(6, 1); fb[1] = GD_K(7, 1);
    S[4] = mfma16(fa[0], bV[1], S[4]); S[5] = mfma16(fa[1], bV[1], S[5]); S[6] = mfma16(fa[2], bV[0], S[6]); S[7] = mfma16(fa[3], bV[0], S[7]);
    GD_SB();
    S[6] = mfma16(fb[0], bV[1], S[6]); S[7] = mfma16(fb[1], bV[1], S[7]);
    GD_SB();
#undef GD_LDW
#undef GD_LDQ
#undef GD_MMV
#undef GD_MMO
#undef GD_SB
#undef GD_W
#undef GD_Q
#undef GD_A
#undef GD_K
    GAS float* go = (GAS float*)gout + (size_t)(n * GCH) * 512;
#pragma unroll
    for (int mt = 0; mt < 4; ++mt)
#pragma unroll
        for (int r = 0; r < 4; ++r) go[(size_t)(16 * mt + 4 * q4 + r) * 512] = o[mt][r];
    }
    if (n + 1 < NCHUNK) { LAS unsigned char* nxt = lds + ((n + 1) & 1) * GOP_LDS;
#pragma unroll
        for (int i = 0; i < 7; ++i) *(LAS v4u*)(nxt + (tid + 512 * i) * 16) = P[i]; }
    __syncthreads();
}

__device__ __forceinline__ void gdn_scan(const KA& A, LAS unsigned char* lds, int unit, int tid, int wave, int lane) {
#ifndef SCAN_SPLIT
#define SCAN_SPLIT 2
#endif
    constexpr int CWW = 8 / SCAN_SPLIT;
    const int bh = unit / SCAN_SPLIT, cw = (unit % SCAN_SPLIT) * CWW + (wave % CWW); const bool active = wave < CWW;
    unsigned char* ws = A.ws;
    const int b = bh >> 2, h = bh & 3;
    const int c16 = lane & 15, q4 = lane >> 4;
    const unsigned char* gop0 = ws + WS_GOP + (size_t)(bh * NCHUNK) * GOP_BYTES;
    const float* gl = (const float*)(ws + WS_GL) + (size_t)bh * NCHUNK * 32;
    float* gout = (float*)(ws + WS_GOUT) + (size_t)(b * SEQ) * 512 + h * 128 + 16 * cw + c16;
    const float glv0 = gl[lane * 32], glv1 = gl[(64 + lane) * 32];
    f32x4 S[8];
#pragma unroll
    for (int i = 0; i < 8; ++i) S[i] = (f32x4){0.f, 0.f, 0.f, 0.f};
    v4u stA[7], stB[7]; f32x4 uE[4], uO[4];
#pragma unroll
    for (int i = 0; i < 7; ++i) stB[i] = *(const GAS v4u*)(gop0 + (size_t)(tid + 512 * i) * 16);
#pragma unroll
    for (int i = 0; i < 7; ++i) stA[i] = *(const GAS v4u*)(gop0 + GOP_BYTES + (size_t)(tid + 512 * i) * 16);
#pragma unroll
    for (int mt = 0; mt < 4; ++mt) { uE[mt] = *(const GAS f32x4*)((const float*)(gop0 + GOP_UT) + (16 * cw + c16) * 64 + 16 * mt + 4 * q4);
                                     uO[mt] = *(const GAS f32x4*)((const float*)(gop0 + GOP_BYTES + GOP_UT) + (16 * cw + c16) * 64 + 16 * mt + 4 * q4); }
#pragma unroll
    for (int i = 0; i < 7; ++i) *(LAS v4u*)(lds + (tid + 512 * i) * 16) = stB[i];
    __syncthreads();
#pragma unroll 1
    for (int n = 0; n < NCHUNK; n += 2) {
        gdn_step(n, lds, gop0, glv0, glv1, gout, tid, cw, active, c16, q4, S, stA, stB, uE);
        gdn_step(n + 1, lds, gop0, glv0, glv1, gout, tid, cw, active, c16, q4, S, stB, stA, uO);
    }
}
__device__ __forceinline__ void mixer_post(const KA& A, int gw, int NGW, int lane) {
    unsigned char* ws = A.ws;
    float lam;
    { float a = A.in(I_LQ1)[lane] * A.in(I_LK1)[lane], c = A.in(I_LQ2)[lane] * A.in(I_LK2)[lane]; a = wave_sum(a); c = wave_sum(c); lam = __expf(a) - __expf(c) + LAMBDA_INIT; }
    const int col = lane * 8, hd = lane >> 4, dvi = (lane & 15) * 8;
    f32x4 gw0 = *(const f32x4*)(A.in(I_GNW) + dvi), gw1 = *(const f32x4*)(A.in(I_GNW) + dvi + 4);
    f32x4 dw0 = *(const f32x4*)(A.in(I_DNW) + dvi), dw1 = *(const f32x4*)(A.in(I_DNW) + dvi + 4);
    for (int m = gw; m < NTOK; m += NGW) {
        const float* go = (const float*)(ws + WS_GOUT) + (size_t)m * 512 + col;
        const f32x4 a0 = *(const GAS f32x4*)go, a1 = *(const GAS f32x4*)(go + 4);
        float ss = a0.x * a0.x + a0.y * a0.y + a0.z * a0.z + a0.w * a0.w + a1.x * a1.x + a1.y * a1.y + a1.z * a1.z + a1.w * a1.w;
        ss += __shfl_xor(ss, 1); ss += __shfl_xor(ss, 2); ss += __shfl_xor(ss, 4); ss += __shfl_xor(ss, 8);
        const float rs = rsqrtf(ss * (1.0f / 128.0f) + RMS_EPS);
        const v4u z = *(const GAS v4u*)((const bf16*)(ws + WS_GZ) + (size_t)m * 512 + col);
        float zz[8] = {bflo(z.x), bfhi(z.x), bflo(z.y), bfhi(z.y), bflo(z.z), bfhi(z.z), bflo(z.w), bfhi(z.w)};
        float ov[8] = {a0.x * gw0.x, a0.y * gw0.y, a0.z * gw0.z, a0.w * gw0.w, a1.x * gw1.x, a1.y * gw1.y, a1.z * gw1.z, a1.w * gw1.w};
#pragma unroll
        for (int i = 0; i < 8; ++i) ov[i] = ov[i] * rs * (zz[i] * sigmoidf_(zz[i]));
        v4u o; o.x = pk2(ov[0], ov[1]); o.y = pk2(ov[2], ov[3]); o.z = pk2(ov[4], ov[5]); o.w = pk2(ov[6], ov[7]);
        *(GAS v4u*)((bf16*)(ws + WS_OA) + (size_t)m * 1024 + col) = o;
        const int vh = dvi >> 6, dd = dvi & 63;
        const bf16* o16 = (const bf16*)(ws + WS_O16) + (size_t)m * 1024 + (hd * 4 + vh) * 64 + dd;
        const v4u p1 = *(const GAS v4u*)o16, p2 = *(const GAS v4u*)(o16 + 128);
        float d[8] = {bflo(p1.x) - lam * bflo(p2.x), bfhi(p1.x) - lam * bfhi(p2.x), bflo(p1.y) - lam * bflo(p2.y), bfhi(p1.y) - lam * bfhi(p2.y),
                      bflo(p1.z) - lam * bflo(p2.z), bfhi(p1.z) - lam * bfhi(p2.z), bflo(p1.w) - lam * bflo(p2.w), bfhi(p1.w) - lam * bfhi(p2.w)};
        float s2 = 0.f;
#pragma unroll
        for (int i = 0; i < 8; ++i) s2 += d[i] * d[i];
        s2 += __shfl_xor(s2, 1); s2 += __shfl_xor(s2, 2); s2 += __shfl_xor(s2, 4); s2 += __shfl_xor(s2, 8);
        const float r2 = rsqrtf(s2 * (1.0f / 128.0f) + RMS_EPS) * (1.0f - LAMBDA_INIT);
        const float dwv[8] = {dw0.x, dw0.y, dw0.z, dw0.w, dw1.x, dw1.y, dw1.z, dw1.w};
#pragma unroll
        for (int i = 0; i < 8; ++i) d[i] = d[i] * r2 * dwv[i];
        o.x = pk2(d[0], d[1]); o.y = pk2(d[2], d[3]); o.z = pk2(d[4], d[5]); o.w = pk2(d[6], d[7]);
        *(GAS v4u*)((bf16*)(ws + WS_OA) + (size_t)m * 1024 + 512 + col) = o;
    }
}

__device__ __forceinline__ void ln_pass(const float* v, const float* g, const float* bb, float* xf, bf16* xb, int gw, int NGW, int lane) {
    f32x4 gg[4], be[4];
#pragma unroll
    for (int j = 0; j < 4; ++j) { gg[j] = *(const f32x4*)(g + 4 * lane + 256 * j); be[j] = *(const f32x4*)(bb + 4 * lane + 256 * j); }
    for (int m = gw; m < NTOK; m += NGW) {
        const GAS f32x4* xr = (const GAS f32x4*)(v + (size_t)m * 1024) + lane;
        f32x4 x[4]; float s = 0.f;
#pragma unroll
        for (int j = 0; j < 4; ++j) { x[j] = xr[64 * j]; s += (x[j].x + x[j].y) + (x[j].z + x[j].w); }
        const float mean = wave_sum(s) * (1.f / 1024.f); float s2 = 0.f;
#pragma unroll
        for (int j = 0; j < 4; ++j) { x[j] = x[j] - mean; s2 += (x[j].x * x[j].x + x[j].y * x[j].y) + (x[j].z * x[j].z + x[j].w * x[j].w); }
        const float rstd = rsqrtf(wave_sum(s2) * (1.f / 1024.f) + LN_EPS);
#pragma unroll
        for (int j = 0; j < 4; ++j) {
            const f32x4 y = x[j] * rstd * gg[j] + be[j];
            if (xf) *((GAS f32x4*)(xf + (size_t)m * 1024) + lane + 64 * j) = y;
            if (xb) { v2u o; o.x = pk2(y.x, y.y); o.y = pk2(y.z, y.w); *((GAS v2u*)(xb + (size_t)m * 1024) + lane + 64 * j) = o; }
        }
    }
}

__device__ __forceinline__ void ln_pass_b(const bf16* v, const float* g, const float* bb, bf16* xb, int gw, int NGW, int lane) {
    f32x4 gg[4], be[4];
#pragma unroll
    for (int j = 0; j < 4; ++j) { gg[j] = *(const f32x4*)(g + 4 * lane + 256 * j); be[j] = *(const f32x4*)(bb + 4 * lane + 256 * j); }
    for (int m = gw; m < NTOK; m += NGW) {
        f32x4 x[4]; float s = 0.f;
#pragma unroll
        for (int j = 0; j < 4; ++j) { const v2u w = *((const GAS v2u*)(v + (size_t)m * 1024) + lane + 64 * j); x[j] = (f32x4){bflo(w.x), bfhi(w.x), bflo(w.y), bfhi(w.y)}; s += (x[j].x + x[j].y) + (x[j].z + x[j].w); }
        const float mean = wave_sum(s) * (1.f / 1024.f); float s2 = 0.f;
#pragma unroll
        for (int j = 0; j < 4; ++j) { x[j] = x[j] - mean; s2 += (x[j].x * x[j].x + x[j].y * x[j].y) + (x[j].z * x[j].z + x[j].w * x[j].w); }
        const float rstd = rsqrtf(wave_sum(s2) * (1.f / 1024.f) + LN_EPS);
#pragma unroll
        for (int j = 0; j < 4; ++j) { const f32x4 y = x[j] * rstd * gg[j] + be[j]; v2u o; o.x = pk2(y.x, y.y); o.y = pk2(y.z, y.w); *((GAS v2u*)(xb + (size_t)m * 1024) + lane + 64 * j) = o; }
    }
}

__device__ __forceinline__ void moe_route(const KA& A, LAS unsigned char* lds, int gw, int NGW, int tid, int lane, const float* v1) {
    unsigned char* ws = A.ws;
    LAS float* rw = (LAS float*)lds;
    LAS unsigned* hist = (LAS unsigned*)(lds + MISC_OFF);
    LAS float* lgb = (LAS float*)(lds + MISC_OFF + 2048);
    { const float* src = A.in(I_RW);
      for (int i = tid; i < 1024 * 32 / 4; i += 512) { const int k = i >> 3, c = i & 7, rho = (k >> 2) + 256 * (k & 3); *(LAS f32x4*)(rw + rho * 32 + ((c ^ ((rho >> 1) & 7)) << 2)) = *((const f32x4*)src + i); }
      const float* lng = A.in(I_LN2G); const float* lnb = A.in(I_LN2B);
      for (int i = tid; i < 256; i += 512) { *((LAS f32x4*)lgb + i) = *((const f32x4*)lng + i); *((LAS f32x4*)(lgb + 1024) + i) = *((const f32x4*)lnb + i); } }
    __syncthreads();
    const float rbias = A.in(I_RB)[lane & 31];
    const int wv = tid >> 6, sw = (lane >> 1) & 7;
    const LAS float* pc[2][8];
#pragma unroll
    for (int hcc = 0; hcc < 2; ++hcc)
#pragma unroll
        for (int c = 0; c < 8; ++c) { unsigned a = (unsigned)(uintptr_t)(rw + (lane + 512 * hcc) * 32 + ((c ^ sw) << 2)); asm volatile("" : "+v"(a)); pc[hcc][c] = (const LAS float*)(uintptr_t)a; }
    for (int grp = gw / NWAVES; grp < NTOK / 64; grp += NGW / NWAVES) {
    if (tid < 32) hist[tid] = 0u;
    __syncthreads();
#pragma unroll 1
    for (int pr = 0; pr < 4; ++pr) {
        const int m0 = grp * 64 + wv * 8 + pr * 2;
        typedef float f32x2r __attribute__((ext_vector_type(2)));
        f32x4 y[2][4];
#pragma unroll
        for (int t2 = 0; t2 < 2; ++t2) {
            const GAS v2u* xr = (const GAS v2u*)((const bf16*)v1 + (size_t)(m0 + t2) * 1024) + lane;
            float s = 0.f;
#pragma unroll
            for (int j = 0; j < 4; ++j) { const v2u w = xr[64 * j]; y[t2][j] = (f32x4){bflo(w.x), bfhi(w.x), bflo(w.y), bfhi(w.y)}; s += (y[t2][j].x + y[t2][j].y) + (y[t2][j].z + y[t2][j].w); }
            const float mean = wave_sum(s) * (1.f / 1024.f); float s2 = 0.f;
#pragma unroll
            for (int j = 0; j < 4; ++j) { y[t2][j] = y[t2][j] - mean; s2 += (y[t2][j].x * y[t2][j].x + y[t2][j].y * y[t2][j].y) + (y[t2][j].z * y[t2][j].z + y[t2][j].w * y[t2][j].w); }
            const float rstd = rsqrtf(wave_sum(s2) * (1.f / 1024.f) + LN_EPS);
#pragma unroll
            for (int j = 0; j < 4; ++j) { y[t2][j] = y[t2][j] * rstd * *((const LAS f32x4*)lgb + lane + 64 * j) + *((const LAS f32x4*)(lgb + 1024) + lane + 64 * j);
                v2u o; o.x = pk2(y[t2][j].x, y[t2][j].y); o.y = pk2(y[t2][j].z, y[t2][j].w); *((GAS v2u*)((bf16*)(ws + WS_X2B) + (size_t)(m0 + t2) * 1024) + lane + 64 * j) = o; }
        }
        f32x2r ac2[32];
#pragma unroll
        for (int e = 0; e < 32; ++e) ac2[e] = (f32x2r){0.f, 0.f};
#pragma unroll
        for (int j = 0; j < 4; ++j) {
#pragma unroll
            for (int cc = 0; cc < 4; ++cc) {
                const f32x2r xv = {y[0][j][cc], y[1][j][cc]};
#pragma unroll
                for (int c = 0; c < 8; ++c) { const f32x4 w = *(const LAS f32x4*)(pc[cc >> 1][c] + (64 * j + 256 * (cc & 1)) * 32);
                    ac2[4 * c] += xv * w.x; ac2[4 * c + 1] += xv * w.y; ac2[4 * c + 2] += xv * w.z; ac2[4 * c + 3] += xv * w.w; }
                asm volatile("" ::: "memory");
            }
        }
        float acc[2][32];
#pragma unroll
        for (int e = 0; e < 32; ++e) { acc[0][e] = ac2[e].x; acc[1][e] = ac2[e].y; }
#pragma unroll
        for (int t2 = 0; t2 < 2; ++t2) {
            const int m = m0 + t2;
#pragma unroll
            for (int w = 16; w >= 1; w >>= 1) {
                const bool up = (lane & w) != 0;
#pragma unroll
                for (int i = 0; i < w; ++i) { const float send = up ? acc[t2][i] : acc[t2][i + w]; const float keep = up ? acc[t2][i + w] : acc[t2][i]; acc[t2][i] = keep + __shfl_xor(send, w); }
            }
            float mine = acc[t2][0] + __shfl_xor(acc[t2][0], 32);
            mine += rbias;
            float tv[4]; int ti[4];
            float cur = mine;
#pragma unroll
            for (int k = 0; k < 4; ++k) {
                float best = cur; int bi = lane & 31;
#pragma unroll
                for (int o = 1; o < 32; o <<= 1) { const float ov = __shfl_xor(best, o); const int oi = __shfl_xor(bi, o); if (ov > best || (ov == best && oi < bi)) { best = ov; bi = oi; } }
                tv[k] = best; ti[k] = bi;
                if ((lane & 31) == bi) cur = -INFINITY;
            }
            const float e1 = __expf(tv[1] - tv[0]), e2 = __expf(tv[2] - tv[0]), e3 = __expf(tv[3] - tv[0]);
            const float inv = 1.0f / (1.0f + e1 + e2 + e3);
            if (lane == 0) {
                *(GAS v4u*)((int*)(ws + WS_TOPI) + (size_t)m * 4) = (v4u){(unsigned)ti[0], (unsigned)ti[1], (unsigned)ti[2], (unsigned)ti[3]};
                *(GAS f32x4*)((float*)(ws + WS_GATE) + (size_t)m * 4) = (f32x4){inv, e1 * inv, e2 * inv, e3 * inv};
                for (int k = 0; k < 4; ++k) __hip_atomic_fetch_add(&hist[ti[k]], 1u, __ATOMIC_RELAXED, __HIP_MEMORY_SCOPE_WORKGROUP);
            }
        }
    }
    __syncthreads();
    if (tid < 32) { ((unsigned*)(ws + WS_GCNT))[grp * 32 + tid] = hist[tid]; if (hist[tid]) atomicAdd((unsigned*)(ws + WS_CTL) + CW_CNT + tid, hist[tid]); }
    __syncthreads();
    }
}

__device__ __forceinline__ void moe_layout(const KA& A, LAS unsigned char* lds, int tid) {
    LAS int* T = (LAS int*)(lds + MISC_OFF + 256);
    LAS int* C32 = (LAS int*)(lds + MISC_OFF);
    if (tid < 32) C32[tid] = (int)__hip_atomic_load((const unsigned*)(A.ws + WS_CTL) + CW_CNT + tid, __ATOMIC_RELAXED, __HIP_MEMORY_SCOPE_AGENT);
    __syncthreads();
    if (tid == 0) {
        int row = 0;
        for (int e = 0; e < 32; ++e) {
            const int c = C32[e]; const int nt = (c + 255) >> 8;
            T[e] = row; for (int t = 0; t < nt; ++t) T[64 + (row >> 8) + t] = e; row += nt * 256;
        }
        T[32] = row >> 8;
    }
    __syncthreads();
}

__device__ __forceinline__ void moe_scatter(const KA& A, LAS unsigned char* lds, int blk, int G, int tid, int wave, int lane) {
    unsigned char* ws = A.ws;
    LAS int* T = (LAS int*)(lds + MISC_OFF + 256);
    LAS unsigned* lc = (LAS unsigned*)(lds);
    const float* x2 = A.out();
    if (blk < NEXP) {
        const int c = (int)__hip_atomic_load((const unsigned*)(ws + WS_CTL) + CW_CNT + blk, __ATOMIC_RELAXED, __HIP_MEMORY_SCOPE_AGENT);
        for (int i = T[blk] + c + tid; i < T[blk] + ((c + 255) & ~255); i += 512) ((int*)(ws + WS_TOKTAB))[i] = 0;
    }
    for (int grp = blk; grp < NTOK / 64; grp += G) {
        int e = 0;
        if (tid < 256) { e = ((const int*)(ws + WS_TOPI))[(size_t)grp * 256 + tid]; lc[320 + tid] = (unsigned)e; }
        { unsigned b = 0; const unsigned* gc = (const unsigned*)(ws + WS_GCNT) + (tid & 31);
#pragma unroll
          for (int q = 0; q < 16; ++q) { const int g2 = (tid >> 5) + 16 * q; b += (g2 < grp) ? gc[g2 * 32] : 0u; }
          lc[576 + tid] = b; }
        __syncthreads();
        if (tid < 32) { unsigned b = 0;
#pragma unroll
            for (int p = 0; p < 16; ++p) b += lc[576 + p * 32 + tid]; lc[32 + tid] = b; }
        __syncthreads();
        if (tid < 256) { unsigned rank = 0; for (int a2 = 0; a2 < tid; ++a2) rank += (lc[320 + a2] == (unsigned)e) ? 1u : 0u;
            const int slot = T[e] + (int)lc[32 + e] + (int)rank; lc[64 + tid] = (unsigned)slot; ((int*)(ws + WS_DEST))[(size_t)grp * 256 + tid] = slot;
            ((int*)(ws + WS_TOKTAB))[slot] = grp * 64 + (tid >> 2); }
        __syncthreads();
        __syncthreads();
    }
}

__device__ __forceinline__ void moe_route_mfma(const KA& A, LAS unsigned char* lds, int gw, int NGW, int tid, int lane, const float* v1) {
    unsigned char* ws = A.ws;
    LAS unsigned* hist = (LAS unsigned*)(lds + MISC_OFF);
    LAS float* lgb = (LAS float*)(lds + MISC_OFF + 2048);
    const int wv = __builtin_amdgcn_readfirstlane(tid >> 6);
    { const float* src = A.in(I_RW);
      for (int it = tid; it < 1024; it += 512) {
          const int sk = it >> 3, eq = it & 7, s = sk >> 2, kg = sk & 3;
          f32x4 v[8];
#pragma unroll
          for (int t = 0; t < 8; ++t) v[t] = *(const f32x4*)(src + (size_t)(8 * sk + t) * 32 + 4 * eq);
#pragma unroll
          for (int c = 0; c < 4; ++c) { const int e = 4 * eq + c, mb = e >> 4, i = e & 15;
              unsigned h[4], l[4];
#pragma unroll
              for (int p2 = 0; p2 < 4; ++p2) { const float x0 = v[2 * p2][c], x1 = v[2 * p2 + 1][c]; h[p2] = pk2(x0, x1); l[p2] = pk2(x0 - bflo(h[p2]), x1 - bfhi(h[p2])); }
              LAS unsigned char* d = lds + (size_t)((s * 2 + mb) * 2) * 1024 + (kg * 16 + i) * 16;
              *(LAS v4u*)d = (v4u){h[0], h[1], h[2], h[3]}; *(LAS v4u*)(d + 1024) = (v4u){l[0], l[1], l[2], l[3]}; } }
      const float* lng = A.in(I_LN2G); const float* lnb = A.in(I_LN2B);
      for (int i = tid; i < 256; i += 512) { *((LAS f32x4*)lgb + i) = *((const f32x4*)lng + i); *((LAS f32x4*)(lgb + 1024) + i) = *((const f32x4*)lnb + i); } }
    __syncthreads();
    for (int grp = gw / NWAVES; grp < NTOK / 64; grp += NGW / NWAVES) {
    if (tid < 32) hist[tid] = 0u;
    __syncthreads();
    if (wv < 4) {
        const int j = lane & 15, kg = lane >> 4;
        const int m = grp * 64 + wv * 16 + j;
        const GAS v4u* xr = (const GAS v4u*)((const bf16*)v1 + (size_t)m * 1024 + 8 * kg);
        float sm = 0.f, sq = 0.f;
        { v4u pa[8];
#pragma unroll
          for (int i = 0; i < 8; ++i) pa[i] = xr[4 * i];
#pragma unroll
          for (int blk8 = 0; blk8 < 4; ++blk8) {
              v4u pn[8];
              if (blk8 < 3) {
#pragma unroll
                  for (int i = 0; i < 8; ++i) pn[i] = xr[4 * (8 * (blk8 + 1) + i)]; }
              __builtin_amdgcn_sched_barrier(0);
              float s0 = 0.f, s1 = 0.f, q0 = 0.f, q1 = 0.f;
#pragma unroll
              for (int i = 0; i < 8; ++i) { const unsigned w[4] = {pa[i].x, pa[i].y, pa[i].z, pa[i].w};
#pragma unroll
                  for (int p2 = 0; p2 < 4; ++p2) { const float a = bflo(w[p2]), b = bfhi(w[p2]); s0 += a; s1 += b; q0 = __builtin_fmaf(a, a, q0); q1 = __builtin_fmaf(b, b, q1); } }
              sm += s0 + s1; sq += q0 + q1;
              __builtin_amdgcn_sched_barrier(0);
              if (blk8 < 3) {
#pragma unroll
                  for (int i = 0; i < 8; ++i) pa[i] = pn[i]; }
          } }
        sm += __shfl_xor(sm, 16); sm += __shfl_xor(sm, 32); sq += __shfl_xor(sq, 16); sq += __shfl_xor(sq, 32);
        const float mean = sm * (1.f / 1024.f), rstd = rsqrtf(__builtin_fmaxf(sq * (1.f / 1024.f) - mean * mean, 0.f) + LN_EPS), c0 = -mean * rstd;
        f32x4 acc[2][3];
#pragma unroll
        for (int mb = 0; mb < 2; ++mb)
#pragma unroll
            for (int q = 0; q < 3; ++q) acc[mb][q] = (f32x4){0.f, 0.f, 0.f, 0.f};
        const LAS f32x4* gp = (const LAS f32x4*)lgb + 2 * kg;
        GAS v4u* xo = (GAS v4u*)((bf16*)(ws + WS_X2B) + (size_t)m * 1024 + 8 * kg);
        const LAS unsigned char* fr = lds + lane * 16;
        v4u cur[8];
#pragma unroll
        for (int i = 0; i < 8; ++i) cur[i] = xr[4 * i];
#pragma unroll
        for (int blk8 = 0; blk8 < 4; ++blk8) {
            v4u nxt[8];
            if (blk8 < 3) {
#pragma unroll
                for (int i = 0; i < 8; ++i) nxt[i] = xr[4 * (8 * (blk8 + 1) + i)]; }
#pragma unroll
            for (int i = 0; i < 8; ++i) { const int s = 8 * blk8 + i;
                const f32x4 g0 = gp[8 * s], g1 = gp[8 * s + 1], b0 = gp[256 + 8 * s], b1 = gp[256 + 8 * s + 1];
                const float gg[8] = {g0.x, g0.y, g0.z, g0.w, g1.x, g1.y, g1.z, g1.w}, bb[8] = {b0.x, b0.y, b0.z, b0.w, b1.x, b1.y, b1.z, b1.w};
                const unsigned w[4] = {cur[i].x, cur[i].y, cur[i].z, cur[i].w};
                unsigned h[4], l[4];
#pragma unroll
                for (int p2 = 0; p2 < 4; ++p2) {
                    const float x0 = __builtin_fmaf(__builtin_fmaf(bflo(w[p2]), rstd, c0), gg[2 * p2], bb[2 * p2]), x1 = __builtin_fmaf(__builtin_fmaf(bfhi(w[p2]), rstd, c0), gg[2 * p2 + 1], bb[2 * p2 + 1]);
                    h[p2] = pk2(x0, x1); l[p2] = pk2(x0 - bflo(h[p2]), x1 - bfhi(h[p2])); }
                const v4u hv = {h[0], h[1], h[2], h[3]}, lv = {l[0], l[1], l[2], l[3]};
                xo[4 * s] = hv;
                const bf16x8 Bh = __builtin_bit_cast(bf16x8, hv), Bl = __builtin_bit_cast(bf16x8, lv);
#pragma unroll
                for (int mb = 0; mb < 2; ++mb) {
                    const bf16x8 Ah = *(const LAS bf16x8*)(fr + ((s * 2 + mb) * 2) * 1024), Al = *(const LAS bf16x8*)(fr + ((s * 2 + mb) * 2 + 1) * 1024);
                    acc[mb][0] = mfma16(Ah, Bh, acc[mb][0]); acc[mb][1] = mfma16(Ah, Bl, acc[mb][1]); acc[mb][2] = mfma16(Al, Bh, acc[mb][2]); }
                asm volatile("" ::: "memory"); __builtin_amdgcn_sched_barrier(0);
            }
            if (blk8 < 3) {
#pragma unroll
                for (int i = 0; i < 8; ++i) cur[i] = nxt[i]; }
        }
        float val[8];
#pragma unroll
        for (int c = 0; c < 8; ++c) val[c] = (acc[c >> 2][0][c & 3] + acc[c >> 2][1][c & 3]) + acc[c >> 2][2][c & 3] + A.in(I_RB)[16 * (c >> 2) + 4 * kg + (c & 3)];
        float tv[4]; int ti[4];
#pragma unroll
        for (int k = 0; k < 4; ++k) {
            float best = val[0]; int bi = 4 * kg;
#pragma unroll
            for (int c = 1; c < 8; ++c) { if (val[c] > best) { best = val[c]; bi = 16 * (c >> 2) + 4 * kg + (c & 3); } }
#pragma unroll
            for (int o = 16; o <= 32; o <<= 1) { const float ov = __shfl_xor(best, o); const int oi = __shfl_xor(bi, o); if (ov > best || (ov == best && oi < bi)) { best = ov; bi = oi; } }
            tv[k] = best; ti[k] = bi;
#pragma unroll
            for (int c = 0; c < 8; ++c) if (16 * (c >> 2) + 4 * kg + (c & 3) == bi) val[c] = -INFINITY;
        }
        const float e1 = __expf(tv[1] - tv[0]), e2 = __expf(tv[2] - tv[0]), e3 = __expf(tv[3] - tv[0]);
        const float inv = 1.0f / (1.0f + e1 + e2 + e3);
        if (kg == 0) {
            *(GAS v4u*)((int*)(ws + WS_TOPI) + (size_t)m * 4) = (v4u){(unsigned)ti[0], (unsigned)ti[1], (unsigned)ti[2], (unsigned)ti[3]};
            *(GAS f32x4*)((float*)(ws + WS_GATE) + (size_t)m * 4) = (f32x4){inv, e1 * inv, e2 * inv, e3 * inv};
#pragma unroll
            for (int k = 0; k < 4; ++k) __hip_atomic_fetch_add(&hist[ti[k]], 1u, __ATOMIC_RELAXED, __HIP_MEMORY_SCOPE_WORKGROUP);
        }
    }
    __syncthreads();
    if (tid < 32) { ((unsigned*)(ws + WS_GCNT))[grp * 32 + tid] = hist[tid]; if (hist[tid]) atomicAdd((unsigned*)(ws + WS_CTL) + CW_CNT + tid, hist[tid]); }
    __syncthreads();
    }
}

__device__ __forceinline__ void moe_combine(const KA& A, int gw, int NGW, int lane) {
    unsigned char* ws = A.ws;
    f32x4 gg[4], be[4];
#pragma unroll
    for (int j = 0; j < 4; ++j) { gg[j] = *(const f32x4*)(A.in(I_LN3G) + 4 * lane + 256 * j); be[j] = *(const f32x4*)(A.in(I_LN3B) + 4 * lane + 256 * j); }
    for (int m = gw; m < NTOK; m += NGW) {
        const v4u dst = *(const GAS v4u*)((const int*)(ws + WS_DEST) + (size_t)m * 4);
        const f32x4 gt = *(const GAS f32x4*)((const float*)(ws + WS_GATE) + (size_t)m * 4);
        const unsigned dd[4] = {dst.x, dst.y, dst.z, dst.w}; const float gk[4] = {gt.x, gt.y, gt.z, gt.w};
        f32x4 x[4]; float s = 0.f;
#pragma unroll
        for (int j = 0; j < 4; ++j) {
#if defined(PROBE_RAW16_OFF)
            f32x4 v; { const v2u y = *((const GAS v2u*)((const bf16*)(ws + (size_t)(PROBE_RAW16_OFF) * MiB) + (size_t)m * 1024) + lane + 64 * j);
                v.x = (float)(y.x & 0xffffu) * (1.0f / 65536.0f); v.y = (float)(y.x >> 16) * (1.0f / 65536.0f); v.z = (float)(y.y & 0xffffu) * (1.0f / 65536.0f); v.w = (float)(y.y >> 16) * (1.0f / 65536.0f); }
#elif defined(PROBE_BF16_OFF)
            f32x4 v; { const v2u y = *((const GAS v2u*)((const bf16*)(ws + (size_t)(PROBE_BF16_OFF) * MiB) + (size_t)m * 1024) + lane + 64 * j); v.x = bflo(y.x); v.y = bfhi(y.x); v.z = bflo(y.y); v.w = bfhi(y.y); }
#elif defined(PROBE_F32_OFF)
            f32x4 v = *((const GAS f32x4*)((const float*)(ws + (size_t)(PROBE_F32_OFF) * MiB) + (size_t)m * 1024) + lane + 64 * j);
#elif defined(PROBE_INPUT)
            f32x4 v = *((const GAS f32x4*)(A.in(I_X) + (size_t)m * 1024) + lane + 64 * j) + *((const GAS f32x4*)(A.in(I_EWD) + (size_t)m * 2048) + lane + 64 * j) + *((const GAS f32x4*)(A.in(I_WIN) + (size_t)m * 224) + lane + 64 * j);
#else
            f32x4 v; { const v2u xw = *((const GAS v2u*)((const bf16*)(ws + WS_X2B) + (size_t)m * 1024) + lane + 64 * j); v = (f32x4){bflo(xw.x), bfhi(xw.x), bflo(xw.y), bfhi(xw.y)} * DN_ALPHA; }
#endif
#ifndef SKIP_MOE
#pragma unroll
            for (int k = 0; k < 4; ++k) { const v2u y = *((const GAS v2u*)((const bf16*)(ws + WS_Y) + (size_t)dd[k] * 1024) + lane + 64 * j);
                v.x += gk[k] * bflo(y.x); v.y += gk[k] * bfhi(y.x); v.z += gk[k] * bflo(y.y); v.w += gk[k] * bfhi(y.y); }
#endif
            x[j] = v; s += (v.x + v.y) + (v.z + v.w);
        }
#if defined(PROBE_RAW16_OFF)
#pragma unroll
        for (int j = 0; j < 4; ++j) *((GAS f32x4*)(A.out() + (size_t)m * 1024) + lane + 64 * j) = x[j];
        (void)s;
#elif defined(PROBE_BITS)
#pragma unroll
        for (int j = 0; j < 4; ++j) { f32x4 q = x[j] * 4096.0f; q.x -= floorf(q.x); q.y -= floorf(q.y); q.z -= floorf(q.z); q.w -= floorf(q.w); *((GAS f32x4*)(A.out() + (size_t)m * 1024) + lane + 64 * j) = q; }
        (void)s;
#else
        const float mean = wave_sum(s) * (1.f / 1024.f); float s2 = 0.f;
#pragma unroll
        for (int j = 0; j < 4; ++j) { x[j] = x[j] - mean; s2 += (x[j].x * x[j].x + x[j].y * x[j].y) + (x[j].z * x[j].z + x[j].w * x[j].w); }
        const float rstd = rsqrtf(wave_sum(s2) * (1.f / 1024.f) + LN_EPS);
#pragma unroll
        for (int j = 0; j < 4; ++j) *((GAS f32x4*)(A.out() + (size_t)m * 1024) + lane + 64 * j) = x[j] * rstd * gg[j] + be[j];
#endif
    }
}
struct InprojMap { unsigned char* ws;
    __device__ __forceinline__ pg8::TileDst operator()(const pg8::Unit& u) const {
        pg8::TileDst d; d.bias = nullptr; d.scale = 1.f; const size_t r0 = (size_t)u.pm * 256; const int pn = u.pn;
        if (pn < 6) { d.base = (bf16*)(ws + WS_GQKV) + r0 * 1536 + pn * 256; d.ldc = 1536; }
        else if (pn < 8) { d.base = (bf16*)(ws + WS_GZ) + r0 * 512 + (pn - 6) * 256; d.ldc = 512; }
        else { const int w = (pn - 8) >> 1; d.base = (bf16*)(ws + (w == 0 ? WS_DQ : (w == 1 ? WS_DK : WS_DV))) + r0 * 512 + ((pn - 8) & 1) * 256; d.ldc = 512; if (w == 0) d.scale = attn_body::C2; }
        return d; } };
struct KvMap { unsigned char* ws;
    __device__ __forceinline__ pg8::TileDst operator()(const pg8::Unit& u) const {
        pg8::TileDst d; d.bias = nullptr; d.scale = 1.f; d.ldc = 256;
        d.base = (bf16*)(ws + ((u.pn >> 2) ? WS_VMAT : WS_KMAT)) + (size_t)((u.pm * 4 + (u.pn & 3)) * 256) * 256; return d; } };
struct WqkMap { unsigned char* ws;
    __device__ __forceinline__ pg8::TileDst operator()(const pg8::Unit& u) const {
        pg8::TileDst d; d.bias = nullptr; d.scale = 0.0625f * 1.4426950408889634f; d.ldc = 1024;
        d.base = (bf16*)(ws + WS_WQK) + (size_t)(u.pm >> 2) * 1048576 + (size_t)((u.pm & 3) * 256) * 1024 + (u.pn & 3) * 256; return d; } };
struct VwoMap { unsigned char* ws;
    __device__ __forceinline__ pg8::TileDst operator()(const pg8::Unit& u) const {
        pg8::TileDst d; d.bias = nullptr; d.scale = 1.f; d.ldc = 1024;
        d.base = (bf16*)(ws + WS_VWO) + (size_t)(u.pn >> 2) * 1048576 + (size_t)((u.pm & 3) * 256) * 1024 + (u.pm >> 2) * 256; return d; } };
struct DownMap { unsigned char* ws; const float* bd;
    __device__ __forceinline__ pg8::TileDst operator()(const pg8::Unit& u) const {
        pg8::TileDst d; d.scale = 1.f; d.ldc = 1024; const int e = u.pn >> 2, pnl = u.pn & 3;
        d.base = (bf16*)(ws + WS_Y) + (size_t)u.pm * 256 * 1024 + pnl * 256; d.bias = bd + e * 1024 + pnl * 256; return d; } };

#ifndef MK_N_LAUNCHES
#define MK_N_LAUNCHES 1
#endif
constexpr int N_PHASES = 17;
__global__ void __launch_bounds__(NWAVES * 64, 2) hybrid_fwd(Args args) {
    extern __shared__ __attribute__((aligned(16))) unsigned char lds_raw[];
    LAS unsigned char* lds = (LAS unsigned char*)lds_raw;
    const int G = gridDim.x, blk = blockIdx.x, NGW = G * NWAVES;
#define PH_IDS unsigned char* ws = WSP(); const KA KAv{ws}; (void)ws; int tid = threadIdx.x; asm volatile("" : "+v"(tid)); const int lane = tid & 63, wave = __builtin_amdgcn_readfirstlane(tid >> 6), gw = blk * NWAVES + wave; (void)lane; (void)gw
#define WSP() ({ const __attribute__((address_space(4))) unsigned long long* p_ = (const __attribute__((address_space(4))) unsigned long long*)__builtin_amdgcn_kernarg_segment_ptr(); asm volatile("" : "+s"(p_)); (unsigned char*)p_[32]; })
#if MK_N_LAUNCHES == 1
    constexpr int lo = 0, hi = N_PHASES;
#else
    const __attribute__((address_space(4))) unsigned char* kap = (const __attribute__((address_space(4))) unsigned char*)__builtin_amdgcn_kernarg_segment_ptr();
    const int lo = *(const __attribute__((address_space(4))) int*)(kap + 264), hi = *(const __attribute__((address_space(4))) int*)(kap + 268);
#endif
    { volatile LAS unsigned* bst0 = (volatile LAS unsigned*)(lds + MISC_OFF + 192);
      if (threadIdx.x < 2) bst0[threadIdx.x] = 0u;
      __syncthreads();
      (void)xcd_barrier_post((unsigned*)(WSP() + WS_CTL) + CW_BAR, bst0); }
#define MKBAR() ({ XcdBarrier b_; b_.bar = (unsigned*)(WSP() + WS_CTL) + CW_BAR; b_.x = xb_xcc_id(); b_.st = (volatile LAS unsigned*)(lds + MISC_OFF + 192); b_; })
#ifndef PH_MASK
#define PH_MASK 0xFFDFF
#endif
#define IN(k) ((((PH_MASK) >> (k)) & 1) && lo <= (k) && (k) < hi)
#ifndef REP_MASK
#define REP_MASK 0
#endif
#define REPS(k) ((((REP_MASK) >> (k)) & 1) ? 2 : 1)
#ifndef BG_MASK
#define BG_MASK 0xA
#endif
#define BG_TAIL(p) do { if (!(((BG_MASK) >> (p)) & 1)) break; __syncthreads(); unsigned* dc_ = (unsigned*)(ws + WS_CTL) + CW_BGDONE + 64 * (p); if (threadIdx.x == 0) __hip_atomic_fetch_add(dc_, 1u, __ATOMIC_RELAXED, __HIP_MEMORY_SCOPE_AGENT); \
    int bt_ = threadIdx.x; asm volatile("" : "+v"(bt_)); bg_pull(KAv, ws, lds, bt_ & 63, 0, 1, dc_, (unsigned)G); } while (0)
#ifndef BAR_REPS
#define BAR_REPS 1
#endif
#define SEAM(k) do { if (IN(k) && (k) + 1 < hi) { const XcdBarrier bar_ = MKBAR(); for (int br_ = 0; br_ < BAR_REPS; ++br_) xcd_barrier(bar_); } } while (0)

    if (IN(0)) for (int rep_ = 0; rep_ < REPS(0); ++rep_) { PH_IDS; p0_prologue(KAv, lds, gw, NGW, wave, lane, tid); }
    SEAM(0);
    if (IN(1)) for (int rep_ = 0; rep_ < REPS(1); ++rep_) { PH_IDS; (void)tid; (void)wave;
        const int GP = (G == 256) ? 224 : G;
        if (blk < GP) { pg8::Gemm g{(const bf16*)(ws + WS_XB), (const bf16*)(ws + WS_WIN), NTOK, INP_N, 1024}; pg8::StaticOrder S; S.init(NTOK, INP_N, GP, blk);
          pg8::EpiBf16Map<InprojMap> E{InprojMap{ws}};
          pg8::gemm_phase<pg8::EpiBf16Map<InprojMap>, pg8::StaticOrder, true, true>(lds, g, S, E); }
        { pg8::Gemm g{(const bf16*)(ws + WS_MEMB), (const bf16*)(ws + WS_WKV), NB * NMEM, 2048, 1024}; pg8::StaticOrder S; S.init(NB * NMEM, 2048, G, (blk + 32) % G);
          pg8::EpiBf16Map<KvMap> E{KvMap{ws}};
          pg8::gemm_phase<pg8::EpiBf16Map<KvMap>, pg8::StaticOrder, true, true>(lds, g, S, E); }
        BG_TAIL(1);
    }
    SEAM(1);
    if (IN(2)) for (int rep_ = 0; rep_ < REPS(2); ++rep_) { PH_IDS;
#ifndef P2_PARTS
#define P2_PARTS 7
#endif
#ifndef REP_PREP
#define REP_PREP 1
#endif
        int cw_head[2] = {-1, -1};
        if (P2_PARTS & 1) for (int rp_ = 0; rp_ < REP_PREP; ++rp_) for (int u = blk; u < NB * 4 * NCHUNK; u += G) gdn_prep_unit(KAv, lds, u, (int)threadIdx.x, cw_head);
        if (P2_PARTS & 2) { pg8::Gemm g{(const bf16*)(ws + WS_KMAT), (const bf16*)(ws + WS_WQH), 2048, 4096, 256}; pg8::WqkOrder S{G, blk};
          pg8::EpiBf16Map<WqkMap> E{WqkMap{ws}};
          pg8::gemm_phase<pg8::EpiBf16Map<WqkMap>, pg8::WqkOrder, true, true>(lds, g, S, E); }
        if (P2_PARTS & 4) { pg8::Gemm g{(const bf16*)(ws + WS_WOH), (const bf16*)(ws + WS_VMAT), 4096, 2048, 256}; pg8::VwoOrder S{G, blk};
          pg8::EpiBf16Map<VwoMap> E{VwoMap{ws}};
          pg8::gemm_phase<pg8::EpiBf16Map<VwoMap>, pg8::VwoOrder, true, true>(lds, g, S, E); }
        BG_TAIL(2);
#if SPLIT23
        split_arrive((unsigned*)(ws + WS_CTL) + CW_SPLIT);
#endif
    }
#if !SPLIT23
    SEAM(2);
#endif
    if (IN(3)) for (int rep_ = 0; rep_ < REPS(3); ++rep_) { PH_IDS;
        const attn_body::AttnTensors AT{(const attn_body::bf16*)(ws + WS_DQ), (const attn_body::bf16*)(ws + WS_DK), (const attn_body::bf16*)(ws + WS_DV), (attn_body::bf16*)(ws + WS_O16)};
#ifndef P3_MODE
#define P3_MODE 0
#endif
#if P3_MODE == 0
        if (blk < NB * 4 * SCAN_SPLIT) {
#if SPLIT23
            split_wait((unsigned*)(ws + WS_CTL) + CW_SPLIT, (unsigned)G, (unsigned*)(ws + WS_CTL) + CW_BAR);
#endif
            gdn_scan(KAv, lds, blk, tid, wave, lane); __syncthreads(); }
        const attn_body::QueueOrder S{(unsigned*)(ws + WS_CTL) + CW_AQ + rep_ * 512, (volatile LAS int*)(lds + MISC_OFF + 200), blk & 7, 0u, 0};
        attn_body::attn_phase<attn_body::QueueOrder>((char*)lds_raw, AT, S);
        BG_TAIL(3);
#else
        if (blk < NB * 4) { gdn_scan(KAv, lds, blk, tid, wave, lane); __syncthreads(); }
        if (P3_MODE == 2) { if (blk < NB * 4) { gdn_scan(KAv, lds, blk, tid, wave, lane); __syncthreads(); } }
        { const XcdBarrier bar_ = MKBAR(); xcd_barrier(bar_); }
        { const attn_body::QueueOrder S{(unsigned*)(ws + WS_CTL) + CW_AQ, (volatile LAS int*)(lds + MISC_OFF + 200), blk & 7, 0u, 0};
          attn_body::attn_phase<attn_body::QueueOrder>((char*)lds_raw, AT, S); }
        if (P3_MODE == 3) { const attn_body::QueueOrder S{(unsigned*)(ws + WS_CTL) + CW_AQ + 512, (volatile LAS int*)(lds + MISC_OFF + 200), blk & 7, 0u, 0};
          attn_body::attn_phase<attn_body::QueueOrder>((char*)lds_raw, AT, S); }
#endif
    }
    SEAM(3);
    if (IN(4)) for (int rep_ = 0; rep_ < REPS(4); ++rep_) { PH_IDS; mixer_post(KAv, gw, NGW, lane); }
    SEAM(4);
    if (IN(5)) for (int rep_ = 0; rep_ < REPS(5); ++rep_) { PH_IDS; (void)tid; (void)wave;
        pg8::Gemm g{(const bf16*)(ws + WS_OA), (const bf16*)(ws + WS_WOUT), NTOK, 1024, 1024}; pg8::StaticOrder S; S.init(NTOK, 1024, G, blk);
        pg8::EpiResBf16 E{KAv.in(I_X), (bf16*)(ws + WS_V1), DN_ALPHA};
        pg8::gemm_phase<pg8::EpiResBf16, pg8::StaticOrder, true, true>(lds, g, S, E);
    }
    SEAM(5);
    if (IN(6)) for (int rep_ = 0; rep_ < REPS(6); ++rep_) { PH_IDS; ln_pass_b((const bf16*)(ws + WS_V1), KAv.in(I_LN1G), KAv.in(I_LN1B), (bf16*)(ws + WS_X1B), gw, NGW, lane); }
    SEAM(6);
    if (IN(7)) for (int rep_ = 0; rep_ < REPS(7); ++rep_) { PH_IDS; (void)tid; (void)wave;
        pg8::Gemm g{(const bf16*)(ws + WS_X1B), (const bf16*)(ws + WS_WQK), NTOK, 1024, 1024}; pg8::BatchOrder S; S.init(NTOK, 1024, G, blk);
        pg8::EpiSoftmax E{(bf16*)(ws + WS_PM)};
        pg8::gemm_phase<pg8::EpiSoftmax, pg8::BatchOrder, false, true>(lds, g, S, E);
    }
    SEAM(7);
    if (IN(8)) for (int rep_ = 0; rep_ < REPS(8); ++rep_) { PH_IDS; (void)tid; (void)wave;
        pg8::Gemm g{(const bf16*)(ws + WS_PM), (const bf16*)(ws + WS_VWO), NTOK, 1024, 1024}; pg8::BatchOrder S; S.init(NTOK, 1024, G, blk);
        pg8::EpiResBf16B E{(const bf16*)(ws + WS_X1B), (bf16*)(ws + WS_V1), DN_ALPHA};
        pg8::gemm_phase<pg8::EpiResBf16B, pg8::BatchOrder, true, true>(lds, g, S, E);
    }
    SEAM(8);
    if (IN(9)) for (int rep_ = 0; rep_ < REPS(9); ++rep_) { PH_IDS; ln_pass((const float*)(ws + WS_V1), KAv.in(I_LN2G), KAv.in(I_LN2B), KAv.out(), (bf16*)(ws + WS_X2B), gw, NGW, lane); }
    SEAM(9);
    if (IN(10)) for (int rep_ = 0; rep_ < REPS(10); ++rep_) { PH_IDS;
#ifndef ROUTER_MFMA
#define ROUTER_MFMA 1
#endif
#if ROUTER_MFMA
        moe_route_mfma(KAv, lds, gw, NGW, tid, lane, (const float*)(ws + WS_V1));
#else
        moe_route(KAv, lds, gw, NGW, tid, lane, (const float*)(ws + WS_V1));
#endif
    }
    SEAM(10);
    if (IN(11)) for (int rep_ = 0; rep_ < REPS(11); ++rep_) { PH_IDS; moe_layout(KAv, lds, tid);
#ifndef P11_REP_SC
#define P11_REP_SC 1
#endif
#pragma unroll 1
        for (int sc_ = 0; sc_ < P11_REP_SC; ++sc_) moe_scatter(KAv, lds, blk, G, tid, wave, lane);
        bg_pull(KAv, ws, lds, lane, 0, -1, nullptr, 0u); }
    SEAM(11);
    if (IN(12)) for (int rep_ = 0; rep_ < REPS(12); ++rep_) { PH_IDS;
        if (!IN(11)) moe_layout(KAv, lds, tid);
        const LAS int* T = (const LAS int*)(lds + MISC_OFF + 256);
        pg8::Gemm g{(const bf16*)(ws + WS_X2B), (const bf16*)(ws + WS_WGU), MOE_MAXROWS, NEXP * 2048, 1024, (const int*)(ws + WS_TOKTAB)};
        pg8::MoeOrder S{G, blk, 8, __builtin_amdgcn_readfirstlane(T[32]), T + 64};
        pg8::EpiSwiglu E{(bf16*)(ws + WS_H), KAv.in(I_EBG), KAv.in(I_EBU)};
        pg8::gemm_phase<pg8::EpiSwiglu, pg8::MoeOrder, true, true, true>(lds, g, S, E);
        bg_pull(KAv, ws, lds, lane, 1, -1, nullptr, 0u);
    }
    SEAM(12);
    if (IN(13)) for (int rep_ = 0; rep_ < REPS(13); ++rep_) { PH_IDS;
        if (!IN(11)) moe_layout(KAv, lds, tid);
        const LAS int* T = (const LAS int*)(lds + MISC_OFF + 256);
        pg8::Gemm g{(const bf16*)(ws + WS_H), (const bf16*)(ws + WS_WD), MOE_MAXROWS, NEXP * 1024, 1024};
        pg8::MoeOrder S{G, blk, 4, __builtin_amdgcn_readfirstlane(T[32]), T + 64};
        pg8::EpiBf16Map<DownMap> E{DownMap{ws, KAv.in(I_EBD)}};
        pg8::gemm_phase<pg8::EpiBf16Map<DownMap>, pg8::MoeOrder, true, true>(lds, g, S, E);
    }
    SEAM(13);
    if (IN(14)) for (int rep_ = 0; rep_ < REPS(14); ++rep_) { PH_IDS; moe_combine(KAv, gw, NGW, lane); }
#undef IN
#undef SEAM
}


#if MK_N_LAUNCHES == 99
__global__ void dbg_chk(const unsigned* p, size_t n, unsigned long long* slot) {
    unsigned long long s = 0;
    for (size_t i = blockIdx.x * (size_t)blockDim.x + threadIdx.x; i < n; i += (size_t)gridDim.x * blockDim.x) s += (unsigned long long)p[i] * (unsigned long long)((i * 2654435761ull) | 1ull);
    atomicAdd(slot, s);
}
__global__ void dbg_cmp(float* out, size_t n, const unsigned long long* slots) {
    float f = 1.0f;
    if (slots[0] != slots[2]) f = 1.5f; else if (slots[1] != slots[3]) f = 1.2f;
    if (f != 1.0f) for (size_t i = blockIdx.x * (size_t)blockDim.x + threadIdx.x; i < n; i += (size_t)gridDim.x * blockDim.x) out[i] *= f;
}
#endif
extern "C" void kernel_launch(void* const* d_in, const int* in_sizes, int n_in, void* d_out, int out_size, void* d_ws, size_t ws_size, hipStream_t stream) {
    static int grid = 0;
    if (grid == 0) {
        if (n_in != 31 || out_size != NTOK * DM || ws_size < WS_END) { fprintf(stderr, "kernel_launch: unexpected shapes (n_in %d, out %d, ws %zu)\n", n_in, out_size, ws_size); grid = -1; return; }
        int dev = 0, cus = 0, per_cu = 0;
        if (hipGetDevice(&dev) != hipSuccess || hipDeviceGetAttribute(&cus, hipDeviceAttributeMultiprocessorCount, dev) != hipSuccess) { grid = -1; return; }
        if (hipFuncSetAttribute((const void*)hybrid_fwd, hipFuncAttributeMaxDynamicSharedMemorySize, LDS_BYTES) != hipSuccess) { fprintf(stderr, "kernel_launch: hipFuncSetAttribute failed\n"); grid = -1; return; }
        if (hipOccupancyMaxActiveBlocksPerMultiprocessor(&per_cu, (const void*)hybrid_fwd, NWAVES * 64, LDS_BYTES) != hipSuccess || per_cu < 1) { fprintf(stderr, "kernel_launch: occupancy query says %d blocks per CU\n", per_cu); (void)hipGetLastError(); per_cu = 1; }
        grid = cus;
        if (grid != 256) fprintf(stderr, "kernel_launch: %d CUs; the fused softmax epilogue assumes 256\n", grid);
    }
    if (grid < 0) return;
    (void)hipMemsetAsync((char*)d_ws + WS_CTL, 0, CTL_ZERO_BYTES, stream);
    Args a{};
    for (int i = 0; i < 31; ++i) a.in[i] = (const float*)d_in[i];
    a.out = (float*)d_out; a.ws = (unsigned char*)d_ws;
#if MK_N_LAUNCHES == 99
    unsigned long long* slots = (unsigned long long*)((char*)d_ws + 223 * MiB);
    (void)hipMemsetAsync(slots, 0, 64, stream);
    for (int rep = 0; rep < 2; ++rep) {
        for (int half = 0; half < 2; ++half) {
            (void)hipMemsetAsync((char*)d_ws + WS_CTL, 0, CTL_ZERO_BYTES, stream);
            a.ph_lo = half ? 10 : 0; a.ph_hi = half ? 15 : 10;
            hipLaunchKernelGGL(hybrid_fwd, dim3(grid), dim3(NWAVES * 64), LDS_BYTES, stream, a);
            hipLaunchKernelGGL(dbg_chk, dim3(1024), dim3(256), 0, stream, (const unsigned*)d_out, (size_t)NTOK * DM, slots + rep * 2 + half);
        }
    }
    hipLaunchKernelGGL(dbg_cmp, dim3(1024), dim3(256), 0, stream, (float*)d_out, (size_t)NTOK * DM, (const unsigned long long*)slots);
#elif MK_N_LAUNCHES == 1
    a.ph_lo = 0; a.ph_hi = N_PHASES;
    void* kargs[] = {&a};
    hipError_t e = hipLaunchCooperativeKernel((const void*)hybrid_fwd, dim3(grid), dim3(NWAVES * 64), kargs, LDS_BYTES, stream);
    if (e != hipSuccess) fprintf(stderr, "cooperative launch failed: %s (grid %d)\n", hipGetErrorString(e), grid);
#else
    for (int p = 0; p < 15; ++p) {
        a.ph_lo = p; a.ph_hi = p + 1;
        hipLaunchKernelGGL(hybrid_fwd, dim3(grid), dim3(NWAVES * 64), LDS_BYTES, stream, a);
    }
#endif
}
```
